# Optimizing an MI355X kernel written in HIP

```python
import jax, jax.numpy as jnp
from jax import lax
import numpy as np

D_MODEL = 1024
BATCH = 4
SEQ = 8192
DEPTH = 2

GRID_W = 64
CTX_LEN = 256
N_MIXERS = 2
EPS = 1e-6
MLA_HEADS = 8
MLA_Q_RANK = 512
MLA_KV_RANK = 256
MLA_NOPE = 128
MLA_ROPE = 64
MLA_V = 128
Q_BLOCK = 128
ROPE_BASE = 10000.0
GLA_HEADS = 4
GLA_DK = D_MODEL // 2 // GLA_HEADS
GLA_DV = D_MODEL // GLA_HEADS
GLA_GATE_RANK = 16
GLA_GATE_NORM = 16.0
GLA_CHUNK = 64
N_EXPERTS = 32
TOP_K = 4
D_FF = D_MODEL
SWIGLU_ALPHA = 1.702
SWIGLU_LIMIT = 7.0
MOE_BLOCK = 128

kernel_name = 'hybrid_mla_gla_moe_dit_trunk'


def rmsnorm(x, g):
    xf = x.astype(jnp.float32)
    y = xf * lax.rsqrt(jnp.mean(xf * xf, axis=-1, keepdims=True) + EPS)
    return (y * g.astype(jnp.float32)).astype(x.dtype)


def axial_rope_tables(n):
    rows = n // GRID_W
    row = jnp.repeat(jnp.arange(rows, dtype=jnp.float32), GRID_W)
    col = jnp.tile(jnp.arange(GRID_W, dtype=jnp.float32), rows)
    nf = MLA_ROPE // 4
    inv = jnp.power(ROPE_BASE, -jnp.arange(nf, dtype=jnp.float32) / nf)
    ang = jnp.concatenate([row[:, None] * inv, col[:, None] * inv], axis=-1)
    return jnp.cos(ang), jnp.sin(ang)


def apply_axial_rope(x, cos, sin):
    nf = MLA_ROPE // 4
    shp = (cos.shape[0],) + (1,) * (x.ndim - 3) + (2, nf)
    c = cos.reshape(shp)
    s = sin.reshape(shp)
    xs = x.astype(jnp.float32).reshape(x.shape[:-1] + (2, 2, nf))
    x1, x2 = xs[..., 0, :], xs[..., 1, :]
    out = jnp.stack([x1 * c - x2 * s, x2 * c + x1 * s], axis=-2)
    return out.reshape(x.shape).astype(x.dtype)


def mla_mixer(h, hc, cos, sin, w_in, q_norm, w_uq, kv_norm, w_ukv, w_o, with_ctx_out):
    H = MLA_HEADS
    w_uk = w_ukv[:, :H * MLA_NOPE].reshape(MLA_KV_RANK, H, MLA_NOPE)
    w_uv = w_ukv[:, H * MLA_NOPE:].reshape(MLA_KV_RANK, H, MLA_V)
    scale = (MLA_NOPE + MLA_ROPE) ** -0.5

    def project(z, rotate):
        b, l, _ = z.shape
        a = z @ w_in
        cq = rmsnorm(a[..., :MLA_Q_RANK], q_norm)
        ckv = rmsnorm(a[..., MLA_Q_RANK:MLA_Q_RANK + MLA_KV_RANK], kv_norm)
        kr = a[..., MLA_Q_RANK + MLA_KV_RANK:]
        q = (cq @ w_uq).reshape(b, l, H, MLA_NOPE + MLA_ROPE)
        q_nope, q_rope = q[..., :MLA_NOPE], q[..., MLA_NOPE:]
        if rotate:
            q_rope = apply_axial_rope(q_rope, cos, sin)
            kr = apply_axial_rope(kr, cos, sin)
        q_eff = jnp.concatenate([jnp.einsum('blhn,chn->blhc', q_nope, w_uk), q_rope], axis=-1)
        keys = jnp.concatenate([ckv, kr], axis=-1)
        return q_eff, keys, ckv

    def attend(q, keys, vals):
        s = jnp.einsum('bqhc,bkc->bhqk', q, keys).astype(jnp.float32) * scale
        p = jax.nn.softmax(s, axis=-1).astype(vals.dtype)
        return jnp.einsum('bhqk,bkc->bqhc', p, vals)

    def out_proj(o):
        b, l = o.shape[:2]
        return jnp.einsum('blhc,chv->blhv', o, w_uv).reshape(b, l, H * MLA_V) @ w_o

    q_l, k_l, v_l = project(h, True)
    q_c, k_c, v_c = project(hc, False)
    k_all = jnp.concatenate([k_l, k_c], axis=1)
    v_all = jnp.concatenate([v_l, v_c], axis=1)
    B, N = h.shape[:2]
    nb = N // Q_BLOCK
    q_blocks = q_l.reshape(B, nb, Q_BLOCK, H, MLA_KV_RANK + MLA_ROPE).transpose(1, 0, 2, 3, 4)
    o = lax.map(lambda qb: attend(qb, k_all, v_all), q_blocks)
    o = o.transpose(1, 0, 2, 3, 4).reshape(B, N, H, MLA_KV_RANK)
    y = out_proj(o)
    yc = out_proj(attend(q_c, k_c, v_c)) if with_ctx_out else None
    return y, yc


def gla_scan(q, k, v, g, s0):
    B, L, H, DK = q.shape
    DV = v.shape[-1]
    C = GLA_CHUNK
    nc = L // C
    mask = jnp.tril(jnp.ones((C, C), dtype=bool))

    def chunks(t):
        return t.reshape(B, nc, C, H, t.shape[-1]).transpose(1, 0, 3, 2, 4).astype(jnp.float32)

    def step(S, inp):
        qc, kc, vc, gc = inp
        b = jnp.cumsum(gc, axis=2)
        o_inter = jnp.einsum('bhcd,bhde->bhce', qc * jnp.exp(b), S)
        diff = b[:, :, :, None, :] - b[:, :, None, :, :]
        decay = jnp.exp(jnp.where(mask[:, :, None], diff, -jnp.inf))
        A = jnp.einsum('bhid,bhijd,bhjd->bhij', qc, decay, kc)
        o_intra = jnp.einsum('bhij,bhje->bhie', A, vc)
        b_last = b[:, :, -1:, :]
        S_new = jnp.exp(b_last[:, :, 0, :])[..., None] * S + jnp.einsum('bhjd,bhje->bhde', kc * jnp.exp(b_last - b), vc)
        return S_new, o_inter + o_intra

    s_fin, o = lax.scan(step, s0, (chunks(q), chunks(k), chunks(v), chunks(g)))
    o = o.transpose(1, 0, 3, 2, 4).reshape(B, L, H, DV).astype(v.dtype)
    return o, s_fin


def gla_mixer(h, hc, w_in, w_gate1, w_gate2, b_gate, head_norm, w_o, with_ctx_out):
    H = GLA_HEADS
    nqk = H * GLA_DK
    nv = H * GLA_DV

    def project(z):
        b, l, _ = z.shape
        a = z @ w_in
        q = a[..., :nqk].reshape(b, l, H, GLA_DK) * (GLA_DK ** -0.5)
        k = a[..., nqk:2 * nqk].reshape(b, l, H, GLA_DK)
        v = a[..., 2 * nqk:2 * nqk + nv].reshape(b, l, H, GLA_DV)
        r = a[..., 2 * nqk + nv:]
        g_f = (jax.nn.log_sigmoid((z @ w_gate1[0]) @ w_gate2[0] + b_gate[0]) / GLA_GATE_NORM).reshape(b, l, H, GLA_DK)
        g_b = (jax.nn.log_sigmoid((z @ w_gate1[1]) @ w_gate2[1] + b_gate[1]) / GLA_GATE_NORM).reshape(b, l, H, GLA_DK)
        return q, k, v, r, g_f, g_b

    def flip(t):
        return jnp.flip(t, axis=1)

    def finish(o, r):
        b, l = o.shape[:2]
        o = rmsnorm(o, head_norm).reshape(b, l, nv)
        return (o * jax.nn.silu(r)) @ w_o

    B = h.shape[0]
    s0 = jnp.zeros((B, H, GLA_DK, GLA_DV), jnp.float32)
    qc, kc, vc, rc, gcf, gcb = project(hc)
    oc_f, sc_f = gla_scan(qc, kc, vc, gcf, s0)
    oc_b, sc_b = gla_scan(flip(qc), flip(kc), flip(vc), flip(gcb), s0)
    q, k, v, r, g_f, g_b = project(h)
    o_f, _ = gla_scan(q, k, v, g_f, sc_f)
    o_b, _ = gla_scan(flip(q), flip(k), flip(v), flip(g_b), sc_b)
    y = finish(o_f + flip(o_b), r)
    yc = finish(oc_f + flip(oc_b), rc) if with_ctx_out else None
    return y, yc


def moe(t, w_router, b_router, w_gu, b_gu, w_down, b_down):
    T, D = t.shape
    logits = (t @ w_router + b_router).astype(jnp.float32)
    top_val, top_idx = lax.top_k(logits, TOP_K)
    gate = jax.nn.softmax(top_val, axis=-1)
    n_assign = T * TOP_K
    flat_e = top_idx.reshape(-1)
    flat_tok = jnp.repeat(jnp.arange(T, dtype=jnp.int32), TOP_K)
    flat_w = gate.reshape(-1)
    order = jnp.argsort(flat_e)
    se = flat_e[order]
    counts = jnp.bincount(flat_e, length=N_EXPERTS)
    padded = (counts + MOE_BLOCK - 1) // MOE_BLOCK * MOE_BLOCK
    start_s = jnp.cumsum(counts) - counts
    end_p = jnp.cumsum(padded)
    start_p = end_p - padded
    dest = start_p[se] + jnp.arange(n_assign) - start_s[se]
    n_rows = (n_assign + MOE_BLOCK - 1) // MOE_BLOCK * MOE_BLOCK + N_EXPERTS * MOE_BLOCK
    n_blocks = n_rows // MOE_BLOCK
    row_tok = jnp.zeros((n_rows,), jnp.int32).at[dest].set(flat_tok[order])
    row_w = jnp.zeros((n_rows,), jnp.float32).at[dest].set(flat_w[order])
    block_e = jnp.minimum(jnp.searchsorted(end_p, jnp.arange(n_blocks) * MOE_BLOCK, side='right'), N_EXPERTS - 1)

    def block_fn(args):
        tok, w, e = args
        xb = t[tok]
        gu = xb @ w_gu[e] + b_gu[e]
        g_, u_ = gu[:, ::2], gu[:, 1::2]
        g_ = jnp.minimum(g_, SWIGLU_LIMIT)
        u_ = jnp.clip(u_, -SWIGLU_LIMIT, SWIGLU_LIMIT)
        y = (u_ + 1) * (g_ * jax.nn.sigmoid(SWIGLU_ALPHA * g_))
        y = y @ w_down[e] + b_down[e]
        return y * w[:, None].astype(y.dtype)

    rows = lax.map(block_fn, (row_tok.reshape(n_blocks, MOE_BLOCK), row_w.reshape(n_blocks, MOE_BLOCK), block_e))
    return jax.ops.segment_sum(rows.reshape(n_rows, D), row_tok, num_segments=T)


def setup_inputs(seed: int = 0) -> dict:
    key = jax.random.key(seed)
    ks = jax.random.split(key, 32)
    D = D_MODEL
    n_mla = (DEPTH + 1) // 2
    n_gla = DEPTH // 2
    mla_in = MLA_Q_RANK + MLA_KV_RANK + MLA_ROPE
    gla_in = 2 * GLA_HEADS * GLA_DK + 2 * GLA_HEADS * GLA_DV

    def nrm(k, shape, scale):
        return jax.random.normal(k, shape, jnp.float32) * scale

    return {
        'x': nrm(ks[0], (BATCH, SEQ, D), 1.0),
        'c': nrm(ks[1], (BATCH, D), 1.0),
        'ctx': nrm(ks[2], (BATCH, CTX_LEN, D), 1.0),
        'c_ctx': nrm(ks[3], (D,), 1.0),
        'mod_w': nrm(ks[4], (DEPTH, D, 6 * D), 0.3 * D ** -0.5),
        'mod_b': nrm(ks[5], (DEPTH, 6 * D), 0.02),
        'norm1': 1.0 + nrm(ks[6], (DEPTH, D), 0.05),
        'norm2': 1.0 + nrm(ks[7], (DEPTH, D), 0.05),
        'mla_w_in': nrm(ks[8], (n_mla, D, mla_in), D ** -0.5),
        'mla_q_norm': 1.0 + nrm(ks[9], (n_mla, MLA_Q_RANK), 0.05),
        'mla_w_uq': nrm(ks[10], (n_mla, MLA_Q_RANK, MLA_HEADS * (MLA_NOPE + MLA_ROPE)), MLA_Q_RANK ** -0.5),
        'mla_kv_norm': 1.0 + nrm(ks[11], (n_mla, MLA_KV_RANK), 0.05),
        'mla_w_ukv': nrm(ks[12], (n_mla, MLA_KV_RANK, MLA_HEADS * (MLA_NOPE + MLA_V)), MLA_KV_RANK ** -0.5),
        'mla_w_o': nrm(ks[13], (n_mla, MLA_HEADS * MLA_V, D), (MLA_HEADS * MLA_V) ** -0.5),
        'gla_w_in': nrm(ks[14], (n_gla, D, gla_in), D ** -0.5),
        'gla_w_gate1': nrm(ks[15], (n_gla, 2, D, GLA_GATE_RANK), D ** -0.5),
        'gla_w_gate2': nrm(ks[16], (n_gla, 2, GLA_GATE_RANK, GLA_HEADS * GLA_DK), GLA_GATE_RANK ** -0.5),
        'gla_b_gate': nrm(ks[17], (n_gla, 2, GLA_HEADS * GLA_DK), 0.1),
        'gla_head_norm': 1.0 + nrm(ks[18], (n_gla, GLA_DV), 0.05),
        'gla_w_o': nrm(ks[19], (n_gla, GLA_HEADS * GLA_DV, D), (GLA_HEADS * GLA_DV) ** -0.5),
        'moe_w_router': nrm(ks[20], (DEPTH, D, N_EXPERTS), D ** -0.5),
        'moe_b_router': nrm(ks[21], (DEPTH, N_EXPERTS), 0.01),
        'moe_w_gu': nrm(ks[22], (DEPTH, N_EXPERTS, D, 2 * D_FF), D ** -0.5),
        'moe_b_gu': nrm(ks[23], (DEPTH, N_EXPERTS, 2 * D_FF), 0.02),
        'moe_w_down': nrm(ks[24], (DEPTH, N_EXPERTS, D_FF, D), D_FF ** -0.5),
        'moe_b_down': nrm(ks[25], (DEPTH, N_EXPERTS, D), 0.02),
        'final_norm': 1.0 + nrm(ks[26], (D,), 0.05),
    }


def reference(x, c, ctx, c_ctx, mod_w, mod_b, norm1, norm2, mla_w_in, mla_q_norm, mla_w_uq, mla_kv_norm, mla_w_ukv, mla_w_o,
              gla_w_in, gla_w_gate1, gla_w_gate2, gla_b_gate, gla_head_norm, gla_w_o,
              moe_w_router, moe_b_router, moe_w_gu, moe_b_gu, moe_w_down, moe_b_down, final_norm):
    B, N, D = x.shape
    Lc = ctx.shape[1]
    cos, sin = axial_rope_tables(N)
    xc = ctx
    for i in range(DEPTH):
        last = i == DEPTH - 1
        mod = (jax.nn.silu(c) @ mod_w[i] + mod_b[i])[:, None, :]
        mod_c = (jax.nn.silu(c_ctx) @ mod_w[i] + mod_b[i])[None, None, :]
        sh1, sc1, g1, sh2, sc2, g2 = jnp.split(mod, 6, axis=-1)
        sh1c, sc1c, g1c, sh2c, sc2c, g2c = jnp.split(mod_c, 6, axis=-1)
        h = rmsnorm(x, norm1[i]) * (1 + sc1) + sh1
        hc = rmsnorm(xc, norm1[i]) * (1 + sc1c) + sh1c
        j = i // N_MIXERS
        if i % N_MIXERS == 0:
            y, yc = mla_mixer(h, hc, cos, sin, mla_w_in[j], mla_q_norm[j], mla_w_uq[j], mla_kv_norm[j], mla_w_ukv[j], mla_w_o[j], not last)
        else:
            y, yc = gla_mixer(h, hc, gla_w_in[j], gla_w_gate1[j], gla_w_gate2[j], gla_b_gate[j], gla_head_norm[j], gla_w_o[j], not last)
        x = x + g1 * y
        h = rmsnorm(x, norm2[i]) * (1 + sc2) + sh2
        if last:
            y = moe(h.reshape(B * N, D), moe_w_router[i], moe_b_router[i], moe_w_gu[i], moe_b_gu[i], moe_w_down[i], moe_b_down[i]).reshape(B, N, D)
            x = x + g2 * y
        else:
            xc = xc + g1c * yc
            hc = rmsnorm(xc, norm2[i]) * (1 + sc2c) + sh2c
            tokens = jnp.concatenate([h.reshape(B * N, D), hc.reshape(B * Lc, D)], axis=0)
            out = moe(tokens, moe_w_router[i], moe_b_router[i], moe_w_gu[i], moe_b_gu[i], moe_w_down[i], moe_b_down[i])
            x = x + g2 * out[:B * N].reshape(B, N, D)
            xc = xc + g2c * out[B * N:].reshape(B, Lc, D)
    return rmsnorm(x, final_norm)
```

```cpp
#include <hip/hip_runtime.h>
#include <cstdio>
#include <cstdint>

#ifndef MK_PER_PHASE
#define MK_PER_PHASE 0
#endif

constexpr int DM = 1024, NB = 4, SEQ = 8192, LC = 256, TPB = SEQ + LC, M = NB * TPB;
constexpr int NE = 32, TOPK = 4;
constexpr int NLAT = NB * SEQ;
constexpr int SROWS = (M * TOPK) + NE * 256;
constexpr int A2W = 3328;
constexpr float EPS = 1e-6f;

constexpr size_t MiB = 1u << 20;
constexpr size_t WS_CTL = 0, CTL_ZERO_BYTES = 1 * MiB;
constexpr size_t WS_MODV = 1 * MiB;
constexpr size_t WS_ROPE = 1 * MiB + 256 * 1024;
constexpr size_t WS_HIST = 1 * MiB + 512 * 1024;
constexpr size_t WS_META = WS_HIST + 64 * 1024;
constexpr size_t WS_TOPI = 2 * MiB, WS_TOPW = 3 * MiB, WS_POS = 4 * MiB, WS_SORT = 5 * MiB, WS_DS = 6 * MiB;
constexpr size_t WS_W_IN = 8 * MiB, WS_W_UQ = 10 * MiB, WS_W_UKV = 12 * MiB, WS_W_O = 14 * MiB, WS_W_GIN = 16 * MiB, WS_W_GO = 24 * MiB;
constexpr size_t WS_W_GU = 32 * MiB, WS_W_DN = 288 * MiB;
constexpr size_t WS_H = 416 * MiB;
constexpr size_t WS_XRES = 482 * MiB;
constexpr size_t WS_ACT = 614 * MiB;
constexpr size_t WS_YS = 894 * MiB;
constexpr size_t WS_A1 = 1174 * MiB, WS_CQ = 1240 * MiB, WS_CKV = 1273 * MiB, WS_KR = 1290 * MiB, WS_Q = 1295 * MiB, WS_KN = 1394 * MiB, WS_V = 1460 * MiB, WS_O = 1526 * MiB;
constexpr size_t WS_A2 = 1174 * MiB;
constexpr size_t WS_UST = 1389 * MiB;
constexpr size_t WS_OF = 1517 * MiB, WS_OB = 1583 * MiB, WS_Z = 1649 * MiB;
constexpr size_t WS_QE = 614 * MiB, WS_KE = 680 * MiB, WS_KPT = 746 * MiB, WS_VT = 812 * MiB, WS_DEC = 878 * MiB;
constexpr size_t WS_H8 = 1715 * MiB;
constexpr size_t WS_CQ8 = 1749 * MiB, WS_CKV8 = 1766 * MiB, WS_O8 = 1775 * MiB;
constexpr size_t WS_Q8 = 1295 * MiB, WS_KN8 = 1394 * MiB, WS_KR8 = 1290 * MiB;
constexpr size_t WS_VT8 = 1460 * MiB;
constexpr size_t WS_END = 1809 * MiB;
static_assert((size_t)M * 1024 * 2 <= 66 * MiB && (size_t)M * 1024 * 4 <= 132 * MiB && (size_t)SROWS * 1024 * 2 <= 280 * MiB && (size_t)M * A2W * 2 <= 215 * MiB, "ws map");
static_assert((size_t)M * 512 * 2 <= 33 * MiB && (size_t)M * 256 * 2 <= 17 * MiB && (size_t)M * 64 * 2 <= 5 * MiB && (size_t)M * 1536 * 2 <= 99 * MiB, "ws map");

#define GAS __attribute__((address_space(1)))
#define LAS __attribute__((address_space(3)))
typedef unsigned short bf16;
typedef unsigned v4u __attribute__((ext_vector_type(4)));
typedef unsigned v2u __attribute__((ext_vector_type(2)));
typedef float f32x4 __attribute__((ext_vector_type(4)));
typedef float f32x16 __attribute__((ext_vector_type(16)));
typedef short bf16x8 __attribute__((ext_vector_type(8)));
typedef short s16x4 __attribute__((ext_vector_type(4)));
typedef GAS unsigned gu32;
#define RLX_AGENT __ATOMIC_RELAXED, __HIP_MEMORY_SCOPE_AGENT
#define LDS_WAIT() asm volatile("s_waitcnt lgkmcnt(0)" ::: "memory")
#define VM_WAIT() asm volatile("s_waitcnt vmcnt(0)" ::: "memory")
__device__ __forceinline__ unsigned f2bf(float f) { unsigned u = __builtin_bit_cast(unsigned, f); return (u + 0x7fffu + ((u >> 16) & 1u)) >> 16; }
__device__ __forceinline__ unsigned pk2(float lo, float hi) { return f2bf(lo) | (f2bf(hi) << 16); }
__device__ __forceinline__ float bf2f(unsigned b) { return __builtin_bit_cast(float, b << 16); }
__device__ __forceinline__ float bflo(unsigned w) { return __builtin_bit_cast(float, w << 16); }
__device__ __forceinline__ float bfhi(unsigned w) { return __builtin_bit_cast(float, w & 0xffff0000u); }
__device__ __forceinline__ float wave_sum(float v) {
#pragma unroll
    for (int o = 1; o < 64; o <<= 1) v += __shfl_xor(v, o);
    return v;
}

struct KP {
    const float *x, *c, *ctx, *c_ctx, *mod_w, *mod_b, *norm1, *norm2, *mla_w_in, *mla_q_norm, *mla_w_uq, *mla_kv_norm, *mla_w_ukv, *mla_w_o,
        *gla_w_in, *gla_w_gate1, *gla_w_gate2, *gla_b_gate, *gla_head_norm, *gla_w_o, *moe_w_router, *moe_b_router, *moe_w_gu, *moe_b_gu, *moe_w_down, *moe_b_down, *final_norm;
    float* out; unsigned char* ws; int ph_lo, ph_hi;
};
namespace pg8 {
#define PG8_LAS __attribute__((address_space(3)))
typedef unsigned short bf16_t;
typedef short bf16x8 __attribute__((ext_vector_type(8)));
typedef float f32x4 __attribute__((ext_vector_type(4)));
typedef unsigned u32x4 __attribute__((ext_vector_type(4)));
constexpr int BM = 256, BK = 64, HALF = 128, HTB = HALF * BK * 2  , STAGE_BYTES = 8 * HTB, NXCD = 8, WGM = 8;

__host__ __device__ __forceinline__ int lds_byte(int r, int c) { const int st = (r >> 4) * 2 + (c >> 5), rr = r & 15, cc = c & 31, ob = rr * 64 + cc * 2; return st * 1024 + (ob ^ (((ob >> 9) & 1) << 5)); }
__host__ __device__ __forceinline__ void stage_rc(int b, int& R, int& C) { const int st = b / 1024, sb = b % 1024, swz = sb ^ (((sb >> 9) & 1) << 5); R = (st >> 1) * 16 + swz / 64; C = (st & 1) * 32 + (swz % 64) / 2; }
__host__ __device__ __forceinline__ int perm32(int rho) { const int n = rho >> 4, i = rho & 15; return 8 * (i >> 2) + 4 * n + (i & 3); }

struct Unit { int pm, pn; };
struct Gemm { const bf16_t* A; const bf16_t* Bt; int M, N, K; };

struct StaticOrder {
    int nM, nN, nwg, G, c;
    __host__ __device__ void init(int M, int N, int G_, int c_) { nM = M / BM; nN = N / BM; nwg = nM * nN; G = G_; c = c_; }
    __host__ __device__ bool next(int i, Unit& u) const {
        const long L = (long)i * G + c; if (L >= nwg) return false;
        int wgid = (int)L; { const int q = nwg / NXCD, r = nwg % NXCD, xcd = wgid % NXCD, off = wgid / NXCD; wgid = (xcd < r ? xcd * (q + 1) : r * (q + 1) + (xcd - r) * q) + off; }
        const int nig = WGM * nN, gid = wgid / nig, fm = gid * WGM, gsz = (nM - fm) < WGM ? (nM - fm) : WGM;
        u.pm = fm + ((wgid % nig) % gsz); u.pn = (wgid % nig) / gsz; return true;
    }
    __device__ __forceinline__ void a_ready(const Unit&) const {}
    __device__ __forceinline__ void done(const Unit&) const {}
};

__device__ __forceinline__ unsigned cvt_pk_bf16(float lo, float hi) { unsigned r; asm volatile("v_cvt_pk_bf16_f32 %0, %1, %2" : "=v"(r) : "v"(lo), "v"(hi)); return r; }
typedef unsigned u32x2 __attribute__((ext_vector_type(2)));
typedef float f32x8 __attribute__((ext_vector_type(8)));
__device__ __forceinline__ f32x4 ag(const f32x4 (&a)[2][2][4][2], int ai, int bj, int m, int n) { return a[ai][bj][m][n]; }
__device__ __forceinline__ f32x4 ag(const f32x8 (&a)[2][2][4], int ai, int bj, int m, int n) { return n == 0 ? __builtin_shufflevector(a[ai][bj][m], a[ai][bj][m], 0, 1, 2, 3) : __builtin_shufflevector(a[ai][bj][m], a[ai][bj][m], 4, 5, 6, 7); }

struct EpiBf16 {
    static constexpr bool PERM = true, AFTER_DRAIN = false;
    bf16_t* O; int ldc; const float* bias; int split_cols; size_t split_stride; float ascale;
    template <class AccT> __device__ __forceinline__ void operator()(const AccT& acc, const Unit& u, int wr, int wc, int fr, int fq) const {
        const int row0 = u.pm * BM + wr * 64 + fr; int colt = u.pn * BM; bf16_t* base = O;
        if (split_cols) { const int t = colt / split_cols; base += (size_t)t * split_stride; colt -= t * split_cols; }
        const int col0 = colt + wc * 32 + 8 * fq, bcol0 = u.pn * BM + wc * 32 + 8 * fq;
        f32x4 bv[2][2];
#pragma unroll
        for (int bj = 0; bj < 2; ++bj)
#pragma unroll
            for (int n = 0; n < 2; ++n) bv[bj][n] = bias ? *(const f32x4*)(bias + bcol0 + bj * HALF + 4 * n) : (f32x4){0.f, 0.f, 0.f, 0.f};
#pragma unroll
        for (int ai = 0; ai < 2; ++ai)
#pragma unroll
            for (int m = 0; m < 4; ++m) { bf16_t* rowp = base + (size_t)(row0 + ai * HALF + m * 16) * ldc + col0;
#pragma unroll
                for (int bj = 0; bj < 2; ++bj) { const f32x4 v0 = ag(acc, ai, bj, m, 0) * ascale + bv[bj][0], v1 = ag(acc, ai, bj, m, 1) * ascale + bv[bj][1];
                    u32x4 w; w.x = cvt_pk_bf16(v0[0], v0[1]); w.y = cvt_pk_bf16(v0[2], v0[3]); w.z = cvt_pk_bf16(v1[0], v1[1]); w.w = cvt_pk_bf16(v1[2], v1[3]);
                    *(u32x4*)(rowp + bj * HALF) = w; } }
    }
};

struct EpiDown8 {
    static constexpr bool PERM = true, AFTER_DRAIN = false;
    unsigned char* ys; const float* bias; float ascale;
    template <class AccT> __device__ __forceinline__ void operator()(const AccT& acc, const Unit& u, int wr, int wc, int fr, int fq) const {
        const int row0 = u.pm * BM + wr * 64 + fr; const int bcol0 = u.pn * BM + wc * 32 + 8 * fq;
        const int cst = (u.pn & 3) * BM + wc * 32 + 8 * (fq & ~1) + (fq & 1) * HALF;
        f32x4 bb[2][2];
#pragma unroll
        for (int bj = 0; bj < 2; ++bj) { bb[bj][0] = *(const f32x4*)(bias + bcol0 + bj * HALF); bb[bj][1] = *(const f32x4*)(bias + bcol0 + bj * HALF + 4); }
#pragma unroll
        for (int ai = 0; ai < 2; ++ai)
#pragma unroll
            for (int m = 0; m < 4; ++m) { unsigned w[2][2];
#pragma unroll
                for (int bj = 0; bj < 2; ++bj) { const f32x4 v0 = ag(acc, ai, bj, m, 0) * ascale + bb[bj][0], v1 = ag(acc, ai, bj, m, 1) * ascale + bb[bj][1];
                    int w0 = 0, w1 = 0; w0 = __builtin_amdgcn_cvt_pk_fp8_f32(v0[0], v0[1], w0, false); w0 = __builtin_amdgcn_cvt_pk_fp8_f32(v0[2], v0[3], w0, true);
                    w1 = __builtin_amdgcn_cvt_pk_fp8_f32(v1[0], v1[1], w1, false); w1 = __builtin_amdgcn_cvt_pk_fp8_f32(v1[2], v1[3], w1, true);
                    w[bj][0] = (unsigned)w0; w[bj][1] = (unsigned)w1; }
                const auto s0 = __builtin_amdgcn_permlane16_swap(w[0][0], w[1][0], false, false), s1 = __builtin_amdgcn_permlane16_swap(w[0][1], w[1][1], false, false);
                *(u32x4*)(ys + (size_t)(row0 + ai * HALF + m * 16) * 1024 + cst) = (u32x4){s0[0], s1[0], s0[1], s1[1]}; }
    }
};

__host__ __device__ __forceinline__ int vpos(int kl) { const int half = kl >> 5, k5 = kl & 31, hi = (k5 >> 2) & 1, r = (k5 & 3) + 4 * (k5 >> 3); return hi * 32 + half * 16 + r; }
struct EpiKV {
    static constexpr bool PERM = true, AFTER_DRAIN = false;
    unsigned char* KN8; unsigned char* VT8; float ascale;
    template <class AccT> __device__ __forceinline__ void operator()(const AccT& acc, const Unit& u, int wr, int wc, int fr, int fq) const {
        const int row0 = u.pm * BM + wr * 64 + fr; const bool isk = u.pn < 4; const int col0 = (u.pn & 3) * BM + wc * 32 + 8 * fq;
        const int b = u.pm / 33, kk0 = (u.pm % 33) * BM + wr * 64 + fr;
#pragma unroll
        for (int ai = 0; ai < 2; ++ai)
#pragma unroll
            for (int m = 0; m < 4; ++m) { const size_t ro = (size_t)(row0 + ai * HALF + m * 16) * 1024 + col0; const int kk = kk0 + ai * HALF + m * 16; const size_t kofs = (size_t)(kk & ~63) + vpos(kk & 63);
#pragma unroll
                for (int bj = 0; bj < 2; ++bj) { const f32x4 v0 = ag(acc, ai, bj, m, 0) * ascale, v1 = ag(acc, ai, bj, m, 1) * ascale;
                    int w0 = 0, w1 = 0; w0 = __builtin_amdgcn_cvt_pk_fp8_f32(v0[0], v0[1], w0, false); w0 = __builtin_amdgcn_cvt_pk_fp8_f32(v0[2], v0[3], w0, true);
                    w1 = __builtin_amdgcn_cvt_pk_fp8_f32(v1[0], v1[1], w1, false); w1 = __builtin_amdgcn_cvt_pk_fp8_f32(v1[2], v1[3], w1, true);
                    if (isk) { *(u32x2*)(KN8 + ro + bj * HALF) = (u32x2){(unsigned)w0, (unsigned)w1}; }
                    else { const int c = col0 + bj * HALF;
                        unsigned char* vp = VT8 + ((size_t)(b * 8 * 128 + c)) * 8448 + kofs;
#pragma unroll
                        for (int i = 0; i < 4; ++i) { vp[(size_t)i * 8448] = (unsigned char)((unsigned)w0 >> (8 * i)); vp[(size_t)(4 + i) * 8448] = (unsigned char)((unsigned)w1 >> (8 * i)); } } } }
    }
};

struct EpiQRope {
    static constexpr bool PERM = true, AFTER_DRAIN = false;
    unsigned char* O; const float* tcos; const float* tsin; float ascale;
    template <class AccT> __device__ __forceinline__ void operator()(const AccT& acc, const Unit& u, int wr, int wc, int fr, int fq) const {
        const int tt = u.pm % 33; const bool latent = tt != 32; const int t0 = tt * 256;
        const int colg = u.pn * BM + wc * 32;
#pragma unroll
        for (int bj = 0; bj < 2; ++bj) {
            const int gm = ((colg + bj * HALF) >> 5) % 6; const bool rope = latent && gm >= 4; const int axis = gm - 4;
#pragma unroll
            for (int ai = 0; ai < 2; ++ai)
#pragma unroll
                for (int m = 0; m < 4; ++m) {
                    const int rloc = ai * HALF + wr * 64 + m * 16 + fr; const int t = t0 + rloc;
                    f32x4 v0 = ag(acc, ai, bj, m, 0) * ascale, v1 = ag(acc, ai, bj, m, 1) * ascale;
                    if (rope) {
                        const int comp = axis == 0 ? (t >> 6) : (t & 63); const int fo = comp * 16 + (fq & 1) * 8;
                        { const f32x4 c0 = *(const f32x4*)(tcos + fo), s0 = *(const f32x4*)(tsin + fo); f32x4 p0;
#pragma unroll
                          for (int i = 0; i < 4; ++i) p0[i] = __shfl_xor(v0[i], 32);
                          v0 = fq < 2 ? v0 * c0 - p0 * s0 : v0 * c0 + p0 * s0; }
                        { const f32x4 c1 = *(const f32x4*)(tcos + fo + 4), s1 = *(const f32x4*)(tsin + fo + 4); f32x4 p1;
#pragma unroll
                          for (int i = 0; i < 4; ++i) p1[i] = __shfl_xor(v1[i], 32);
                          v1 = fq < 2 ? v1 * c1 - p1 * s1 : v1 * c1 + p1 * s1; }
                    }
                    int w0 = 0, w1 = 0; w0 = __builtin_amdgcn_cvt_pk_fp8_f32(v0[0], v0[1], w0, false); w0 = __builtin_amdgcn_cvt_pk_fp8_f32(v0[2], v0[3], w0, true);
                    w1 = __builtin_amdgcn_cvt_pk_fp8_f32(v1[0], v1[1], w1, false); w1 = __builtin_amdgcn_cvt_pk_fp8_f32(v1[2], v1[3], w1, true);
                    *(u32x2*)(O + (size_t)(u.pm * BM + rloc) * 1536 + colg + bj * HALF + 8 * fq) = (u32x2){(unsigned)w0, (unsigned)w1};
                }
        }
    }
};

struct EpiGla {
    static constexpr bool PERM = true, AFTER_DRAIN = false;
    bf16_t* A2; bf16_t* VT;
    template <class AccT> __device__ __forceinline__ void operator()(const AccT& acc, const Unit& u, int wr, int wc, int fr, int fq) const {
        const int row0 = u.pm * BM + wr * 64 + fr; const int col0 = u.pn * BM + wc * 32 + 8 * fq; const bool isv = (u.pn >> 2) == 1;
#pragma unroll
        for (int ai = 0; ai < 2; ++ai)
#pragma unroll
            for (int m = 0; m < 4; ++m) { const int row = row0 + ai * HALF + m * 16;
#pragma unroll
                for (int bj = 0; bj < 2; ++bj) { const f32x4 v0 = ag(acc, ai, bj, m, 0), v1 = ag(acc, ai, bj, m, 1);
                    u32x4 w; w.x = cvt_pk_bf16(v0[0], v0[1]); w.y = cvt_pk_bf16(v0[2], v0[3]); w.z = cvt_pk_bf16(v1[0], v1[1]); w.w = cvt_pk_bf16(v1[2], v1[3]);
                    if (!isv) { *(u32x4*)(A2 + (size_t)row * 3328 + col0 + bj * HALF) = w; }
                    else { bf16_t* vp = VT + ((size_t)(row >> 6) * 1024 + (col0 + bj * HALF - 1024)) * 64 + (row & 63);
                        vp[0] = (bf16_t)(w.x & 0xffffu); vp[64] = (bf16_t)(w.x >> 16); vp[128] = (bf16_t)(w.y & 0xffffu); vp[192] = (bf16_t)(w.y >> 16);
                        vp[256] = (bf16_t)(w.z & 0xffffu); vp[320] = (bf16_t)(w.z >> 16); vp[384] = (bf16_t)(w.w & 0xffffu); vp[448] = (bf16_t)(w.w >> 16); } } }
    }
};

struct EpiResid {
    static constexpr bool PERM = true, AFTER_DRAIN = false;
    const float* xin; const float* ctxin; bf16_t* xres; const float* gate; float ascale;
    template <class AccT> __device__ __forceinline__ void operator()(const AccT& acc, const Unit& u, int wr, int wc, int fr, int fq) const {
        const int b = u.pm / 33, tt = u.pm % 33; const bool isctx = tt == 32; const int bs = isctx ? 4 : b;
        bf16_t* dst = xres + (size_t)u.pm * BM * 1024;
        const float* src = xin ? (isctx ? ctxin + (size_t)b * 256 * 1024 : xin + ((size_t)b * 8192 + (size_t)tt * 256) * 1024) : nullptr;
        const float* g = gate + bs * 6144;
        const int r0 = wr * 64 + fr, c0 = u.pn * BM + wc * 32 + 8 * fq;
#pragma unroll
        for (int ai = 0; ai < 2; ++ai)
#pragma unroll
            for (int m = 0; m < 4; ++m) { const size_t ro = (size_t)(r0 + ai * HALF + m * 16) * 1024;
#pragma unroll
                for (int bj = 0; bj < 2; ++bj) { const int c = c0 + bj * HALF;
                    f32x4 x0, x1;
                    if (src) { x0 = *(const f32x4*)(src + ro + c); x1 = *(const f32x4*)(src + ro + c + 4); }
                    else { const u32x4 xb = *(const u32x4*)(dst + ro + c);
                        x0 = (f32x4){__builtin_bit_cast(float, xb.x << 16), __builtin_bit_cast(float, xb.x & 0xffff0000u), __builtin_bit_cast(float, xb.y << 16), __builtin_bit_cast(float, xb.y & 0xffff0000u)};
                        x1 = (f32x4){__builtin_bit_cast(float, xb.z << 16), __builtin_bit_cast(float, xb.z & 0xffff0000u), __builtin_bit_cast(float, xb.w << 16), __builtin_bit_cast(float, xb.w & 0xffff0000u)}; }
                    const f32x4 g0 = *(const f32x4*)(g + c), g1 = *(const f32x4*)(g + c + 4);
                    const f32x4 v0 = x0 + g0 * (ag(acc, ai, bj, m, 0) * ascale), v1 = x1 + g1 * (ag(acc, ai, bj, m, 1) * ascale);
                    u32x4 w; w.x = cvt_pk_bf16(v0[0], v0[1]); w.y = cvt_pk_bf16(v0[2], v0[3]); w.z = cvt_pk_bf16(v1[0], v1[1]); w.w = cvt_pk_bf16(v1[2], v1[3]);
                    *(u32x4*)(dst + ro + c) = w; } }
    }
};

__device__ __forceinline__ float swiglu1(float g, float up) {
    g = fminf(g, 7.0f); up = fminf(fmaxf(up, -7.0f), 7.0f);
    return (up + 1.0f) * g * __builtin_amdgcn_rcpf(1.0f + __expf(-1.702f * g));
}
struct EpiSwiglu {
    static constexpr bool PERM = true, AFTER_DRAIN = false;
    unsigned char* act; const float* bgu; float ascale;
    template <class AccT> __device__ __forceinline__ void operator()(const AccT& acc, const Unit& u, int wr, int wc, int fr, int fq) const {
        const int e = u.pn >> 3, ct = u.pn & 7; const int lc0 = ct * BM + wc * 32 + 8 * fq; const int row0 = u.pm * BM + wr * 64 + fr;
#pragma unroll
        for (int bj = 0; bj < 2; ++bj) { const int lc = lc0 + bj * HALF;
            const f32x4 b0 = *(const f32x4*)(bgu + e * 2048 + lc), b1 = *(const f32x4*)(bgu + e * 2048 + lc + 4);
#pragma unroll
            for (int ai = 0; ai < 2; ++ai) { unsigned w[4];
#pragma unroll
                for (int m = 0; m < 4; ++m) { const f32x4 v0 = ag(acc, ai, bj, m, 0) * ascale + b0, v1 = ag(acc, ai, bj, m, 1) * ascale + b1;
                    int x = 0; x = __builtin_amdgcn_cvt_pk_fp8_f32(swiglu1(v0[0], v0[1]), swiglu1(v0[2], v0[3]), x, false); x = __builtin_amdgcn_cvt_pk_fp8_f32(swiglu1(v1[0], v1[1]), swiglu1(v1[2], v1[3]), x, true);
                    w[m] = (unsigned)x; }
                const auto p02 = __builtin_amdgcn_permlane32_swap(w[0], w[2], false, false), p13 = __builtin_amdgcn_permlane32_swap(w[1], w[3], false, false);
                const auto q01 = __builtin_amdgcn_permlane16_swap(p02[0], p13[0], false, false), q23 = __builtin_amdgcn_permlane16_swap(p02[1], p13[1], false, false);
                *(u32x4*)(act + (size_t)(row0 + ai * HALF + fq * 16) * 1024 + ct * HALF + wc * 16 + bj * 64) = (u32x4){q01[0], q01[1], q23[0], q23[1]}; } }
    }
};

struct LatentOrder {
    StaticOrder so;
    __device__ void init(int N, int G_, int c_) { so.init(128 * BM, N, G_, c_); }
    __device__ bool next(int i, Unit& u) const { if (!so.next(i, u)) return false; u.pm = (u.pm >> 5) * 33 + (u.pm & 31); return true; }
    __device__ __forceinline__ void a_ready(const Unit&) const {}
    __device__ __forceinline__ void done(const Unit&) const {}
};
struct MoeOrder {
    const PG8_LAS int* tstart; int sh, G, c;
    __device__ bool next(int i, Unit& u) const {
        const int NT = tstart[32]; int rt, ct;
        if ((G & 7) == 0) { const int x = c & 7, q = c >> 3, nq = G >> 3; const int uu = i * nq + q; const int per = (NT + 7) >> 3, rl = uu >> sh; if (rl >= per) return false; rt = x * per + rl; ct = uu & ((1 << sh) - 1); }
        else { const long L = (long)i * G + c; rt = (int)(L >> sh); ct = (int)(L & ((1 << sh) - 1)); }
        if (rt >= NT) return false;
        const int e = tstart[64 + rt];
        u.pm = rt; u.pn = (e << sh) + ct; return true;
    }
    __device__ __forceinline__ void a_ready(const Unit&) const {}
    __device__ __forceinline__ void done(const Unit&) const {}
};

typedef int v8i32 __attribute__((ext_vector_type(8)));
__device__ __forceinline__ v8i32 cat8(bf16x8 lo, bf16x8 hi) { typedef int v4i32 __attribute__((ext_vector_type(4))); const v4i32 a = __builtin_bit_cast(v4i32, lo), b = __builtin_bit_cast(v4i32, hi); return (v8i32){a[0], a[1], a[2], a[3], b[0], b[1], b[2], b[3]}; }
template <class Epi, class Sched, bool ALIGN_EPI = false, bool SP2 = false, bool FP8 = false>
__device__ __forceinline__ void gemm_phase(PG8_LAS unsigned char* lds, const Gemm g, const Sched& S, const Epi& E) {
    const int tid = threadIdx.x, wid = __builtin_amdgcn_readfirstlane(tid >> 6), lane = tid & 63, wr = wid >> 2, wc = wid & 3, fr = lane & 15, fq = lane >> 4;
    const int K = g.K, nt = K / BK;
    unsigned voffA[2], voffB[2];
#pragma unroll
    for (int i = 0; i < 2; ++i) { int R, C; stage_rc(tid * 16 + i * 8192, R, C); const int Rb = Epi::PERM ? ((R & ~31) + perm32(R & 31)) : R;
        voffA[i] = (unsigned)(R * K + C) * 2u; voffB[i] = (unsigned)(Rb * K + C) * 2u; }
    const size_t kstep = (size_t)(BK * 2);
    const size_t hstep = (size_t)HALF * K * 2;
    const size_t tstep = 2 * hstep;
    const unsigned ldsw = (unsigned)wid * 1024u;
    const int aoff = lds_byte(wr * 64 + fr, fq * (FP8 ? 16 : 8)), boff = lds_byte(wc * 32 + fr, fq * (FP8 ? 16 : 8));
    const int h0off = (fq & 1) * 16, h1off = 16 - h0off;
#define PG8_SA(b, h) (((b) * 2 + (h)) * HTB)
#define PG8_SB(b, h) ((4 + (b) * 2 + (h)) * HTB)
#define PG8_STAGE(bufoff, gbase, voff) do { _Pragma("unroll") for (int _i = 0; _i < 2; ++_i) \
        __builtin_amdgcn_global_load_lds((const unsigned*)((const char*)(gbase) + (voff)[_i]), (PG8_LAS unsigned*)(lds + (bufoff) + ldsw + _i * 8192), 16, 0, 0); } while (0)
#define PG8_LDA(dst, b, h) do { if constexpr (FP8) { _Pragma("unroll") for (int m = 0; m < 4; ++m) dst##8[m] = cat8(*(const PG8_LAS bf16x8*)(lds + PG8_SA(b, h) + aoff + m * 2048 + h0off), *(const PG8_LAS bf16x8*)(lds + PG8_SA(b, h) + aoff + m * 2048 + h1off)); } else { \
        _Pragma("unroll") for (int m = 0; m < 4; ++m) _Pragma("unroll") for (int k = 0; k < 2; ++k) dst[m][k] = *(const PG8_LAS bf16x8*)(lds + PG8_SA(b, h) + aoff + m * 2048 + k * 1024); } } while (0)
#define PG8_LDB(dst, b, h) do { if constexpr (FP8) { _Pragma("unroll") for (int n = 0; n < 2; ++n) dst##8[n] = cat8(*(const PG8_LAS bf16x8*)(lds + PG8_SB(b, h) + boff + n * 2048 + h0off), *(const PG8_LAS bf16x8*)(lds + PG8_SB(b, h) + boff + n * 2048 + h1off)); } else { \
        _Pragma("unroll") for (int n = 0; n < 2; ++n) _Pragma("unroll") for (int k = 0; k < 2; ++k) dst[n][k] = *(const PG8_LAS bf16x8*)(lds + PG8_SB(b, h) + boff + n * 2048 + k * 1024); } } while (0)
#define PG8_MMA(ai, bj, At, Bt) do { __builtin_amdgcn_s_setprio(1); if constexpr (FP8) { _Pragma("unroll") for (int m = 0; m < 4; ++m) _Pragma("unroll") for (int n = 0; n < 2; ++n) \
        asm volatile("v_mfma_scale_f32_16x16x128_f8f6f4 %0, %1, %2, %0, %3, %3 op_sel_hi:[0,0,0]" : "+v"(acc[ai][bj][m][n]) : "v"(Bt##8[n]), "v"(At##8[m]), "v"(sc1_)); } else { \
        _Pragma("unroll") for (int m = 0; m < 4; ++m) _Pragma("unroll") for (int n = 0; n < 2; ++n) _Pragma("unroll") for (int k = 0; k < 2; ++k) \
        acc[ai][bj][m][n] = __builtin_amdgcn_mfma_f32_16x16x32_bf16(Bt[n][k], At[m][k], acc[ai][bj][m][n], 0, 0, 0); } __builtin_amdgcn_s_setprio(0); } while (0)
#define PG8_WAIT_V(n) asm volatile("s_waitcnt vmcnt(" #n ")" ::: "memory")
#define PG8_WAIT_L(n) asm volatile("s_waitcnt lgkmcnt(" #n ")" ::: "memory")
#define PG8_BAR __builtin_amdgcn_s_barrier()
#define PG8_SCHED __builtin_amdgcn_sched_barrier(0)
    Unit cur, nxt; int ui = 0;
    if (!S.next(0, cur)) return;
    f32x4 acc[2][2][4][2];
#pragma unroll
    for (int a = 0; a < 2; ++a)
#pragma unroll
        for (int b = 0; b < 2; ++b)
#pragma unroll
            for (int m = 0; m < 4; ++m)
#pragma unroll
                for (int n = 0; n < 2; ++n) acc[a][b][m][n] = (f32x4){0.f, 0.f, 0.f, 0.f};
    bf16x8 At[4][2], B0[2][2], B1[2][2];
    v8i32 At8[4], B08[2], B18[2];
    typedef float f32x8 __attribute__((ext_vector_type(8)));
    f32x8 acc8[2][2][4];
#define PG8_ZERO8() do { _Pragma("unroll") for (int a = 0; a < 2; ++a) _Pragma("unroll") for (int b = 0; b < 2; ++b) _Pragma("unroll") for (int m = 0; m < 4; ++m) acc8[a][b][m] = (f32x8){0.f, 0.f, 0.f, 0.f, 0.f, 0.f, 0.f, 0.f}; } while (0)
#define PG8_ACC8TO4() do { if constexpr (FP8) { _Pragma("unroll") for (int a = 0; a < 2; ++a) _Pragma("unroll") for (int b = 0; b < 2; ++b) _Pragma("unroll") for (int m = 0; m < 4; ++m) { \
        acc[a][b][m][0] = __builtin_shufflevector(acc8[a][b][m], acc8[a][b][m], 0, 1, 2, 3); acc[a][b][m][1] = __builtin_shufflevector(acc8[a][b][m], acc8[a][b][m], 4, 5, 6, 7); } PG8_ZERO8(); } } while (0)
    const int sc1_ = 0x7f7f7f7f;
    const char* cA = (const char*)g.A + (size_t)cur.pm * tstep; const char* cB = (const char*)g.Bt + (size_t)cur.pn * tstep;
    S.a_ready(cur);
    if constexpr (SP2) {
        PG8_STAGE(PG8_SB(0, 0), cB, voffB); PG8_STAGE(PG8_SB(0, 1), cB + hstep, voffB); PG8_STAGE(PG8_SA(0, 0), cA, voffA); PG8_STAGE(PG8_SA(0, 1), cA + hstep, voffA);
        if (wr == 1) PG8_BAR;
        PG8_WAIT_V(2); PG8_BAR;
        PG8_STAGE(PG8_SB(1, 0), cB + kstep, voffB); PG8_STAGE(PG8_SA(1, 0), cA + kstep, voffA); PG8_STAGE(PG8_SB(1, 1), cB + hstep + kstep, voffB);
        PG8_WAIT_V(6); PG8_BAR;
    } else {
        PG8_STAGE(PG8_SB(0, 0), cB, voffB); PG8_STAGE(PG8_SA(0, 0), cA, voffA); PG8_STAGE(PG8_SB(0, 1), cB + hstep, voffB); PG8_STAGE(PG8_SA(0, 1), cA + hstep, voffA);
        if (wr == 1) PG8_BAR;
        PG8_WAIT_V(4); PG8_BAR;
        PG8_STAGE(PG8_SB(1, 0), cB + kstep, voffB); PG8_STAGE(PG8_SA(1, 0), cA + kstep, voffA); PG8_STAGE(PG8_SB(1, 1), cB + hstep + kstep, voffB);
        PG8_WAIT_V(6); PG8_BAR;
    }
    for (;;) {
        const bool has_next = S.next(ui + 1, nxt);
        const char* nA = has_next ? (const char*)g.A + (size_t)nxt.pm * tstep : cA; const char* nB = has_next ? (const char*)g.Bt + (size_t)nxt.pn * tstep : cB;
        for (int t = 0; t < nt; t += 2) {
            const bool last = (t == nt - 2);
            const char* a1 = cA + (size_t)(t + 1) * kstep;
            const char* a2 = last ? nA : cA + (size_t)(t + 2) * kstep; const char* b2 = last ? nB : cB + (size_t)(t + 2) * kstep;
            const char* a3 = a2 + kstep; const char* b3 = b2 + kstep;
            if (last && has_next) S.a_ready(nxt);
            if constexpr (SP2) {
            PG8_LDB(B0, 0, 0); PG8_LDB(B1, 0, 1); PG8_SCHED; PG8_LDA(At, 0, 0); PG8_STAGE(PG8_SA(1, 1), a1 + hstep, voffA);
            PG8_WAIT_V(8); PG8_WAIT_L(0); PG8_BAR; PG8_MMA(0, 0, At, B0); PG8_MMA(0, 1, At, B1); PG8_BAR; PG8_SCHED;
            PG8_LDA(At, 0, 1); PG8_STAGE(PG8_SB(0, 0), b2, voffB); PG8_STAGE(PG8_SB(0, 1), b2 + hstep, voffB); PG8_STAGE(PG8_SA(0, 0), a2, voffA);
            PG8_WAIT_V(8); PG8_WAIT_L(0); PG8_BAR; PG8_MMA(1, 0, At, B0); PG8_MMA(1, 1, At, B1); PG8_BAR; PG8_SCHED;
            PG8_LDB(B0, 1, 0); PG8_LDB(B1, 1, 1); PG8_SCHED; PG8_LDA(At, 1, 0); PG8_STAGE(PG8_SA(0, 1), a2 + hstep, voffA);
            PG8_WAIT_V(8); PG8_WAIT_L(0); PG8_BAR; PG8_MMA(0, 0, At, B0); PG8_MMA(0, 1, At, B1); PG8_BAR; PG8_SCHED;
            PG8_LDA(At, 1, 1); PG8_STAGE(PG8_SB(1, 0), b3, voffB); PG8_STAGE(PG8_SB(1, 1), b3 + hstep, voffB); PG8_STAGE(PG8_SA(1, 0), a3, voffA);
            PG8_WAIT_V(8); PG8_WAIT_L(0); PG8_BAR; PG8_MMA(1, 0, At, B0); PG8_MMA(1, 1, At, B1); PG8_BAR; PG8_SCHED;
            } else {
            PG8_LDB(B0, 0, 0); PG8_SCHED; PG8_LDA(At, 0, 0); PG8_STAGE(PG8_SA(1, 1), a1 + hstep, voffA);
            PG8_WAIT_L(8); PG8_BAR; PG8_WAIT_L(0); PG8_MMA(0, 0, At, B0); PG8_BAR; PG8_SCHED;
            PG8_LDB(B1, 0, 1); PG8_STAGE(PG8_SB(0, 0), b2, voffB);
            PG8_BAR; PG8_WAIT_L(0); PG8_MMA(0, 1, At, B1); PG8_BAR;
            PG8_LDA(At, 0, 1); PG8_STAGE(PG8_SA(0, 0), a2, voffA);
            PG8_BAR; PG8_WAIT_L(0); PG8_MMA(1, 0, At, B0); PG8_BAR; PG8_SCHED;
            PG8_STAGE(PG8_SB(0, 1), b2 + hstep, voffB);
            PG8_WAIT_V(6); PG8_BAR; PG8_MMA(1, 1, At, B1); PG8_BAR;
            PG8_LDB(B0, 1, 0); PG8_SCHED; PG8_LDA(At, 1, 0); PG8_STAGE(PG8_SA(0, 1), a2 + hstep, voffA);
            PG8_WAIT_L(8); PG8_BAR; PG8_WAIT_L(0); PG8_MMA(0, 0, At, B0); PG8_BAR; PG8_SCHED;
            PG8_LDB(B1, 1, 1); PG8_STAGE(PG8_SB(1, 0), b3, voffB);
            PG8_BAR; PG8_WAIT_L(0); PG8_MMA(0, 1, At, B1); PG8_BAR;
            PG8_LDA(At, 1, 1); PG8_STAGE(PG8_SA(1, 0), a3, voffA);
            PG8_BAR; PG8_WAIT_L(0); PG8_MMA(1, 0, At, B0); PG8_BAR; PG8_SCHED;
            PG8_STAGE(PG8_SB(1, 1), b3 + hstep, voffB);
            PG8_WAIT_V(6); PG8_BAR; PG8_MMA(1, 1, At, B1); PG8_BAR;
            }
        }
        if constexpr (ALIGN_EPI) { if (wr == 0) PG8_BAR; }
        if constexpr (!Epi::AFTER_DRAIN) { if constexpr (FP8) asm volatile("s_nop 15\n\ts_nop 15" ::: "memory"); E(acc, cur, wr, wc, fr, fq); S.done(cur); }
        if (!has_next) break;
#pragma unroll
        for (int a = 0; a < 2; ++a)
#pragma unroll
            for (int b = 0; b < 2; ++b)
#pragma unroll
                for (int m = 0; m < 4; ++m)
#pragma unroll
                    for (int n = 0; n < 2; ++n) acc[a][b][m][n] = (f32x4){0.f, 0.f, 0.f, 0.f};
        cur = nxt; cA = nA; cB = nB; ++ui;
        if constexpr (ALIGN_EPI) { if (wr == 1) PG8_BAR; }
    }
    PG8_WAIT_V(0);
    if constexpr (!ALIGN_EPI) { if (wr == 0) PG8_BAR; }
    PG8_BAR;
    if constexpr (Epi::AFTER_DRAIN) { E.fused(acc, cur, wr, wc, fr, fq, lds, wid, lane); S.done(cur); }
#undef PG8_ZERO8
#undef PG8_ACC8TO4
#undef PG8_SA
#undef PG8_SB
#undef PG8_STAGE
#undef PG8_LDA
#undef PG8_LDB
#undef PG8_MMA
#undef PG8_WAIT_V
#undef PG8_WAIT_L
#undef PG8_BAR
#undef PG8_SCHED
}

template <class Epi, class Sched, bool FP8 = false>
__device__ __forceinline__ void gemm_phase_gather(PG8_LAS unsigned char* lds, const Gemm g, const int* rowidx, const Sched& S, const Epi& E) {
    const int tid = threadIdx.x, wid = __builtin_amdgcn_readfirstlane(tid >> 6), lane = tid & 63, wr = wid >> 2, wc = wid & 3, fr = lane & 15, fq = lane >> 4;
    const int K = g.K, nt = K / BK;
    int RA[2]; unsigned CA2[2], voffB[2];
#pragma unroll
    for (int i = 0; i < 2; ++i) { int R, C; stage_rc(tid * 16 + i * 8192, R, C); const int Rb = Epi::PERM ? ((R & ~31) + perm32(R & 31)) : R;
        RA[i] = R; CA2[i] = (unsigned)C * 2u; voffB[i] = (unsigned)(Rb * K + C) * 2u; }
    const size_t kstep = (size_t)(BK * 2);
    const size_t hstep = (size_t)HALF * K * 2;
    const size_t tstep = 2 * hstep;
    const unsigned ldsw = (unsigned)wid * 1024u;
    const unsigned rowb = (unsigned)K * 2u;
    const int aoff = lds_byte(wr * 64 + fr, fq * (FP8 ? 16 : 8)), boff = lds_byte(wc * 32 + fr, fq * (FP8 ? 16 : 8));
    const int h0off = (fq & 1) * 16, h1off = 16 - h0off;
#define PG8_SA(b, h) (((b) * 2 + (h)) * HTB)
#define PG8_SB(b, h) ((4 + (b) * 2 + (h)) * HTB)
#define PG8_STAGE(bufoff, gbase, voff) do { _Pragma("unroll") for (int _i = 0; _i < 2; ++_i) \
        __builtin_amdgcn_global_load_lds((const unsigned*)((const char*)(gbase) + (voff)[_i]), (PG8_LAS unsigned*)(lds + (bufoff) + ldsw + _i * 8192), 16, 0, 0); } while (0)
#define PG8_STAGEA(bufoff, offs, kb) do { _Pragma("unroll") for (int _i = 0; _i < 2; ++_i) \
        __builtin_amdgcn_global_load_lds((const unsigned*)((const char*)g.A + (size_t)(offs)[_i] + (size_t)(kb)), (PG8_LAS unsigned*)(lds + (bufoff) + ldsw + _i * 8192), 16, 0, 0); } while (0)
#define PG8_GIDX(d0, d1, pm_) do { _Pragma("unroll") for (int _i = 0; _i < 2; ++_i) { const int r0_ = rowidx[(size_t)(pm_) * BM + RA[_i]], r1_ = rowidx[(size_t)(pm_) * BM + HALF + RA[_i]]; \
        d0[_i] = (unsigned)r0_ * rowb + CA2[_i]; d1[_i] = (unsigned)r1_ * rowb + CA2[_i]; } } while (0)
#define PG8_LDA(dst, b, h) do { if constexpr (FP8) { _Pragma("unroll") for (int m = 0; m < 4; ++m) dst##8[m] = cat8(*(const PG8_LAS bf16x8*)(lds + PG8_SA(b, h) + aoff + m * 2048 + h0off), *(const PG8_LAS bf16x8*)(lds + PG8_SA(b, h) + aoff + m * 2048 + h1off)); } else { \
        _Pragma("unroll") for (int m = 0; m < 4; ++m) _Pragma("unroll") for (int k = 0; k < 2; ++k) dst[m][k] = *(const PG8_LAS bf16x8*)(lds + PG8_SA(b, h) + aoff + m * 2048 + k * 1024); } } while (0)
#define PG8_LDB(dst, b, h) do { if constexpr (FP8) { _Pragma("unroll") for (int n = 0; n < 2; ++n) dst##8[n] = cat8(*(const PG8_LAS bf16x8*)(lds + PG8_SB(b, h) + boff + n * 2048 + h0off), *(const PG8_LAS bf16x8*)(lds + PG8_SB(b, h) + boff + n * 2048 + h1off)); } else { \
        _Pragma("unroll") for (int n = 0; n < 2; ++n) _Pragma("unroll") for (int k = 0; k < 2; ++k) dst[n][k] = *(const PG8_LAS bf16x8*)(lds + PG8_SB(b, h) + boff + n * 2048 + k * 1024); } } while (0)
#define PG8_MMA(ai, bj, At, Bt) do { __builtin_amdgcn_s_setprio(1); if constexpr (FP8) { _Pragma("unroll") for (int m = 0; m < 4; ++m) _Pragma("unroll") for (int n = 0; n < 2; ++n) \
        asm volatile("v_mfma_scale_f32_16x16x128_f8f6f4 %0, %1, %2, %0, %3, %3 op_sel_hi:[0,0,0]" : "+v"(acc[ai][bj][m][n]) : "v"(Bt##8[n]), "v"(At##8[m]), "v"(sc1_)); } else { \
        _Pragma("unroll") for (int m = 0; m < 4; ++m) _Pragma("unroll") for (int n = 0; n < 2; ++n) _Pragma("unroll") for (int k = 0; k < 2; ++k) \
        acc[ai][bj][m][n] = __builtin_amdgcn_mfma_f32_16x16x32_bf16(Bt[n][k], At[m][k], acc[ai][bj][m][n], 0, 0, 0); } __builtin_amdgcn_s_setprio(0); } while (0)
#define PG8_WAIT_V(n) asm volatile("s_waitcnt vmcnt(" #n ")" ::: "memory")
#define PG8_WAIT_L(n) asm volatile("s_waitcnt lgkmcnt(" #n ")" ::: "memory")
#define PG8_BAR __builtin_amdgcn_s_barrier()
#define PG8_SCHED __builtin_amdgcn_sched_barrier(0)
    Unit cur, nxt; int ui = 0;
    if (!S.next(0, cur)) return;
    f32x4 acc[2][2][4][2];
#pragma unroll
    for (int a = 0; a < 2; ++a)
#pragma unroll
        for (int b = 0; b < 2; ++b)
#pragma unroll
            for (int m = 0; m < 4; ++m)
#pragma unroll
                for (int n = 0; n < 2; ++n) acc[a][b][m][n] = (f32x4){0.f, 0.f, 0.f, 0.f};
    bf16x8 At[4][2], B0[2][2], B1[2][2];
    v8i32 At8[4], B08[2], B18[2];
    typedef float f32x8 __attribute__((ext_vector_type(8)));
    f32x8 acc8[2][2][4];
#define PG8_ZERO8() do { _Pragma("unroll") for (int a = 0; a < 2; ++a) _Pragma("unroll") for (int b = 0; b < 2; ++b) _Pragma("unroll") for (int m = 0; m < 4; ++m) acc8[a][b][m] = (f32x8){0.f, 0.f, 0.f, 0.f, 0.f, 0.f, 0.f, 0.f}; } while (0)
#define PG8_ACC8TO4() do { if constexpr (FP8) { _Pragma("unroll") for (int a = 0; a < 2; ++a) _Pragma("unroll") for (int b = 0; b < 2; ++b) _Pragma("unroll") for (int m = 0; m < 4; ++m) { \
        acc[a][b][m][0] = __builtin_shufflevector(acc8[a][b][m], acc8[a][b][m], 0, 1, 2, 3); acc[a][b][m][1] = __builtin_shufflevector(acc8[a][b][m], acc8[a][b][m], 4, 5, 6, 7); } PG8_ZERO8(); } } while (0)
    const int sc1_ = 0x7f7f7f7f;
    unsigned ga0[2], ga1[2], gn0[2], gn1[2];
    PG8_GIDX(ga0, ga1, cur.pm);
    const char* cB = (const char*)g.Bt + (size_t)cur.pn * tstep;
    S.a_ready(cur);
    PG8_STAGE(PG8_SB(0, 0), cB, voffB); PG8_STAGE(PG8_SB(0, 1), cB + hstep, voffB); PG8_STAGEA(PG8_SA(0, 0), ga0, 0); PG8_STAGEA(PG8_SA(0, 1), ga1, 0);
    if (wr == 1) PG8_BAR;
    PG8_WAIT_V(2); PG8_BAR;
    PG8_STAGE(PG8_SB(1, 0), cB + kstep, voffB); PG8_STAGEA(PG8_SA(1, 0), ga0, kstep); PG8_STAGE(PG8_SB(1, 1), cB + hstep + kstep, voffB);
    PG8_WAIT_V(6); PG8_BAR;
    for (;;) {
        const bool has_next = S.next(ui + 1, nxt);
        if (has_next) { PG8_GIDX(gn0, gn1, nxt.pm); } else { gn0[0] = ga0[0]; gn0[1] = ga0[1]; gn1[0] = ga1[0]; gn1[1] = ga1[1]; }
        const char* nB = has_next ? (const char*)g.Bt + (size_t)nxt.pn * tstep : cB;
        for (int t = 0; t < nt; t += 2) {
            const bool last = (t == nt - 2);
            const size_t k1 = (size_t)(t + 1) * kstep;
            const size_t k2 = last ? (size_t)0 : (size_t)(t + 2) * kstep;
            unsigned s0[2], s1[2];
            s0[0] = last ? gn0[0] : ga0[0]; s0[1] = last ? gn0[1] : ga0[1]; s1[0] = last ? gn1[0] : ga1[0]; s1[1] = last ? gn1[1] : ga1[1];
            const char* b2 = last ? nB : cB + (size_t)(t + 2) * kstep;
            const char* b3 = b2 + kstep;
            if (last && has_next) S.a_ready(nxt);
            PG8_LDB(B0, 0, 0); PG8_LDB(B1, 0, 1); PG8_SCHED; PG8_LDA(At, 0, 0); PG8_STAGEA(PG8_SA(1, 1), ga1, k1);
            PG8_WAIT_V(8); PG8_WAIT_L(0); PG8_BAR; PG8_MMA(0, 0, At, B0); PG8_MMA(0, 1, At, B1); PG8_BAR; PG8_SCHED;
            PG8_LDA(At, 0, 1); PG8_STAGE(PG8_SB(0, 0), b2, voffB); PG8_STAGE(PG8_SB(0, 1), b2 + hstep, voffB); PG8_STAGEA(PG8_SA(0, 0), s0, k2);
            PG8_WAIT_V(8); PG8_WAIT_L(0); PG8_BAR; PG8_MMA(1, 0, At, B0); PG8_MMA(1, 1, At, B1); PG8_BAR; PG8_SCHED;
            PG8_LDB(B0, 1, 0); PG8_LDB(B1, 1, 1); PG8_SCHED; PG8_LDA(At, 1, 0); PG8_STAGEA(PG8_SA(0, 1), s1, k2);
            PG8_WAIT_V(8); PG8_WAIT_L(0); PG8_BAR; PG8_MMA(0, 0, At, B0); PG8_MMA(0, 1, At, B1); PG8_BAR; PG8_SCHED;
            PG8_LDA(At, 1, 1); PG8_STAGE(PG8_SB(1, 0), b3, voffB); PG8_STAGE(PG8_SB(1, 1), b3 + hstep, voffB); PG8_STAGEA(PG8_SA(1, 0), s0, k2 + kstep);
            PG8_WAIT_V(8); PG8_WAIT_L(0); PG8_BAR; PG8_MMA(1, 0, At, B0); PG8_MMA(1, 1, At, B1); PG8_BAR; PG8_SCHED;
        }
        if (wr == 0) PG8_BAR;
        if constexpr (FP8) asm volatile("s_nop 15\n\ts_nop 15" ::: "memory"); E(acc, cur, wr, wc, fr, fq); S.done(cur);
        if (!has_next) break;
#pragma unroll
        for (int a = 0; a < 2; ++a)
#pragma unroll
            for (int b = 0; b < 2; ++b)
#pragma unroll
                for (int m = 0; m < 4; ++m)
#pragma unroll
                    for (int n = 0; n < 2; ++n) acc[a][b][m][n] = (f32x4){0.f, 0.f, 0.f, 0.f};
        cur = nxt; cB = nB; ga0[0] = gn0[0]; ga0[1] = gn0[1]; ga1[0] = gn1[0]; ga1[1] = gn1[1]; ++ui;
        if (wr == 1) PG8_BAR;
    }
    PG8_WAIT_V(0);
    PG8_BAR;
#undef PG8_ZERO8
#undef PG8_ACC8TO4
#undef PG8_SA
#undef PG8_SB
#undef PG8_STAGE
#undef PG8_STAGEA
#undef PG8_GIDX
#undef PG8_LDA
#undef PG8_LDB
#undef PG8_MMA
#undef PG8_WAIT_V
#undef PG8_WAIT_L
#undef PG8_BAR
#undef PG8_SCHED
}
}
#define XB_TMO      128
#define XB_XCNT(j)  (256  + 64 * (j))
#define XB_XSUB(j)  (1280 + 64 * (j))
#define XB_XGEN(j)  (2304 + 64 * (j))
#define XB_TOP      3328
#define XB_TOPGEN   3392
#define XCD_BAR_WORDS 3456
#define XB_SPIN_CAP (1u << 18)

__device__ __forceinline__ unsigned xb_ld(unsigned* p)              { return __hip_atomic_load(p, __ATOMIC_RELAXED, __HIP_MEMORY_SCOPE_AGENT); }
__device__ __forceinline__ unsigned xb_add(unsigned* p, unsigned v) { return __hip_atomic_fetch_add(p, v, __ATOMIC_RELAXED, __HIP_MEMORY_SCOPE_AGENT); }
__device__ __forceinline__ unsigned xb_xcc_id() { return (unsigned)__builtin_amdgcn_s_getreg((3 << 11) | 20) & 0xFu; }
#define XB_SPIN(cond, bar) do { unsigned _sp = 0; while (cond) { __builtin_amdgcn_s_sleep(1); \
    if ((++_sp & 255u) == 0u) { if (xb_ld(&(bar)[XB_TMO])) break; if (_sp > XB_SPIN_CAP) { atomicAdd(&(bar)[XB_TMO], 1u); break; } } } } while (0)

struct XcdBarrier {
    unsigned* bar; unsigned x;
    volatile LAS unsigned* st;
};

__device__ __forceinline__ XcdBarrier xcd_barrier_post(unsigned* bar, volatile LAS unsigned* st) {
    XcdBarrier b; b.bar = bar; b.x = xb_xcc_id(); b.st = st;
    if (threadIdx.x == 0) (void)xb_add(&bar[XB_XCNT(b.x)], 1u);
    return b;
}
__device__ __forceinline__ void xcd_barrier_complete(unsigned* bar, unsigned x, unsigned& nloc, unsigned& nx) {
    const unsigned G = gridDim.x * gridDim.y * gridDim.z;
    unsigned sum, cnt, mine, sp = 0u;
    for (;;) {
        sum = 0u; cnt = 0u; mine = 0u;
#pragma unroll
        for (unsigned j = 0; j < 16; ++j) { const unsigned c = xb_ld(&bar[XB_XCNT(j)]); sum += c; cnt += (c > 0u) ? 1u : 0u; mine = (j == x) ? c : mine; }
        if (sum == G) break;
        __builtin_amdgcn_s_sleep(1);
        if ((++sp & 255u) == 0u) { if (xb_ld(&bar[XB_TMO])) break; if (sp > XB_SPIN_CAP) { atomicAdd(&bar[XB_TMO], 1u); break; } }
    }
    nloc = mine > 0u ? mine : 1u; nx = cnt > 0u ? cnt : 1u;
}

__device__ __forceinline__ void xcd_barrier(const XcdBarrier& b) {
    asm volatile("s_waitcnt vmcnt(0)" ::: "memory");
    __syncthreads();
    if (threadIdx.x == 0) {
        unsigned* bar = b.bar;
        __builtin_amdgcn_s_waitcnt(0);
        unsigned nloc = b.st[0], nx = b.st[1];
        if (nloc == 0u) { xcd_barrier_complete(bar, b.x, nloc, nx); b.st[0] = nloc; b.st[1] = nx; }
        const unsigned old = xb_add(&bar[XB_XSUB(b.x)], 1u);
        const unsigned gen = old / nloc;
        if (old + 1u == (gen + 1u) * nloc) {
            __builtin_amdgcn_fence(__ATOMIC_RELEASE, "agent");
            asm volatile("s_waitcnt vmcnt(0)" ::: "memory");
            const unsigned og = xb_add(&bar[XB_TOP], 1u);
            const unsigned tg = og / nx;
            if (og + 1u == (tg + 1u) * nx) xb_add(&bar[XB_TOPGEN], 1u);
            else XB_SPIN(xb_ld(&bar[XB_TOPGEN]) == tg, bar);
            __builtin_amdgcn_fence(__ATOMIC_ACQUIRE, "agent");
            xb_add(&bar[XB_XGEN(b.x)], 1u);
            asm volatile("s_waitcnt vmcnt(0)" ::: "memory");
        } else {
            XB_SPIN(xb_ld(&bar[XB_XGEN(b.x)]) == gen, bar);
            __builtin_amdgcn_fence(__ATOMIC_ACQUIRE, "agent");
            asm volatile("s_waitcnt vmcnt(0)" ::: "memory");
        }
    }
    __syncthreads();
}

struct Ctx {
    LAS unsigned char* lds; unsigned char* ws; int tid, lane, wave, G, blk;
};
__device__ __forceinline__ int tok2row(int tok, bool latent_only) { return latent_only ? (tok >> 13) * TPB + (tok & 8191) : tok; }

__device__ __forceinline__ void p0_transpose_item(const float* W, int K, int N, bf16* WT, int row_off, LAS float* scr, int item, int lane) {
    const int nblk = N / 32, kb = item / nblk, nb = item % nblk, k0 = 64 * kb, n0 = 32 * nb;
#pragma unroll 8
    for (int i = 0; i < 32; ++i) { const int kk = 2 * i + (lane >> 5); scr[kk * 33 + (lane & 31)] = W[(size_t)(k0 + kk) * N + n0 + (lane & 31)]; }
    LDS_WAIT(); asm volatile("" ::: "memory");
    const int c = lane & 7;
#pragma unroll
    for (int j = 0; j < 4; ++j) { const int n = (lane >> 3) + 8 * j; const LAS float* s = scr + (8 * c) * 33 + n;
        v4u o; o.x = pk2(s[0 * 33], s[1 * 33]); o.y = pk2(s[2 * 33], s[3 * 33]); o.z = pk2(s[4 * 33], s[5 * 33]); o.w = pk2(s[6 * 33], s[7 * 33]);
        *(GAS v4u*)(WT + (size_t)(row_off + n0 + n) * K + k0 + 8 * c) = o; }
    LDS_WAIT(); asm volatile("" ::: "memory");
}

__device__ __forceinline__ void p0_transpose_item8(const float* W, int K, int N, unsigned char* WT, int row_off, LAS float* scr, int item, int lane) {
    const int nblk = N / 32, kb = item / nblk, nb = item % nblk, k0 = 64 * kb, n0 = 32 * nb;
#pragma unroll 8
    for (int i = 0; i < 32; ++i) { const int kk = 2 * i + (lane >> 5); scr[kk * 33 + (lane & 31)] = W[(size_t)(k0 + kk) * N + n0 + (lane & 31)]; }
    LDS_WAIT(); asm volatile("" ::: "memory");
    const int c = lane & 3;
#pragma unroll
    for (int j = 0; j < 2; ++j) { const int n = (lane >> 2) + 16 * j; const LAS float* s = scr + (16 * c) * 33 + n;
        int w[4];
#pragma unroll
        for (int q = 0; q < 4; ++q) { int x = 0; x = __builtin_amdgcn_cvt_pk_fp8_f32(32.0f * s[(4 * q) * 33], 32.0f * s[(4 * q + 1) * 33], x, false); x = __builtin_amdgcn_cvt_pk_fp8_f32(32.0f * s[(4 * q + 2) * 33], 32.0f * s[(4 * q + 3) * 33], x, true); w[q] = x; }
        *(GAS v4u*)(WT + (size_t)(row_off + n0 + n) * K + k0 + 16 * c) = (v4u){(unsigned)w[0], (unsigned)w[1], (unsigned)w[2], (unsigned)w[3]}; }
    LDS_WAIT(); asm volatile("" ::: "memory");
}

__device__ __forceinline__ void phase_prologue(const KP& p, const Ctx& F) {
    unsigned char* ws = F.ws;
    if (F.blk < 192) {
        LAS float* sc = (LAS float*)F.lds;
        LAS float* part = (LAS float*)(F.lds + 20480);
        for (int i = F.tid; i < 5120; i += 512) { const int bs = i >> 10, k = i & 1023; const float cv = bs < 4 ? p.c[bs * 1024 + k] : p.c_ctx[k]; sc[i] = cv / (1.0f + expf(-cv)); }
        __syncthreads();
        float* modv = (float*)(ws + WS_MODV);
        for (int u = F.blk; u < 192; u += F.G) {
            const int layer = u / 96, n0 = (u % 96) * 64;
            float a0 = 0.f, a1 = 0.f, a2 = 0.f, a3 = 0.f, a4 = 0.f;
            const float* W = p.mod_w + (size_t)layer * 1024 * 6144 + n0 + F.lane;
#pragma unroll 32
            for (int kk = 0; kk < 128; ++kk) { const int k = F.wave * 128 + kk; const float w = W[(size_t)k * 6144];
                a0 += sc[k] * w; a1 += sc[1024 + k] * w; a2 += sc[2048 + k] * w; a3 += sc[3072 + k] * w; a4 += sc[4096 + k] * w; }
            part[(F.wave * 5 + 0) * 64 + F.lane] = a0; part[(F.wave * 5 + 1) * 64 + F.lane] = a1; part[(F.wave * 5 + 2) * 64 + F.lane] = a2;
            part[(F.wave * 5 + 3) * 64 + F.lane] = a3; part[(F.wave * 5 + 4) * 64 + F.lane] = a4;
            __syncthreads();
            if (F.tid < 320) { const int bs = F.tid >> 6, l = F.tid & 63; float s = 0.f;
#pragma unroll
                for (int w = 0; w < 8; ++w) s += part[(w * 5 + bs) * 64 + l];
                modv[(size_t)(layer * 5 + bs) * 6144 + n0 + l] = s + p.mod_b[layer * 6144 + n0 + l]; }
            __syncthreads();
        }
    }
    __syncthreads();
    const int gt = F.blk * 512 + F.tid, NGT = F.G * 512;
    { float* tc = (float*)(ws + WS_ROPE); float* tsn = tc + 2048;
      for (int i = gt; i < 2048; i += NGT) { const int comp = i >> 4, f = i & 15; const float inv = powf(10000.0f, -(float)f / 16.0f); const float ang = (float)comp * inv; tc[i] = cosf(ang); tsn[i] = sinf(ang); } }
    { bf16* WG = (bf16*)(ws + WS_W_GIN); bf16* WI = (bf16*)(ws + WS_W_IN);
      for (int i = gt; i < 32 * 1024; i += NGT) { const int rr = i >> 10, k = i & 1023; const int dir = rr >> 4, j = rr & 15;
          WG[(size_t)(3072 + rr) * 1024 + k] = (bf16)f2bf(p.gla_w_gate1[((size_t)dir * 1024 + k) * 16 + j]); }
      for (int i = gt; i < 224 * 1024 / 8; i += NGT) *(v4u*)(WG + (size_t)3104 * 1024 + (size_t)i * 8) = (v4u){0u, 0u, 0u, 0u};
      for (int i = gt; i < 192 * 1024 / 16; i += NGT) *(v4u*)((unsigned char*)WI + (size_t)832 * 1024 + (size_t)i * 16) = (v4u){0u, 0u, 0u, 0u}; }
    LAS float* scr = (LAS float*)(F.lds + F.wave * 16384);
    const int gw = F.blk * 8 + F.wave, NGW = F.G * 8;
    constexpr int I_IN = 16 * 26, I_UQ = 8 * 48, I_UKV = 4 * 64, I_O = 16 * 32, I_GIN = 16 * 96, I_GO = 16 * 32, I_GU = 16 * 64, I_DN = 16 * 32;
    constexpr int I_SMALL = I_IN + I_UQ + I_UKV + I_O + I_GIN + I_GO;
    constexpr int NITEMS = I_SMALL + 64 * I_GU + 64 * I_DN;
    for (int it = gw; it < NITEMS; it += NGW) {
        int r = it;
        if (r < I_IN) { p0_transpose_item8(p.mla_w_in, 1024, 832, ws + WS_W_IN, 0, scr, r, F.lane); continue; } r -= I_IN;
        if (r < I_UQ) { p0_transpose_item8(p.mla_w_uq, 512, 1536, ws + WS_W_UQ, 0, scr, r, F.lane); continue; } r -= I_UQ;
        if (r < I_UKV) { p0_transpose_item8(p.mla_w_ukv, 256, 2048, ws + WS_W_UKV, 0, scr, r, F.lane); continue; } r -= I_UKV;
        if (r < I_O) { p0_transpose_item8(p.mla_w_o, 1024, 1024, ws + WS_W_O, 0, scr, r, F.lane); continue; } r -= I_O;
        if (r < I_GIN) { p0_transpose_item(p.gla_w_in, 1024, 3072, (bf16*)(ws + WS_W_GIN), 0, scr, r, F.lane); continue; } r -= I_GIN;
        if (r < I_GO) { p0_transpose_item(p.gla_w_o, 1024, 1024, (bf16*)(ws + WS_W_GO), 0, scr, r, F.lane); continue; } r -= I_GO;
        if (r < 64 * I_GU) { const int mat = r / I_GU, rr = r % I_GU;
            p0_transpose_item8(p.moe_w_gu + (size_t)mat * 1024 * 2048, 1024, 2048, ws + WS_W_GU, mat * 2048, scr, rr, F.lane); continue; } r -= 64 * I_GU;
        { const int mat = r / I_DN, rr = r % I_DN;
            p0_transpose_item8(p.moe_w_down + (size_t)mat * 1024 * 1024, 1024, 1024, ws + WS_W_DN, mat * 1024, scr, rr, F.lane); }
    }
}

__device__ __forceinline__ void norm_mod_store(const f32x4 (&v)[4], const float* gw, const float* scv, const float* shv, bf16* orow, int lane) {
    float ss = 0.f;
#pragma unroll
    for (int j = 0; j < 4; ++j) ss += (v[j].x * v[j].x + v[j].y * v[j].y) + (v[j].z * v[j].z + v[j].w * v[j].w);
    const float rstd = 1.0f / sqrtf(wave_sum(ss) * (1.0f / 1024.0f) + EPS);
#pragma unroll
    for (int j = 0; j < 4; ++j) { const int c = 4 * lane + 256 * j;
        const f32x4 g = *(const f32x4*)(gw + c), sc = *(const f32x4*)(scv + c), sh = *(const f32x4*)(shv + c);
        const f32x4 h = (v[j] * rstd) * g * (sc + 1.0f) + sh;
        v2u o; o.x = pk2(h.x, h.y); o.y = pk2(h.z, h.w); *(v2u*)(orow + c) = o; }
}

__device__ __forceinline__ void norm_mod_store8(const f32x4 (&v)[4], const float* gw, const float* scv, const float* shv, unsigned char* orow, int lane) {
    float ss = 0.f;
#pragma unroll
    for (int j = 0; j < 4; ++j) ss += (v[j].x * v[j].x + v[j].y * v[j].y) + (v[j].z * v[j].z + v[j].w * v[j].w);
    const float rstd = 1.0f / sqrtf(wave_sum(ss) * (1.0f / 1024.0f) + EPS);
#pragma unroll
    for (int j = 0; j < 4; ++j) { const int c = 4 * lane + 256 * j;
        const f32x4 g = *(const f32x4*)(gw + c), sc = *(const f32x4*)(scv + c), sh = *(const f32x4*)(shv + c);
        const f32x4 h = (v[j] * rstd) * g * (sc + 1.0f) + sh;
        int w8 = 0; w8 = __builtin_amdgcn_cvt_pk_fp8_f32(h.x, h.y, w8, false); w8 = __builtin_amdgcn_cvt_pk_fp8_f32(h.z, h.w, w8, true); *(int*)(orow + c) = w8; }
}

__device__ __forceinline__ void phase_norm1_l0(const KP& p, const Ctx& F) {
    const float* modv = (const float*)(F.ws + WS_MODV); unsigned char* H8 = F.ws + WS_H8;
    const int gw = F.blk * 8 + F.wave, NGW = F.G * 8;
    for (int r = gw; r < M; r += NGW) {
        const int b = r / TPB, t = r % TPB; const bool lat = t < SEQ; const int bs = lat ? b : 4;
        const float* xr = lat ? p.x + ((size_t)b * SEQ + t) * 1024 : p.ctx + ((size_t)b * LC + (t - SEQ)) * 1024;
        f32x4 v[4];
#pragma unroll
        for (int j = 0; j < 4; ++j) v[j] = *(const f32x4*)(xr + 4 * F.lane + 256 * j);
        const float* mv = modv + (size_t)bs * 6144;
        norm_mod_store8(v, p.norm1, mv + 1024, mv, H8 + (size_t)r * 1024, F.lane);
    }
}

__device__ __forceinline__ void phase_mla_thin(const KP& p, const Ctx& F) {
    const bf16* A1 = (const bf16*)(F.ws + WS_A1); unsigned char* CQ8 = F.ws + WS_CQ8; unsigned char* CKV8 = F.ws + WS_CKV8; unsigned char* KR8 = F.ws + WS_KR8;
    const float* tc = (const float*)(F.ws + WS_ROPE); const float* tsn = tc + 2048;
    const int gw = F.blk * 8 + F.wave, NGW = F.G * 8, lane = F.lane;
    for (int r = gw; r < M; r += NGW) {
        const bf16* ar = A1 + (size_t)r * 1024; const int t = r % TPB;
        const v4u qa = *(const v4u*)(ar + 8 * lane);
        float q[8] = {bflo(qa.x), bfhi(qa.x), bflo(qa.y), bfhi(qa.y), bflo(qa.z), bfhi(qa.z), bflo(qa.w), bfhi(qa.w)};
        float ss = 0.f;
#pragma unroll
        for (int i = 0; i < 8; ++i) ss += q[i] * q[i];
        const float rq = 1.0f / sqrtf(wave_sum(ss) * (1.0f / 512.0f) + EPS);
        const f32x4 g0 = *(const f32x4*)(p.mla_q_norm + 8 * lane), g1 = *(const f32x4*)(p.mla_q_norm + 8 * lane + 4);
        { int a = 0, b2 = 0; a = __builtin_amdgcn_cvt_pk_fp8_f32(q[0] * rq * g0.x, q[1] * rq * g0.y, a, false); a = __builtin_amdgcn_cvt_pk_fp8_f32(q[2] * rq * g0.z, q[3] * rq * g0.w, a, true);
          b2 = __builtin_amdgcn_cvt_pk_fp8_f32(q[4] * rq * g1.x, q[5] * rq * g1.y, b2, false); b2 = __builtin_amdgcn_cvt_pk_fp8_f32(q[6] * rq * g1.z, q[7] * rq * g1.w, b2, true);
          *(v2u*)(CQ8 + (size_t)r * 512 + 8 * lane) = (v2u){(unsigned)a, (unsigned)b2}; }
        const v2u ka = *(const v2u*)(ar + 512 + 4 * lane);
        const float k0 = bflo(ka.x), k1 = bfhi(ka.x), k2 = bflo(ka.y), k3 = bfhi(ka.y);
        const float rk = 1.0f / sqrtf(wave_sum(k0 * k0 + k1 * k1 + k2 * k2 + k3 * k3) * (1.0f / 256.0f) + EPS);
        const f32x4 gk = *(const f32x4*)(p.mla_kv_norm + 4 * lane);
        { int a = 0; a = __builtin_amdgcn_cvt_pk_fp8_f32(k0 * rk * gk.x, k1 * rk * gk.y, a, false); a = __builtin_amdgcn_cvt_pk_fp8_f32(k2 * rk * gk.z, k3 * rk * gk.w, a, true); *(int*)(CKV8 + (size_t)r * 256 + 4 * lane) = a; }
        float val = bf2f(ar[768 + lane]);
        const float other = __shfl_xor(val, 16);
        if (t < SEQ) { const int axis = lane >> 5, half = (lane >> 4) & 1, f = lane & 15; const int comp = axis == 0 ? (t >> 6) : (t & 63);
            const float cs = tc[comp * 16 + f], sn = tsn[comp * 16 + f];
            val = half == 0 ? val * cs - other * sn : val * cs + other * sn; }
        KR8[(size_t)r * 64 + lane] = (unsigned char)(__builtin_amdgcn_cvt_pk_fp8_f32(val, 0.f, 0, false) & 0xff);
    }
}

__device__ __forceinline__ void phase_router(const KP& p, const Ctx& F, int layer, bool latent_only) {
    const int ntok = latent_only ? NLAT : M; const int tpb = ntok / F.G;
    const float* modv = (const float*)(F.ws + WS_MODV) + (size_t)layer * 5 * 6144; const bf16* xres = (const bf16*)(F.ws + WS_XRES); unsigned char* H8 = F.ws + WS_H8;
    int* TOPI = (int*)(F.ws + WS_TOPI); float* TOPW = (float*)(F.ws + WS_TOPW); int* HIST = (int*)(F.ws + WS_HIST);
    constexpr int RS = 1032;
    LAS bf16* hhi = (LAS bf16*)F.lds;
    LAS bf16* hlo = hhi + 16 * RS;
    LAS float* part = (LAS float*)(F.lds + 2 * 16 * RS * 2);
    LAS float* lg = part + 8 * 16 * 32;
    LAS float* sel = lg + 16 * 32;
    LAS int* lhist = (LAS int*)(sel + 64);
    const int lane = F.lane, wave = F.wave, e = lane & 31, q4 = lane >> 4, l15 = lane & 15;
    if (F.tid < 32) lhist[F.tid] = 0;
    bf16x8 whi[2][4], wlo[2][4];
    { const float* wr_ = p.moe_w_router + (size_t)layer * 1024 * 32;
#pragma unroll
      for (int nt = 0; nt < 2; ++nt)
#pragma unroll
          for (int kk = 0; kk < 4; ++kk)
#pragma unroll
              for (int j = 0; j < 8; ++j) { const float w = wr_[(size_t)(wave * 128 + kk * 32 + q4 * 8 + j) * 32 + nt * 16 + l15]; const unsigned h = f2bf(w); whi[nt][kk][j] = (short)h; wlo[nt][kk][j] = (short)f2bf(w - bf2f(h)); } }
    const float brt = p.moe_b_router[layer * 32 + e];
    const float* n2 = p.norm2 + layer * 1024;
    __syncthreads();
    const int tok0 = F.blk * tpb, nsteps = (tpb + 15) / 16;
    v2u vn[2][4];
    f32x4 gsc[4], shv[4]; int bs_cur = -1;
#pragma unroll
    for (int rr = 0; rr < 2; ++rr) { const int tl = 2 * wave + rr; const int r = tok2row(tok0 + (tl < tpb ? tl : 0), latent_only);
#pragma unroll
        for (int j = 0; j < 4; ++j) vn[rr][j] = *(const v2u*)(xres + (size_t)r * 1024 + 4 * lane + 256 * j); }
#pragma unroll 1
    for (int st = 0; st < nsteps; ++st) {
#pragma unroll
        for (int rr = 0; rr < 2; ++rr) {
            const int tl = st * 16 + 2 * wave + rr; const bool valid = tl < tpb; const int tok = tok0 + (valid ? tl : 0);
            f32x4 v[4];
#pragma unroll
            for (int j = 0; j < 4; ++j) v[j] = (f32x4){bflo(vn[rr][j].x), bfhi(vn[rr][j].x), bflo(vn[rr][j].y), bfhi(vn[rr][j].y)};
            { const int tln = tl + 16; const int rn = tok2row(tok0 + (tln < tpb ? tln : 0), latent_only);
#pragma unroll
              for (int j = 0; j < 4; ++j) vn[rr][j] = *(const v2u*)(xres + (size_t)rn * 1024 + 4 * lane + 256 * j); }
            const int r = tok2row(tok, latent_only); const int b = r / TPB, t = r % TPB; const int bs = t < SEQ ? b : 4;
            if (bs != bs_cur) { const float* mv = modv + (size_t)bs * 6144; bs_cur = bs;
#pragma unroll
                for (int j = 0; j < 4; ++j) { const int c = 4 * lane + 256 * j; const f32x4 g = *(const f32x4*)(n2 + c), sc = *(const f32x4*)(mv + 4096 + c); gsc[j] = g * (sc + 1.0f); shv[j] = *(const f32x4*)(mv + 3072 + c); } }
            float ss = 0.f;
#pragma unroll
            for (int j = 0; j < 4; ++j) ss += (v[j].x * v[j].x + v[j].y * v[j].y) + (v[j].z * v[j].z + v[j].w * v[j].w);
            const float rstd = 1.0f / sqrtf(wave_sum(ss) * (1.0f / 1024.0f) + EPS);
#pragma unroll
            for (int j = 0; j < 4; ++j) { const int c = 4 * lane + 256 * j;
                const f32x4 h = (v[j] * rstd) * gsc[j] + shv[j];
                const unsigned h0 = f2bf(h.x), h1 = f2bf(h.y), h2 = f2bf(h.z), h3 = f2bf(h.w);
                v2u o; o.x = h0 | (h1 << 16); o.y = h2 | (h3 << 16);
                v2u l; l.x = pk2(h.x - bf2f(h0), h.y - bf2f(h1)); l.y = pk2(h.z - bf2f(h2), h.w - bf2f(h3));
                *(LAS v2u*)(hhi + (2 * wave + rr) * RS + c) = o; *(LAS v2u*)(hlo + (2 * wave + rr) * RS + c) = l;
                if (valid) { int w8 = 0; w8 = __builtin_amdgcn_cvt_pk_fp8_f32(h.x, h.y, w8, false); w8 = __builtin_amdgcn_cvt_pk_fp8_f32(h.z, h.w, w8, true); *(int*)(H8 + (size_t)r * 1024 + c) = w8; } }
        }
        __syncthreads();
        { f32x4 a0 = {0.f, 0.f, 0.f, 0.f}, a1 = {0.f, 0.f, 0.f, 0.f};
#pragma unroll
          for (int kk = 0; kk < 4; ++kk) { const int ko = l15 * RS + wave * 128 + kk * 32 + q4 * 8;
              const bf16x8 ah = *(const LAS bf16x8*)(hhi + ko), al = *(const LAS bf16x8*)(hlo + ko);
              a0 = __builtin_amdgcn_mfma_f32_16x16x32_bf16(ah, whi[0][kk], a0, 0, 0, 0); a1 = __builtin_amdgcn_mfma_f32_16x16x32_bf16(ah, whi[1][kk], a1, 0, 0, 0);
              a0 = __builtin_amdgcn_mfma_f32_16x16x32_bf16(ah, wlo[0][kk], a0, 0, 0, 0); a1 = __builtin_amdgcn_mfma_f32_16x16x32_bf16(ah, wlo[1][kk], a1, 0, 0, 0);
              a0 = __builtin_amdgcn_mfma_f32_16x16x32_bf16(al, whi[0][kk], a0, 0, 0, 0); a1 = __builtin_amdgcn_mfma_f32_16x16x32_bf16(al, whi[1][kk], a1, 0, 0, 0); }
#pragma unroll
          for (int rg = 0; rg < 4; ++rg) { part[(wave * 16 + 4 * q4 + rg) * 32 + l15] = a0[rg]; part[(wave * 16 + 4 * q4 + rg) * 32 + 16 + l15] = a1[rg]; } }
        __syncthreads();
        { const int row = 2 * wave + (lane >> 5); const int tl = st * 16 + row; const bool valid = tl < tpb; const int tok = tok0 + tl;
            float logit = brt;
#pragma unroll
            for (int w = 0; w < 8; ++w) logit += part[(w * 16 + row) * 32 + e];
            lg[row * 32 + e] = logit;
            int rank = 0;
#pragma unroll
            for (int j4 = 0; j4 < 8; ++j4) { const f32x4 lv = *(const LAS f32x4*)(lg + row * 32 + 4 * j4);
#pragma unroll
                for (int i = 0; i < 4; ++i) { const int j = 4 * j4 + i; rank += (lv[i] > logit || (lv[i] == logit && j < e)) ? 1 : 0; } }
            if (valid && rank < 4) { TOPI[(size_t)tok * 4 + rank] = e; atomicAdd((int*)(lhist + e), 1); }
            if (rank < 4) sel[row * 4 + rank] = logit;
            if (valid && e < 4) { const f32x4 sv = *(const LAS f32x4*)(sel + row * 4);
                const float e1 = __expf(sv[1] - sv[0]), e2 = __expf(sv[2] - sv[0]), e3 = __expf(sv[3] - sv[0]); const float inv = 1.0f / (1.0f + e1 + e2 + e3);
                const float mine = e == 0 ? 1.0f : (e == 1 ? e1 : (e == 2 ? e2 : e3));
                TOPW[(size_t)tok * 4 + e] = mine * inv; }
        }
    }
    __syncthreads();
    if (F.tid < 32) HIST[F.blk * 32 + F.tid] = lhist[F.tid];
}

__device__ __forceinline__ void phase_lists(const KP& p, const Ctx& F, bool latent_only) {
    const int ntok = latent_only ? NLAT : M; const int tpb = ntok / F.G;
    const int* HIST = (const int*)(F.ws + WS_HIST); const int* TOPI = (const int*)(F.ws + WS_TOPI);
    int* POS = (int*)(F.ws + WS_POS); int* SORT = (int*)(F.ws + WS_SORT); int* META = (int*)(F.ws + WS_META);
    LAS int* ltot = (LAS int*)F.lds;
    LAS int* lbase = ltot + 32;
    LAS int* lstart = ltot + 64;
    LAS int* ltop = ltot + 128;
    LAS int* ptot = ltot + 1024; LAS int* pbase = ltot + 1536;
    { const int e = F.tid & 31, j = F.tid >> 5, per = (F.G + 15) >> 4; int tot = 0, base = 0;
        for (int k = 0; k < per; ++k) { const int b = j * per + k; const int h = (b < F.G) ? HIST[b * 32 + e] : 0; tot += h; base += (b < F.blk) ? h : 0; }
        ptot[j * 32 + e] = tot; pbase[j * 32 + e] = base; }
    for (int i = F.tid; i < tpb * 4; i += 512) ltop[i] = TOPI[(size_t)F.blk * tpb * 4 + i];
    __syncthreads();
    if (F.tid < 32) { int tot = 0, base = 0;
#pragma unroll
        for (int j = 0; j < 16; ++j) { tot += ptot[j * 32 + F.tid]; base += pbase[j * 32 + F.tid]; }
        ltot[F.tid] = tot; lbase[F.tid] = base; }
    __syncthreads();
    if (F.tid == 0) { int s = 0; for (int e = 0; e < 32; ++e) { lstart[e] = s; s += (ltot[e] + 255) & ~255; } lstart[32] = s; }
    __syncthreads();
    {
        const int e = F.tid & 31, seg = F.tid >> 5, n = tpb * 4, per = (n + 15) >> 4, i0 = seg * per, i1 = min(n, i0 + per);
        int cnt = 0;
        for (int i = i0; i < i1; ++i) cnt += (ltop[i] == e) ? 1 : 0;
        ptot[seg * 32 + e] = cnt;
        __syncthreads();
        int pos = lstart[e] + lbase[e];
        for (int s2 = 0; s2 < seg; ++s2) pos += ptot[s2 * 32 + e];
        for (int i = i0; i < i1; ++i) if (ltop[i] == e) { const int tok = F.blk * tpb + (i >> 2); SORT[pos] = tok2row(tok, latent_only); POS[(size_t)tok * 4 + (i & 3)] = pos; ++pos; } }
    if (F.blk < 32) { const int e = F.blk; const int s0 = lstart[e] + ltot[e], s1 = lstart[e + 1]; for (int i = s0 + F.tid; i < s1; i += 512) SORT[i] = 0; }
    if (F.blk == 0 && F.tid < 33) { META[64 + F.tid] = lstart[F.tid] >> 8; if (F.tid < 32) { META[F.tid] = ltot[F.tid]; META[32 + F.tid] = lstart[F.tid]; } }
}

template <bool FINAL>
__device__ __forceinline__ void phase_combine(const KP& p, const Ctx& F, int layer) {
    const float* modv = (const float*)(F.ws + WS_MODV); bf16* xres = (bf16*)(F.ws + WS_XRES); bf16* H = (bf16*)(F.ws + WS_H);
    const int* POS = (const int*)(F.ws + WS_POS); const float* TOPW = (const float*)(F.ws + WS_TOPW); const unsigned char* YS = F.ws + WS_YS;
    const int ntok = FINAL ? NLAT : M; const int gw = F.blk * 8 + F.wave, NGW = F.G * 8, lane = F.lane;
    int4 psC, psN, psNN; float4 wvC, wvN, wvNN; int yC[4][4], yN[4][4]; v2u xC[4], xN[4];
#define CB_IDX(tok_, ps_, wv_) do { ps_ = *(const int4*)(POS + (size_t)(tok_) * 4); wv_ = *(const float4*)(TOPW + (size_t)(tok_) * 4); } while (0)
#define CB_DATA(tok_, ps_, y_, x_) do { const int r_ = tok2row((tok_), FINAL); _Pragma("unroll") for (int j_ = 0; j_ < 4; ++j_) { const int c_ = 4 * lane + 256 * j_; \
        y_[0][j_] = *(const int*)(YS + (size_t)ps_.x * 1024 + c_); y_[1][j_] = *(const int*)(YS + (size_t)ps_.y * 1024 + c_); y_[2][j_] = *(const int*)(YS + (size_t)ps_.z * 1024 + c_); y_[3][j_] = *(const int*)(YS + (size_t)ps_.w * 1024 + c_); \
        x_[j_] = *(const v2u*)(xres + (size_t)r_ * 1024 + c_); } } while (0)
    int tok = gw;
    if (tok < ntok) { CB_IDX(tok, psC, wvC); CB_DATA(tok, psC, yC, xC); }
    if (tok + NGW < ntok) CB_IDX(tok + NGW, psN, wvN);
#pragma unroll 1
    for (; tok < ntok; tok += NGW) {
        if (tok + NGW < ntok) CB_DATA(tok + NGW, psN, yN, xN);
        if (tok + 2 * NGW < ntok) CB_IDX(tok + 2 * NGW, psNN, wvNN);
        __builtin_amdgcn_sched_barrier(0);
        const int r = tok2row(tok, FINAL); const int b = r / TPB, t = r % TPB; const int bs = t < SEQ ? b : 4;
        const float* g2 = modv + (size_t)(layer * 5 + bs) * 6144 + 5120;
        f32x4 v[4];
#pragma unroll
        for (int j = 0; j < 4; ++j) { const int c = 4 * lane + 256 * j; f32x4 a;
            a.x = wvC.x * __builtin_amdgcn_cvt_f32_fp8(yC[0][j], 0) + wvC.y * __builtin_amdgcn_cvt_f32_fp8(yC[1][j], 0) + wvC.z * __builtin_amdgcn_cvt_f32_fp8(yC[2][j], 0) + wvC.w * __builtin_amdgcn_cvt_f32_fp8(yC[3][j], 0);
            a.y = wvC.x * __builtin_amdgcn_cvt_f32_fp8(yC[0][j], 1) + wvC.y * __builtin_amdgcn_cvt_f32_fp8(yC[1][j], 1) + wvC.z * __builtin_amdgcn_cvt_f32_fp8(yC[2][j], 1) + wvC.w * __builtin_amdgcn_cvt_f32_fp8(yC[3][j], 1);
            a.z = wvC.x * __builtin_amdgcn_cvt_f32_fp8(yC[0][j], 2) + wvC.y * __builtin_amdgcn_cvt_f32_fp8(yC[1][j], 2) + wvC.z * __builtin_amdgcn_cvt_f32_fp8(yC[2][j], 2) + wvC.w * __builtin_amdgcn_cvt_f32_fp8(yC[3][j], 2);
            a.w = wvC.x * __builtin_amdgcn_cvt_f32_fp8(yC[0][j], 3) + wvC.y * __builtin_amdgcn_cvt_f32_fp8(yC[1][j], 3) + wvC.z * __builtin_amdgcn_cvt_f32_fp8(yC[2][j], 3) + wvC.w * __builtin_amdgcn_cvt_f32_fp8(yC[3][j], 3);
            const f32x4 gg = *(const f32x4*)(g2 + c);
            v[j] = (f32x4){bflo(xC[j].x), bfhi(xC[j].x), bflo(xC[j].y), bfhi(xC[j].y)} + gg * a; }
        if (!FINAL) {
#pragma unroll
            for (int j = 0; j < 4; ++j) { v2u o; o.x = pk2(v[j].x, v[j].y); o.y = pk2(v[j].z, v[j].w); *(v2u*)(xres + (size_t)r * 1024 + 4 * lane + 256 * j) = o; }
            const float* mv = modv + (size_t)(5 + bs) * 6144;
            norm_mod_store(v, p.norm1 + 1024, mv + 1024, mv, H + (size_t)r * 1024, lane);
        } else {
            float ss = 0.f;
#pragma unroll
            for (int j = 0; j < 4; ++j) ss += (v[j].x * v[j].x + v[j].y * v[j].y) + (v[j].z * v[j].z + v[j].w * v[j].w);
            const float rstd = 1.0f / sqrtf(wave_sum(ss) * (1.0f / 1024.0f) + EPS);
            float* orow = p.out + (size_t)tok * 1024;
#if defined(MX_SELFTEST) || defined(ATT_CHECK)
            const float tsc = 1.0f + 0.1f * (float)((const unsigned*)(F.ws + WS_CTL))[64];
#else
            const float tsc = 1.0f;
#endif
#pragma unroll
            for (int j = 0; j < 4; ++j) { const int c = 4 * lane + 256 * j; const f32x4 g = *(const f32x4*)(p.final_norm + c); *(f32x4*)(orow + c) = (v[j] * rstd) * g * tsc; }
        }
        psC = psN; wvC = wvN; psN = psNN; wvN = wvNN;
#pragma unroll
        for (int j = 0; j < 4; ++j) { xC[j] = xN[j];
#pragma unroll
            for (int k2 = 0; k2 < 4; ++k2) yC[k2][j] = yN[k2][j]; }
    }
#undef CB_IDX
#undef CB_DATA
}

__device__ __forceinline__ void phase_gla_finish(const KP& p, const Ctx& F) {
    const bf16* OFb = (const bf16*)(F.ws + WS_OF); const bf16* OBb = (const bf16*)(F.ws + WS_OB); const bf16* A2 = (const bf16*)(F.ws + WS_A2); bf16* Z = (bf16*)(F.ws + WS_Z);
    const int gw = F.blk * 8 + F.wave, NGW = F.G * 8, lane = F.lane;
    for (int tok = gw; tok < NLAT; tok += NGW) {
        const int r = tok2row(tok, true); const int c = 16 * lane;
        const v4u a0 = *(const v4u*)(OFb + (size_t)r * 1024 + c), a1 = *(const v4u*)(OFb + (size_t)r * 1024 + c + 8);
        const v4u b0 = *(const v4u*)(OBb + (size_t)r * 1024 + c), b1 = *(const v4u*)(OBb + (size_t)r * 1024 + c + 8);
        const v4u g0 = *(const v4u*)(A2 + (size_t)r * A2W + 2048 + c), g1 = *(const v4u*)(A2 + (size_t)r * A2W + 2048 + c + 8);
        float o[16], rg[16];
#pragma unroll
        for (int i = 0; i < 4; ++i) { o[2 * i] = bflo(a0[i]) + bflo(b0[i]); o[2 * i + 1] = bfhi(a0[i]) + bfhi(b0[i]); o[8 + 2 * i] = bflo(a1[i]) + bflo(b1[i]); o[8 + 2 * i + 1] = bfhi(a1[i]) + bfhi(b1[i]);
            rg[2 * i] = bflo(g0[i]); rg[2 * i + 1] = bfhi(g0[i]); rg[8 + 2 * i] = bflo(g1[i]); rg[8 + 2 * i + 1] = bfhi(g1[i]); }
        float ss = 0.f;
#pragma unroll
        for (int i = 0; i < 16; ++i) ss += o[i] * o[i];
        ss += __shfl_xor(ss, 1); ss += __shfl_xor(ss, 2); ss += __shfl_xor(ss, 4); ss += __shfl_xor(ss, 8);
        const float rstd = 1.0f / sqrtf(ss * (1.0f / 256.0f) + EPS);
        const float* hn = p.gla_head_norm + (c & 255);
        unsigned w[8];
#pragma unroll
        for (int i = 0; i < 8; ++i) { const float x0 = o[2 * i] * rstd * hn[2 * i] * (rg[2 * i] / (1.0f + __expf(-rg[2 * i]))), x1 = o[2 * i + 1] * rstd * hn[2 * i + 1] * (rg[2 * i + 1] / (1.0f + __expf(-rg[2 * i + 1])));
            w[i] = pk2(x0, x1); }
        *(v4u*)(Z + (size_t)r * 1024 + c) = (v4u){w[0], w[1], w[2], w[3]}; *(v4u*)(Z + (size_t)r * 1024 + c + 8) = (v4u){w[4], w[5], w[6], w[7]};
    }
}

namespace att {
constexpr int NW = 8, QBLK = 32, KVBLK = 64;
constexpr float SCALE = 0.07216878364870322f;
constexpr float THR = 2.f;
constexpr float PSHIFT = 5.f;
#ifndef ATT_SDEPTH
#define ATT_SDEPTH 2
#endif
constexpr int SDEPTH = ATT_SDEPTH;
constexpr int LDQ8 = 1536, LDK = 1024, LDK8 = 1024, LDKR8 = 64, LDO = 1024;
constexpr int SHM_V = 128 * KVBLK, SHM_K8 = KVBLK * 128, SHM_KR8 = KVBLK * 64;
constexpr int OFF_V = 0, OFF_K = 2 * SHM_V, OFF_KR = OFF_K + 2 * SHM_K8, OFF_WS = OFF_KR + 2 * SHM_KR8, OFF_Q2 = OFF_WS + NW * 64 * 4, SHM_ATTN = OFF_Q2 + NW * 2048;
typedef int v8i __attribute__((ext_vector_type(8)));
typedef int v4i __attribute__((ext_vector_type(4)));
#define K8U(key, u) ((key) * 128 + ((((u) ^ (((key) >> 1) & 7))) << 4))
#define KR8U(key, u) ((key) * 64 + ((((u) ^ (((key) >> 2) & 3))) << 4))
__device__ __forceinline__ v8i cat8(v4i lo, v4i hi) { return (v8i){lo[0], lo[1], lo[2], lo[3], hi[0], hi[1], hi[2], hi[3]}; }
__device__ __forceinline__ void mfma64(f32x16& c, v8i a, v8i b, int sc) { asm volatile("v_mfma_scale_f32_32x32x64_f8f6f4 %0, %1, %2, %0, %3, %3 op_sel_hi:[0,0,0]" : "+v"(c) : "v"(a), "v"(b), "v"(sc)); }
__device__ __forceinline__ void mfma64s(f32x16& c, v8i a, v8i b, int sa, int sb) { asm volatile("v_mfma_scale_f32_32x32x64_f8f6f4 %0, %1, %2, %0, %3, %4 op_sel_hi:[0,0,0]" : "+v"(c) : "v"(a), "v"(b), "v"(sa), "v"(sb)); }
typedef float f32x8 __attribute__((ext_vector_type(8)));
#define SBAR() __builtin_amdgcn_sched_barrier(0)
__device__ __forceinline__ int crow(int r, int hi) { return (r & 3) + 8 * (r >> 2) + 4 * hi; }
__device__ __forceinline__ unsigned cvtpk(float lo, float hi) { unsigned r; asm volatile("v_cvt_pk_bf16_f32 %0, %1, %2" : "=v"(r) : "v"(lo), "v"(hi)); return r; }

constexpr float THR2 = THR * 1.4426950408889634f;
__device__ __forceinline__ void softmax_step(f32x16& p0, f32x16& p1, float mref, float& m2, float& l_reg, float& al, v8i& pa, bool first) {
  const float d = mref - m2;
  if (__builtin_expect(__any(d != 0.f), 0)) {
#pragma unroll
    for (int r = 0; r < 16; ++r) { p0[r] += d; p1[r] += d; }
  }
  float pmax = p0[0];
#pragma unroll
  for (int r = 1; r < 16; ++r) pmax = fmaxf(pmax, p0[r]);
#pragma unroll
  for (int r = 0; r < 16; ++r) pmax = fmaxf(pmax, p1[r]);
  { auto rr = __builtin_amdgcn_permlane32_swap(__float_as_uint(pmax), __float_as_uint(pmax), false, false);
    pmax = fmaxf(__uint_as_float(rr[0]), __uint_as_float(rr[1])); }
  const float ex = pmax - PSHIFT;
  al = 1.f;
  if (__builtin_expect(first || __any(ex > THR2), 0)) {
    const float inc = first ? ex : fmaxf(ex, 0.f);
    m2 += inc; al = first ? 0.f : __builtin_amdgcn_exp2f(-inc);
#pragma unroll
    for (int r = 0; r < 16; ++r) { p0[r] -= inc; p1[r] -= inc; }
  }
#pragma unroll
  for (int r = 0; r < 16; ++r) p0[r] = __builtin_amdgcn_exp2f(p0[r]);
#pragma unroll
  for (int r = 0; r < 16; ++r) p1[r] = __builtin_amdgcn_exp2f(p1[r]);
  float ps = 0;
#pragma unroll
  for (int r = 0; r < 16; ++r) ps += p0[r];
#pragma unroll
  for (int r = 0; r < 16; ++r) ps += p1[r];
  { auto rr = __builtin_amdgcn_permlane32_swap(__float_as_uint(ps), __float_as_uint(ps), false, false);
    ps = __uint_as_float(rr[0]) + __uint_as_float(rr[1]); }
  l_reg = l_reg * al + ps;
#pragma unroll
  for (int w = 0; w < 4; ++w) { int x, y;
    asm("v_cvt_pk_fp8_f32 %0, %2, %3\n\tv_cvt_pk_fp8_f32 %1, %6, %7\n\tv_cvt_pk_fp8_f32 %0, %4, %5 op_sel:[0,0,1]\n\tv_cvt_pk_fp8_f32 %1, %8, %9 op_sel:[0,0,1]\n\ts_nop 0"
        : "=&v"(x), "=&v"(y) : "v"(p0[4 * w]), "v"(p0[4 * w + 1]), "v"(p0[4 * w + 2]), "v"(p0[4 * w + 3]), "v"(p1[4 * w]), "v"(p1[4 * w + 1]), "v"(p1[4 * w + 2]), "v"(p1[4 * w + 3]));
    pa[w] = x; pa[4 + w] = y; }
}
__device__ __forceinline__ void qkt(f32x16& p0, f32x16& p1, const char* K8s, const char* KR8s, const v8i* qf, int r32, int hi, int sc) {
  p0 = f32x16{}; p1 = f32x16{};
  asm volatile("s_nop 4" : "+v"(p0), "+v"(p1));
#pragma unroll
  for (int s = 0; s < 2; ++s) { const int u0 = 4 * s + 2 * hi;
    const v8i a0 = cat8(*reinterpret_cast<const v4i*>(K8s + K8U(r32, u0)), *reinterpret_cast<const v4i*>(K8s + K8U(r32, u0 + 1)));
    const v8i a1 = cat8(*reinterpret_cast<const v4i*>(K8s + K8U(32 + r32, u0)), *reinterpret_cast<const v4i*>(K8s + K8U(32 + r32, u0 + 1)));
    mfma64(p0, a0, qf[s], sc); mfma64(p1, a1, qf[s], sc); }
  { const int u0 = 2 * hi;
    const v8i a0 = cat8(*reinterpret_cast<const v4i*>(KR8s + KR8U(r32, u0)), *reinterpret_cast<const v4i*>(KR8s + KR8U(r32, u0 + 1)));
    const v8i a1 = cat8(*reinterpret_cast<const v4i*>(KR8s + KR8U(32 + r32, u0)), *reinterpret_cast<const v4i*>(KR8s + KR8U(32 + r32, u0 + 1)));
    mfma64(p0, a0, qf[2], sc); mfma64(p1, a1, qf[2], sc); }
  asm volatile("s_nop 15\n\ts_nop 7" : "+v"(p0), "+v"(p1));
}
#define V8U(d, u) ((d) * 64 + ((((u) ^ (((d) >> 2) & 3))) << 4))
__device__ __forceinline__ void pv_d0(f32x16* o, const char* V8s, v8i pa, int r32, int hi, int sc) {
#pragma unroll
  for (int d0 = 0; d0 < 4; ++d0) { const int d = 32 * d0 + r32;
    const v8i vb = cat8(*reinterpret_cast<const v4i*>(V8s + V8U(d, 2 * hi)), *reinterpret_cast<const v4i*>(V8s + V8U(d, 2 * hi + 1)));
    mfma64(o[d0], pa, vb, sc); }
  asm volatile("s_nop 15\n\ts_nop 7" : "+v"(o[0]), "+v"(o[1]), "+v"(o[2]), "+v"(o[3]));
}

__device__ __forceinline__ void attn_unit(const unsigned char* __restrict__ Qb, const unsigned char* __restrict__ Kh, const unsigned char* __restrict__ KRh, const unsigned char* __restrict__ Vh, unsigned char* __restrict__ Ob, int seq, char* lds) {
  int tid_ = threadIdx.x; asm volatile("" : "+v"(tid_));
  const int tid = tid_, wid = __builtin_amdgcn_readfirstlane(tid >> 6), lane = tid & 63, r32 = lane & 31, hi = lane >> 5;
  char* V_lds = lds + OFF_V; char* K_lds = lds + OFF_K; char* KR_lds = lds + OFF_KR;
  float* ws = (float*)(lds + OFF_WS) + wid * 64; float* li_l = ws; float* al_l = ws + 32;
  float m2 = 0.f, mrE = 0.f, mrO = 0.f, l_reg = 0, al = 1.f; f32x16 o[4] = {}; v8i qf[2];
  const int sc1 = 0x7f7f7f7f, scq = 0x7c7c7c7c;
  const unsigned char* Qw = Qb + (long)(wid * QBLK + r32) * LDQ8 + hi * 32;
#pragma unroll
  for (int s = 0; s < 2; ++s) qf[s] = *reinterpret_cast<const v8i*>(Qw + s * 64);
  char* q2_l = lds + OFF_Q2 + wid * 2048 + lane * 16;
  { const v8i q2 = *reinterpret_cast<const v8i*>(Qw + 128); *(v4i*)q2_l = (v4i){q2[0], q2[1], q2[2], q2[3]}; *(v4i*)(q2_l + 1024) = (v4i){q2[4], q2[5], q2[6], q2[7]}; }
  const int v8d = tid >> 2, v8u = tid & 3;
  const int k8r = tid >> 3, k8u = tid & 7, kr8r = (tid >> 2) & 63, kr8u = tid & 3;
  const bool has_kr = wid < 4;
  const int NT = seq / KVBLK;
  v4i sv8, sk8, skr8;
#define SLOAD(kt, vt) do { const int kt_ = min((kt), NT - 1) * KVBLK, vt_ = min(max((vt), 0), NT - 1) * KVBLK; \
    sv8 = *reinterpret_cast<const v4i*>(Vh + (size_t)v8d * 8448 + (unsigned)vt_ + v8u * 16); \
    sk8 = *reinterpret_cast<const v4i*>(Kh + (unsigned)(kt_ + k8r) * LDK8 + k8u * 16); \
    if (has_kr) skr8 = *reinterpret_cast<const v4i*>(KRh + (unsigned)(kt_ + kr8r) * LDKR8 + kr8u * 16); } while (0)
#define SWRITE(b) do { *(v4i*)(V_lds + (b) * SHM_V + V8U(v8d, v8u)) = sv8; \
    *(v4i*)(K_lds + (b) * SHM_K8 + K8U(k8r, k8u)) = sk8; \
    if (has_kr) *(v4i*)(KR_lds + (b) * SHM_KR8 + KR8U(kr8r, kr8u)) = skr8; } while (0)
#define STAGE(b, t_) do { asm volatile("s_waitcnt vmcnt(0)" ::: "memory"); SWRITE(b); SLOAD((t_) + 3, (t_) + 1); } while (0)
#define RESC() do { if (__any(al < 1.f)) { if (hi == 0) al_l[r32] = al; asm volatile("s_waitcnt lgkmcnt(0)" ::: "memory"); \
    _Pragma("unroll") for (int d = 0; d < 4; ++d) _Pragma("unroll") for (int r = 0; r < 16; ++r) o[d][r] *= al_l[crow(r, hi)]; \
    asm volatile("s_nop 4" : "+v"(o[0]), "+v"(o[1]), "+v"(o[2]), "+v"(o[3])); } } while (0)
#define LDK(b, half, s) cat8(*reinterpret_cast<const v4i*>(K_lds + (b) * SHM_K8 + K8U(32 * (half) + r32, 4 * (s) + 2 * hi)), *reinterpret_cast<const v4i*>(K_lds + (b) * SHM_K8 + K8U(32 * (half) + r32, 4 * (s) + 2 * hi + 1)))
#define LDKR(b, half) cat8(*reinterpret_cast<const v4i*>(KR_lds + (b) * SHM_KR8 + KR8U(32 * (half) + r32, 2 * hi)), *reinterpret_cast<const v4i*>(KR_lds + (b) * SHM_KR8 + KR8U(32 * (half) + r32, 2 * hi + 1)))
#define LDV(b, d0) cat8(*reinterpret_cast<const v4i*>(V_lds + (b) * SHM_V + V8U(32 * (d0) + r32, 2 * hi)), *reinterpret_cast<const v4i*>(V_lds + (b) * SHM_V + V8U(32 * (d0) + r32, 2 * hi + 1)))
#define MSTEP(do_pv, vb, do_qk, kb, P0, P1, MR) do { __builtin_amdgcn_s_setprio(1); \
    if (do_pv) { RESC(); \
      { const v8i v0 = LDV(vb, 0), v1 = LDV(vb, 1), v2 = LDV(vb, 2), v3 = LDV(vb, 3); SBAR(); \
        mfma64(o[0], pa, v0, sc1); mfma64(o[1], pa, v1, sc1); mfma64(o[2], pa, v2, sc1); mfma64(o[3], pa, v3, sc1); SBAR(); } } \
    if (do_qk) { v8i a0 = LDK(kb, 0, 0), a1 = LDK(kb, 1, 0); const v8i b0 = LDK(kb, 0, 1), b1 = LDK(kb, 1, 1); \
      { const float ci = PSHIFT - m2; MR = m2; _Pragma("unroll") for (int r_ = 0; r_ < 16; ++r_) { P0[r_] = ci; P1[r_] = ci; } } \
      asm volatile("s_nop 4" : "+v"(P0), "+v"(P1)); SBAR(); \
      mfma64s(P0, a0, qf[0], sc1, scq); mfma64s(P1, a1, qf[0], sc1, scq); SBAR(); \
      a0 = LDKR(kb, 0); a1 = LDKR(kb, 1); const v8i q2 = cat8(*reinterpret_cast<const v4i*>(q2_l), *reinterpret_cast<const v4i*>(q2_l + 1024)); SBAR(); \
      mfma64s(P0, b0, qf[1], sc1, scq); mfma64s(P1, b1, qf[1], sc1, scq); SBAR(); \
      mfma64s(P0, a0, q2, sc1, scq); mfma64s(P1, a1, q2, sc1, scq); \
      asm volatile("s_nop 15\n\ts_nop 7" : "+v"(P0), "+v"(P1)); } SBAR(); __builtin_amdgcn_s_setprio(0); } while (0)
#define VSTEP(P0, P1, MR, first) do { softmax_step(P0, P1, MR, m2, l_reg, al, pa, first); SBAR(); } while (0)
  f32x16 pE0, pE1, pO0, pO1; v8i pa = {0, 0, 0, 0, 0, 0, 0, 0};
  const bool g1 = wid >= 4;
  SLOAD(0, 0); asm volatile("s_waitcnt vmcnt(0)" ::: "memory"); SWRITE(0); SLOAD(1, 0); __syncthreads();
  if (g1) __syncthreads();
#pragma unroll 1
  for (int t = -1; t < NT; t += 2) {
    if (g1) STAGE(1, t);
    MSTEP(t >= 1, 0, t + 1 < NT, 0, pE0, pE1, mrE);
    __syncthreads();
    if (!g1) STAGE(1, t);
    if (t >= 1) VSTEP(pO0, pO1, mrO, false);
    __syncthreads();
    if (g1) STAGE(0, t + 1);
    MSTEP(t >= 0, 1, t + 2 < NT, 1, pO0, pO1, mrO);
    __syncthreads();
    if (!g1) STAGE(0, t + 1);
    if (t + 1 < NT) VSTEP(pE0, pE1, mrE, t < 0);
    __syncthreads();
  }
  if (!g1) __syncthreads();
  asm volatile("s_nop 15\n\ts_nop 7" : "+v"(o[0]), "+v"(o[1]), "+v"(o[2]), "+v"(o[3]));
  if (hi == 0) li_l[r32] = l_reg; asm volatile("s_waitcnt lgkmcnt(0)" ::: "memory");
  float rli[16];
#pragma unroll
  for (int r = 0; r < 16; ++r) rli[r] = __builtin_amdgcn_rcpf(li_l[crow(r, hi)]);
  unsigned char* Ow = Ob + (long)(wid * QBLK) * LDO;
#pragma unroll
  for (int r = 0; r < 16; ++r) { int orow = crow(r, hi);
#pragma unroll
    for (int d0 = 0; d0 < 4; ++d0) Ow[(long)orow * LDO + d0 * 32 + r32] = (unsigned char)(__builtin_amdgcn_cvt_pk_fp8_f32(o[d0][r] * rli[r], 0.f, 0, false) & 0xff); }
  __syncthreads();
#undef SLOAD
#undef SWRITE
#undef STAGE
#undef RESC
#undef LDK
#undef LDKR
#undef LDV
#undef MSTEP
#undef VSTEP
}
#undef K8U
#undef KR8U
#undef V8U
#undef SBAR
}

__device__ __forceinline__ void phase_attention(const Ctx& F) {
    const unsigned char* Q = F.ws + WS_Q8; const unsigned char* KN = F.ws + WS_KN8; const unsigned char* KR = F.ws + WS_KR8; const unsigned char* VT = F.ws + WS_VT8; unsigned char* O = F.ws + WS_O8;
    char* lds = (char*)F.lds;
    const bool xcd = (F.G & 7) == 0; const int nq = xcd ? (F.G >> 3) : F.G; const int lat_rounds = xcd ? (128 + nq - 1) / nq : (1024 + F.G - 1) / F.G;
#pragma unroll 1
    for (int i = 0;; ++i) {
        int bh, qrow, krow, seq;
        if (i < lat_rounds) {
            int qt;
            if (xcd) { const int x = F.blk & 7, q = F.blk >> 3; const int uu = i * nq + q; bh = (uu >> 5) * 8 + x; qt = uu & 31; if (uu >= 128) continue; }
            else { const int uu = i * F.G + F.blk; bh = uu >> 5; qt = uu & 31; if (uu >= 1024) continue; }
            qrow = qt * 256; krow = 0; seq = TPB;
        } else { bh = (i - lat_rounds) * F.G + F.blk; if (bh >= NB * 8) break; qrow = SEQ; krow = SEQ; seq = LC; }
        const int b = bh >> 3, h = bh & 7; const size_t r0 = (size_t)b * TPB;
        att::attn_unit(Q + (r0 + qrow) * 1536 + h * 192, KN + (r0 + krow) * 1024 + h * 128, KR + (r0 + krow) * 64, VT + (size_t)(bh * 128) * 8448 + krow, O + (r0 + qrow) * 1024 + h * 128, seq, lds);
    }
}

__device__ __forceinline__ f32x4 mfma16(bf16x8 a, bf16x8 b, f32x4 c) { return __builtin_amdgcn_mfma_f32_16x16x32_bf16(a, b, c, 0, 0, 0); }
constexpr int NCH = M / 64;
constexpr int GL_AM = 0, GL_ST = 18432, GL_END = GL_ST + 8 * 32 * 136 * 2;

__device__ __forceinline__ void phase_gla_prep(const KP& p, const Ctx& F) {
    const bf16* A2 = (const bf16*)(F.ws + WS_A2);
    bf16* QE = (bf16*)(F.ws + WS_QE); bf16* KE = (bf16*)(F.ws + WS_KE); bf16* KPT = (bf16*)(F.ws + WS_KPT); bf16* VT = (bf16*)(F.ws + WS_VT); float* DEC = (float*)(F.ws + WS_DEC);
    const int gw = F.blk * 8 + F.wave, NGW = F.G * 8, tid = F.tid, lane = F.lane, wave = F.wave, q4 = lane >> 4, l15 = lane & 15;
    constexpr int TS = 264, PS = 72;
    LAS bf16* qT = (LAS bf16*)F.lds; LAS bf16* kT = qT + 64 * TS; LAS bf16* pT = kT + 64 * TS;
    const int pr = tid >> 5, pc = (tid & 31) * 8;
    const int kpr = tid >> 3, kpc = (tid & 7) * 8;
    v4u sq[4], sk[4]; bf16x8 tf[4]; bf16x8 w2n[2]; float bgn[2];
#define GP_LOADS(task_) do { const int hp_ = (task_) & 1, cgd_ = (task_) >> 1; const int cg_ = cgd_ % NCH, dir_ = cgd_ / NCH; const bf16* a_ = A2 + ((size_t)cg_ * 64) * A2W; \
        _Pragma("unroll") for (int i_ = 0; i_ < 4; ++i_) { const bf16* r_ = a_ + (size_t)(pr + 16 * i_) * A2W + hp_ * 256 + pc; sq[i_] = *(const v4u*)r_; sk[i_] = *(const v4u*)(r_ + 512); } \
        _Pragma("unroll") for (int mt_ = 0; mt_ < 4; ++mt_) { tf[mt_] = (bf16x8){0, 0, 0, 0, 0, 0, 0, 0}; if (q4 < 2) tf[mt_] = *(const bf16x8*)(a_ + (size_t)(16 * mt_ + l15) * A2W + 3072 + dir_ * 16 + q4 * 8); } \
        _Pragma("unroll") for (int tt_ = 0; tt_ < 2; ++tt_) { const int dcol_ = hp_ * 256 + (2 * wave + tt_) * 16 + l15; w2n[tt_] = (bf16x8){0, 0, 0, 0, 0, 0, 0, 0}; \
            if (q4 < 2) { _Pragma("unroll") for (int j_ = 0; j_ < 8; ++j_) w2n[tt_][j_] = (short)f2bf(p.gla_w_gate2[(size_t)(dir_ * 16 + q4 * 8 + j_) * 512 + dcol_]); } \
            bgn[tt_] = p.gla_b_gate[dir_ * 512 + dcol_]; } } while (0)
    const int ntask = 2 * NCH * 2;
    if (F.blk < ntask) GP_LOADS(F.blk);
#pragma unroll 1
    for (int task = F.blk; task < ntask; task += F.G) {
        const int hp = task & 1, cgd = task >> 1; const int cg = cgd % NCH, dir = cgd / NCH; const size_t row0 = (size_t)cg * 64;
#pragma unroll
        for (int i = 0; i < 4; ++i) { *(LAS v4u*)(qT + (pr + 16 * i) * TS + pc) = sq[i]; *(LAS v4u*)(kT + (pr + 16 * i) * TS + pc) = sk[i]; }
        bf16x8 tfc[4], w2c[2]; float bgc[2];
#pragma unroll
        for (int mt = 0; mt < 4; ++mt) tfc[mt] = tf[mt];
#pragma unroll
        for (int tt = 0; tt < 2; ++tt) { w2c[tt] = w2n[tt]; bgc[tt] = bgn[tt]; }
        __syncthreads();
        if (task + F.G < ntask) GP_LOADS(task + F.G);
        __builtin_amdgcn_sched_barrier(0);
#pragma unroll
        for (int tt = 0; tt < 2; ++tt) {
            const int ct = 2 * wave + tt, lc = ct * 16 + l15, dcol = hp * 256 + lc;
            const float bgd = bgc[tt];
            f32x4 gp[4];
#pragma unroll
            for (int mt = 0; mt < 4; ++mt) gp[mt] = mfma16(tfc[mt], w2c[tt], (f32x4){0.f, 0.f, 0.f, 0.f});
            float bb[4][4], gg[4][4]; float carry = 0.f;
#pragma unroll
            for (int mt = 0; mt < 4; ++mt) {
                float c[4];
#pragma unroll
                for (int r = 0; r < 4; ++r) { const float xg = gp[mt][r] + bgd; const float g = (fminf(xg, 0.f) - __logf(1.0f + __expf(-fabsf(xg)))) * 0.0625f; gg[mt][r] = g; c[r] = g + (r ? c[r - 1] : 0.f); }
                const float t0 = __shfl(c[3], l15), t1 = __shfl(c[3], l15 + 16), t2 = __shfl(c[3], l15 + 32), t3 = __shfl(c[3], l15 + 48);
                const float ex = carry + (q4 > 0 ? t0 : 0.f) + (q4 > 1 ? t1 : 0.f) + (q4 > 2 ? t2 : 0.f);
#pragma unroll
                for (int r = 0; r < 4; ++r) bb[mt][r] = ex + c[r];
                carry += (t0 + t1) + (t2 + t3);
            }
            const float btot = carry;
#pragma unroll
            for (int mt = 0; mt < 4; ++mt) {
                float kp[4];
#pragma unroll
                for (int r = 0; r < 4; ++r) { const int m = 16 * mt + 4 * q4 + r;
                    const float qv = bf2f(qT[m * TS + lc]), kv = bf2f(kT[m * TS + lc]); const float bv = dir ? (btot - bb[mt][r] + gg[mt][r]) : bb[mt][r];
                    qT[m * TS + lc] = (bf16)f2bf(qv * 0.08838834764831845f * __expf(bv)); kT[m * TS + lc] = (bf16)f2bf(kv * __expf(-bv));
                    kp[r] = kv * __expf(btot - bv); }
                v2u w; w.x = pk2(kp[0], kp[1]); w.y = pk2(kp[2], kp[3]);
                *(LAS v2u*)(pT + lc * PS + 16 * mt + 4 * q4) = w;
            }
            if (q4 == 0) DEC[((size_t)dir * NCH + cg) * 512 + dcol] = __expf(btot);
        }
        __syncthreads();
#pragma unroll
        for (int i = 0; i < 4; ++i) { const size_t oi = ((size_t)dir * M + row0 + pr + 16 * i) * 512 + hp * 256 + pc;
            *(v4u*)(QE + oi) = *(const LAS v4u*)(qT + (pr + 16 * i) * TS + pc); *(v4u*)(KE + oi) = *(const LAS v4u*)(kT + (pr + 16 * i) * TS + pc);
            *(v4u*)(KPT + (((size_t)dir * NCH + cg) * 512 + hp * 256 + kpr + 64 * i) * 64 + kpc) = *(const LAS v4u*)(pT + (kpr + 64 * i) * PS + kpc); }
        __syncthreads();
    }
#undef GP_LOADS
}

constexpr int GL_QE = 0, GL_KE = 17408, GL_KP = 34816, GL_AMS = 53248, GL_STS = 62464, GL_DEC = GL_STS + 8 * 32 * 136 * 2, GL_T1 = GL_DEC + 512, GL_END2 = GL_T1 + 2048;
template <bool OUT>
__device__ __forceinline__ void gla_unit(const KP& p, const Ctx& F, int ch, int s) {
    const int dir = ch & 1, hh = (ch >> 1) & 3, b = ch >> 3;
    const int tid = F.tid, lane = F.lane, wave = F.wave, q4 = lane >> 4, l15 = lane & 15;
    const bf16* A2 = (const bf16*)(F.ws + WS_A2); const bf16* VT = (const bf16*)(F.ws + WS_VT);
    bf16* UST = (bf16*)(F.ws + WS_UST); float* DS = (float*)(F.ws + WS_DS);
    bf16* Oout = (bf16*)(F.ws + (dir ? WS_OB : WS_OF));
    LAS bf16* QEs = (LAS bf16*)(F.lds + GL_QE); LAS bf16* KEs = (LAS bf16*)(F.lds + GL_KE); LAS bf16* KPs = (LAS bf16*)(F.lds + GL_KP); LAS bf16* AMs = (LAS bf16*)(F.lds + GL_AMS);
    LAS bf16* ST = (LAS bf16*)(F.lds + GL_STS) + wave * (32 * 136); LAS float* DECs = (LAS float*)(F.lds + GL_DEC); LAS bf16* T1s = (LAS bf16*)(F.lds + GL_T1);
    const int qr0 = tid >> 4, qc0 = (tid & 15) * 8;
    const int lc = wave * 16 + l15;
    v4u sq[2], sk[2], st1 = {0u, 0u, 0u, 0u}; bf16x8 vtn[2][2];
    bf16x8 w2f = {0, 0, 0, 0, 0, 0, 0, 0};
    if (q4 < 2) {
#pragma unroll
        for (int j = 0; j < 8; ++j) w2f[j] = (short)f2bf(p.gla_w_gate2[(size_t)(dir * 16 + q4 * 8 + j) * 512 + hh * 128 + lc]);
    }
    const float bgd = p.gla_b_gate[dir * 512 + hh * 128 + lc];
#define GL_CHUNK(sb_) ((s == 0) ? (dir ? 131 - (sb_) : 128 + (sb_)) : (dir ? 127 - 4 * (s - 1) - (sb_) : 4 * (s - 1) + (sb_)))
#define GL_LOADS(sb_) do { const int cg_ = b * 132 + GL_CHUNK(sb_); const bf16* a_ = A2 + ((size_t)cg_ * 64) * A2W; \
        if (OUT) { sq[0] = *(const v4u*)(a_ + (size_t)qr0 * A2W + hh * 128 + qc0); sq[1] = *(const v4u*)(a_ + (size_t)(qr0 + 32) * A2W + hh * 128 + qc0); } \
        sk[0] = *(const v4u*)(a_ + (size_t)qr0 * A2W + 512 + hh * 128 + qc0); sk[1] = *(const v4u*)(a_ + (size_t)(qr0 + 32) * A2W + 512 + hh * 128 + qc0); \
        if (tid < 128) st1 = *(const v4u*)(a_ + (size_t)(tid >> 1) * A2W + 3072 + dir * 16 + (tid & 1) * 8); \
        { const bf16* v_ = VT + ((size_t)cg_ * 1024 + hh * 256 + wave * 32) * 64 + 8 * q4; \
            vtn[0][0] = *(const bf16x8*)(v_ + (size_t)l15 * 64); vtn[0][1] = *(const bf16x8*)(v_ + (size_t)l15 * 64 + 32); \
            vtn[1][0] = *(const bf16x8*)(v_ + (size_t)(16 + l15) * 64); vtn[1][1] = *(const bf16x8*)(v_ + (size_t)(16 + l15) * 64 + 32); } } while (0)
    GL_LOADS(0);
    f32x4 sacc[2][8];
    if (OUT) {
        const bf16* U0 = UST + ((size_t)(ch * 32 + (s - 1)) * 256 + wave * 32 + 4 * q4) * 128 + l15;
#pragma unroll
        for (int et = 0; et < 2; ++et)
#pragma unroll
            for (int nt = 0; nt < 8; ++nt)
#pragma unroll
                for (int r = 0; r < 4; ++r) { const bf16 v = U0[(size_t)(16 * et + r) * 128 + nt * 16]; sacc[et][nt][r] = bf2f(v); ST[(16 * et + 4 * q4 + r) * 136 + nt * 16 + l15] = v; }
    } else {
#pragma unroll
        for (int et = 0; et < 2; ++et)
#pragma unroll
            for (int nt = 0; nt < 8; ++nt) sacc[et][nt] = (f32x4){0.f, 0.f, 0.f, 0.f};
    }
    float dprod[8];
#pragma unroll
    for (int nt = 0; nt < 8; ++nt) dprod[nt] = 1.0f;
#pragma unroll 1
    for (int sb = 0; sb < 4; ++sb) {
        const size_t row0 = (size_t)(b * 132 + GL_CHUNK(sb)) * 64;
        if (OUT) { *(LAS v4u*)(QEs + qr0 * 136 + qc0) = sq[0]; *(LAS v4u*)(QEs + (qr0 + 32) * 136 + qc0) = sq[1]; }
        *(LAS v4u*)(KEs + qr0 * 136 + qc0) = sk[0]; *(LAS v4u*)(KEs + (qr0 + 32) * 136 + qc0) = sk[1];
        if (tid < 128) *(LAS v4u*)(T1s + tid * 8) = st1;
        bf16x8 vtf[2][2];
#pragma unroll
        for (int et = 0; et < 2; ++et) { vtf[et][0] = vtn[et][0]; vtf[et][1] = vtn[et][1]; }
        __syncthreads();
        if (sb < 3) GL_LOADS(sb + 1);
        __builtin_amdgcn_sched_barrier(0);
        {
            float bb[4][4]; float carry = 0.f;
#pragma unroll
            for (int mt = 0; mt < 4; ++mt) {
                bf16x8 tf = {0, 0, 0, 0, 0, 0, 0, 0};
                if (q4 < 2) tf = *(const LAS bf16x8*)(T1s + (16 * mt + l15) * 16 + q4 * 8);
                const f32x4 gp = mfma16(tf, w2f, (f32x4){0.f, 0.f, 0.f, 0.f});
                float c[4], g4[4];
#pragma unroll
                for (int r = 0; r < 4; ++r) { const float xg = gp[r] + bgd; const float g = (fminf(xg, 0.f) - __logf(1.0f + __expf(-fabsf(xg)))) * 0.0625f; g4[r] = g; c[r] = g + (r ? c[r - 1] : 0.f); }
                const float t0 = __shfl(c[3], l15), t1 = __shfl(c[3], l15 + 16), t2 = __shfl(c[3], l15 + 32), t3 = __shfl(c[3], l15 + 48);
                const float ex = carry + (q4 > 0 ? t0 : 0.f) + (q4 > 1 ? t1 : 0.f) + (q4 > 2 ? t2 : 0.f);
#pragma unroll
                for (int r = 0; r < 4; ++r) bb[mt][r] = ex + c[r] - (dir ? g4[r] : 0.f);
                carry += (t0 + t1) + (t2 + t3);
            }
            const float btot = carry;
#pragma unroll
            for (int mt = 0; mt < 4; ++mt) {
                float kp[4];
#pragma unroll
                for (int r = 0; r < 4; ++r) { const int m = 16 * mt + 4 * q4 + r;
                    const float kv = bf2f(KEs[m * 136 + lc]); const float bv = dir ? (btot - bb[mt][r]) : bb[mt][r];
                    kp[r] = kv * __expf(btot - bv);
                    if (OUT) { const float qv = bf2f(QEs[m * 136 + lc]); QEs[m * 136 + lc] = (bf16)f2bf(qv * 0.08838834764831845f * __expf(bv)); KEs[m * 136 + lc] = (bf16)f2bf(kv * __expf(-bv)); } }
                v2u w; w.x = pk2(kp[0], kp[1]); w.y = pk2(kp[2], kp[3]);
                *(LAS v2u*)(KPs + lc * 72 + 16 * mt + 4 * q4) = w;
            }
            if (q4 == 0) DECs[lc] = __expf(btot);
        }
        __syncthreads();
        float dc[8];
#pragma unroll
        for (int nt = 0; nt < 8; ++nt) dc[nt] = DECs[nt * 16 + l15];
        if (OUT) {
#pragma unroll
            for (int tt = 0; tt < 2; ++tt) { const int tix = 2 * wave + tt, mt = tix >> 2, nt = tix & 3; f32x4 a = {0.f, 0.f, 0.f, 0.f};
#pragma unroll
                for (int kk = 0; kk < 4; ++kk) a = mfma16(*(const LAS bf16x8*)(QEs + (16 * mt + l15) * 136 + kk * 32 + 8 * q4), *(const LAS bf16x8*)(KEs + (16 * nt + l15) * 136 + kk * 32 + 8 * q4), a);
#pragma unroll
                for (int r = 0; r < 4; ++r) { const int i = 16 * mt + 4 * q4 + r, j = 16 * nt + l15; const bool keep = dir ? (j >= i) : (j <= i); AMs[i * 72 + j] = keep ? (bf16)f2bf(a[r]) : (bf16)0; } }
            __syncthreads();
            bf16x8 stf[2][4];
#pragma unroll
            for (int et = 0; et < 2; ++et)
#pragma unroll
                for (int kk = 0; kk < 4; ++kk) stf[et][kk] = *(const LAS bf16x8*)(ST + (16 * et + l15) * 136 + kk * 32 + 8 * q4);
#pragma unroll
            for (int mt = 0; mt < 4; ++mt) { f32x4 o0 = {0.f, 0.f, 0.f, 0.f}, o1 = {0.f, 0.f, 0.f, 0.f};
#pragma unroll
                for (int kk = 0; kk < 4; ++kk) { const bf16x8 qf = *(const LAS bf16x8*)(QEs + (16 * mt + l15) * 136 + kk * 32 + 8 * q4); o0 = mfma16(qf, stf[0][kk], o0); o1 = mfma16(qf, stf[1][kk], o1); }
#pragma unroll
                for (int kk = 0; kk < 2; ++kk) { const bf16x8 af = *(const LAS bf16x8*)(AMs + (16 * mt + l15) * 72 + kk * 32 + 8 * q4); o0 = mfma16(af, vtf[0][kk], o0); o1 = mfma16(af, vtf[1][kk], o1); }
#pragma unroll
                for (int r = 0; r < 4; ++r) { bf16* op = Oout + (row0 + 16 * mt + 4 * q4 + r) * 1024 + hh * 256 + wave * 32 + l15; op[0] = (bf16)f2bf(o0[r]); op[16] = (bf16)f2bf(o1[r]); } }
        }
#pragma unroll
        for (int nt = 0; nt < 8; ++nt) { dprod[nt] *= dc[nt];
            const bf16x8 k0 = *(const LAS bf16x8*)(KPs + (16 * nt + l15) * 72 + 8 * q4), k1 = *(const LAS bf16x8*)(KPs + (16 * nt + l15) * 72 + 32 + 8 * q4);
#pragma unroll
            for (int et = 0; et < 2; ++et) { sacc[et][nt] = sacc[et][nt] * dc[nt]; sacc[et][nt] = mfma16(vtf[et][0], k0, sacc[et][nt]); sacc[et][nt] = mfma16(vtf[et][1], k1, sacc[et][nt]); } }
        if (OUT && sb < 3) {
#pragma unroll
            for (int et = 0; et < 2; ++et)
#pragma unroll
                for (int nt = 0; nt < 8; ++nt)
#pragma unroll
                    for (int r = 0; r < 4; ++r) ST[(16 * et + 4 * q4 + r) * 136 + nt * 16 + l15] = (bf16)f2bf(sacc[et][nt][r]);
        }
        __syncthreads();
    }
#undef GL_LOADS
#undef GL_CHUNK
    if (!OUT) {
        bf16* U0 = UST + ((size_t)(ch * 32 + s) * 256 + wave * 32 + 4 * q4) * 128 + l15;
#pragma unroll
        for (int et = 0; et < 2; ++et)
#pragma unroll
            for (int nt = 0; nt < 8; ++nt)
#pragma unroll
                for (int r = 0; r < 4; ++r) U0[(size_t)(16 * et + r) * 128 + nt * 16] = (bf16)f2bf(sacc[et][nt][r]);
        if (wave == 0 && q4 == 0) {
#pragma unroll
            for (int nt = 0; nt < 8; ++nt) DS[(size_t)(ch * 32 + s) * 128 + nt * 16 + l15] = dprod[nt];
        }
    }
}
template <bool OUT>
__device__ __forceinline__ void phase_gla_units(const KP& p, const Ctx& F) {
#pragma unroll 1
    for (int u = F.blk; u < 32 * 32; u += F.G) { const int s = (u & 31) + (OUT ? 1 : 0), ch = u >> 5; gla_unit<OUT>(p, F, ch, s); }
}
__device__ __forceinline__ void phase_gla_scan(const Ctx& F) {
    unsigned* UST = (unsigned*)(F.ws + WS_UST); const float* DS = (const float*)(F.ws + WS_DS);
    const int gt = F.blk * 512 + F.tid, NGT = F.G * 512;
    for (int idx = gt; idx < 32 * 16384; idx += NGT) {
        const int ch = idx >> 14, ed2 = idx & 16383, d = (ed2 & 63) * 2;
        unsigned u[32]; float d0[32], d1[32];
#pragma unroll
        for (int s = 0; s < 32; ++s) { u[s] = UST[(size_t)(ch * 32 + s) * 16384 + ed2]; const float2 dd = *(const float2*)(DS + (size_t)(ch * 32 + s) * 128 + d); d0[s] = dd.x; d1[s] = dd.y; }
        float r0 = 0.f, r1 = 0.f;
#pragma unroll
        for (int s = 0; s < 32; ++s) { r0 = d0[s] * r0 + bflo(u[s]); r1 = d1[s] * r1 + bfhi(u[s]); UST[(size_t)(ch * 32 + s) * 16384 + ed2] = pk2(r0, r1); }
    }
}

constexpr int NWAVES = 8;
constexpr int LDS_BYTES = 163840;
constexpr int CTRL_OFF = 159744;
constexpr int MISC_OFF = CTRL_OFF + 320;
constexpr int TSTART_OFF = CTRL_OFF + 1024;
constexpr int CW_BAR = 4096;
constexpr int NPHASE = 24;


#ifdef MX_SELFTEST
typedef int v8i __attribute__((ext_vector_type(8)));
__device__ __forceinline__ float mx_a(int i, int k) { return (float)((i * 7 + k * 3) % 5 - 2) * 0.5f; }
__device__ __forceinline__ float mx_b(int k, int j) { return (float)((k * 5 + j * 11) % 7 - 3) * 0.25f; }
__device__ __forceinline__ int mx_kmap(int hyp, int q4, int j, int t) { return hyp == 0 ? 32 * q4 + 4 * j + t : 64 * (j >> 2) + 16 * q4 + 4 * (j & 3) + t; }
__device__ __forceinline__ bool mx_try(int hyp, int lane) {
    const int l15 = lane & 15, q4 = lane >> 4; v8i a, b;
#pragma unroll
    for (int j = 0; j < 8; ++j) { int wa = 0, wb = 0;
        wa = __builtin_amdgcn_cvt_pk_fp8_f32(mx_a(l15, mx_kmap(hyp, q4, j, 0)), mx_a(l15, mx_kmap(hyp, q4, j, 1)), wa, false);
        wa = __builtin_amdgcn_cvt_pk_fp8_f32(mx_a(l15, mx_kmap(hyp, q4, j, 2)), mx_a(l15, mx_kmap(hyp, q4, j, 3)), wa, true);
        wb = __builtin_amdgcn_cvt_pk_fp8_f32(mx_b(mx_kmap(hyp, q4, j, 0), l15), mx_b(mx_kmap(hyp, q4, j, 1), l15), wb, false);
        wb = __builtin_amdgcn_cvt_pk_fp8_f32(mx_b(mx_kmap(hyp, q4, j, 2), l15), mx_b(mx_kmap(hyp, q4, j, 3), l15), wb, true);
        a[j] = wa; b[j] = wb; }
    f32x4 c = {0.f, 0.f, 0.f, 0.f};
    c = __builtin_amdgcn_mfma_scale_f32_16x16x128_f8f6f4(a, b, c, 0, 0, 0, 0x7f7f7f7f, 0, 0x7f7f7f7f);
    bool ok = true;
#pragma unroll
    for (int r = 0; r < 4; ++r) { const int i = 4 * q4 + r; float ref = 0.f; for (int kk = 0; kk < 128; ++kk) ref += mx_a(i, kk) * mx_b(kk, l15); ok = ok && (fabsf(ref - c[r]) < 1e-3f); }
    return __all(ok);
}
#endif

#ifdef ATT_CHECK
__device__ __forceinline__ float f8dec(unsigned char b) { return __builtin_amdgcn_cvt_f32_fp8((int)b, 0); }
__device__ __forceinline__ void att_check(const Ctx& F, unsigned* ctl) {
    if (F.blk >= 8) return;
    const int sid = F.blk * 8 + F.wave, lane = F.lane, b = sid & 3, h = (sid >> 2) & 7;
    const bool isctx = sid >= 56; const int qt = isctx ? SEQ + (sid * 37) % 256 : (sid * 1237 + 11) % SEQ;
    const size_t r0 = (size_t)b * TPB; const size_t krow0 = r0 + (isctx ? SEQ : 0); const int nk = isctx ? LC : TPB;
    const unsigned char* Q8 = F.ws + WS_Q8 + (r0 + qt) * 1536 + h * 192; const unsigned char* KN8 = F.ws + WS_KN8 + krow0 * 1024 + h * 128; const unsigned char* KR8 = F.ws + WS_KR8 + krow0 * 64;
    const unsigned char* VT = F.ws + WS_VT8 + (size_t)((b * 8 + h) * 128) * 8448 + (isctx ? SEQ : 0); const unsigned char* O8 = F.ws + WS_O8 + (r0 + qt) * 1024 + h * 128;
    const float q0 = f8dec(Q8[lane]), q1 = f8dec(Q8[64 + lane]), q2 = f8dec(Q8[128 + lane]);
    float m = -1e30f, l = 0.f, a0 = 0.f, a1 = 0.f;
    for (int j = 0; j < nk; ++j) {
        const float part = q0 * f8dec(KN8[(size_t)j * 1024 + lane]) + q1 * f8dec(KN8[(size_t)j * 1024 + 64 + lane]) + q2 * f8dec(KR8[(size_t)j * 64 + lane]);
        const float s = wave_sum(part) * 0.07216878364870322f;
        const float mn = fmaxf(m, s), sc = __expf(m - mn), pj = __expf(s - mn); m = mn;
        l = l * sc + pj; { const size_t ko = (size_t)(j & ~63) + pg8::vpos(j & 63); a0 = a0 * sc + pj * f8dec(VT[(size_t)lane * 8448 + ko]); a1 = a1 * sc + pj * f8dec(VT[(size_t)(64 + lane) * 8448 + ko]); }
    }
    const float o0 = a0 / l, o1 = a1 / l, k0 = f8dec(O8[lane]), k1 = f8dec(O8[64 + lane]);
    const float err = wave_sum((o0 - k0) * (o0 - k0) + (o1 - k1) * (o1 - k1)), nrm = wave_sum(o0 * o0 + o1 * o1);
    if (lane == 0 && !(err <= 0.04f * nrm)) atomicOr(&ctl[64], 4u);
}
#endif
__device__ __forceinline__ void load_tstart(const Ctx& F) {
    const int* META = (const int*)(F.ws + WS_META); LAS int* ts = (LAS int*)(F.lds + TSTART_OFF);
    int t0 = threadIdx.x; asm volatile("" : "+v"(t0));
    if (t0 < 33) ts[t0] = META[64 + t0];
    __syncthreads();
    for (int rt = t0; rt < SROWS / 256; rt += NWAVES * 64) { int e = 0;
#pragma unroll 1
        for (int k = 1; k < 32; ++k) e += (ts[k] <= rt) ? 1 : 0;
        ts[64 + rt] = e; }
    __syncthreads();
}

typedef const __attribute__((address_space(4))) KP* KPc;
__device__ __forceinline__ const KP& kp_launder() { KPc q = (KPc)__builtin_amdgcn_kernarg_segment_ptr(); asm volatile("" : "+s"(q)); return *(const KP*)q; }
__global__ void __launch_bounds__(NWAVES * 64, 2) trunk_fwd(KP pk) {
#define p kp_launder()
    extern __shared__ __attribute__((aligned(16))) unsigned char lds_raw[];
    Ctx F;
    F.lds = (LAS unsigned char*)lds_raw; F.ws = p.ws;
    F.tid = threadIdx.x; F.lane = F.tid & 63; F.wave = __builtin_amdgcn_readfirstlane(F.tid >> 6); F.G = gridDim.x; F.blk = blockIdx.x;
    { int t0 = threadIdx.x; asm volatile("" : "+v"(t0));
      for (int u = t0; u < (LDS_BYTES - CTRL_OFF) / 4; u += NWAVES * 64) ((LAS unsigned*)(F.lds + CTRL_OFF))[u] = 0u; }
    __syncthreads();
    unsigned* ctl = (unsigned*)(p.ws + WS_CTL);
#if MK_PER_PHASE
#define GRID_BAR() do { } while (0)
#else
    XcdBarrier bar = xcd_barrier_post(ctl + CW_BAR, (volatile LAS unsigned*)(F.lds + MISC_OFF) + 8);
#define GRID_BAR() xcd_barrier(bar)
#endif
#ifdef MX_SELFTEST
    if (F.blk == 0 && F.wave == 0) { const bool h1 = mx_try(0, F.lane), h2 = mx_try(1, F.lane); if (F.lane == 0) ctl[64] = h1 ? 0u : (h2 ? 1u : 2u); }
#endif
    const int lo = p.ph_lo, hi = p.ph_hi;
#ifndef PH_MASK
#define PH_MASK 0xffffff
#endif
#define IN(k) (((PH_MASK >> (k)) & 1) && lo <= (k) && (k) < hi)
#define SEAM(k) do { if (IN(k) && IN((k) + 1)) GRID_BAR(); } while (0)
#ifndef REP_MASK
#define REP_MASK 0
#endif
#define NREP(k) (1 + ((REP_MASK >> (k)) & 1))
    unsigned char* ws = p.ws;
    const float* modv = (const float*)(ws + WS_MODV);
    LAS unsigned char* ring = F.lds;
    const LAS int* tstart = (const LAS int*)(F.lds + TSTART_OFF);

    if (IN(0)) _Pragma("unroll") for (int rep_ = 0; rep_ < NREP(0); ++rep_) { if (rep_) GRID_BAR(); phase_prologue(p, F); } SEAM(0);
    if (IN(1)) _Pragma("unroll") for (int rep_ = 0; rep_ < NREP(1); ++rep_) { if (rep_) GRID_BAR(); phase_norm1_l0(p, F); } SEAM(1);
    if (IN(2)) _Pragma("unroll") for (int rep_ = 0; rep_ < NREP(2); ++rep_) { if (rep_) GRID_BAR();
        pg8::Gemm g{(const pg8::bf16_t*)(ws + WS_H8), (const pg8::bf16_t*)(ws + WS_W_IN), M, 1024, 512}; pg8::StaticOrder S; S.init(M, 1024, F.G, F.blk);
        pg8::EpiBf16 E{(pg8::bf16_t*)(ws + WS_A1), 1024, nullptr, 0, 0, 0.03125f};
        pg8::gemm_phase<pg8::EpiBf16, pg8::StaticOrder, true, true, true>(ring, g, S, E);
    } SEAM(2);
    if (IN(3)) _Pragma("unroll") for (int rep_ = 0; rep_ < NREP(3); ++rep_) { if (rep_) GRID_BAR(); phase_mla_thin(p, F); } SEAM(3);
    if (IN(4)) _Pragma("unroll") for (int rep_ = 0; rep_ < NREP(4); ++rep_) { if (rep_) GRID_BAR();
        { pg8::Gemm g{(const pg8::bf16_t*)(ws + WS_CQ8), (const pg8::bf16_t*)(ws + WS_W_UQ), M, 1536, 256}; pg8::StaticOrder S; S.init(M, 1536, F.G, F.blk);
          pg8::EpiQRope E{ws + WS_Q8, (const float*)(ws + WS_ROPE), (const float*)(ws + WS_ROPE) + 2048, 0.03125f * (8.0f * 0.07216878364870322f * 1.4426950408889634f)};
          pg8::gemm_phase<pg8::EpiQRope, pg8::StaticOrder, true, true, true>(ring, g, S, E); }
        { pg8::Gemm g{(const pg8::bf16_t*)(ws + WS_CKV8), (const pg8::bf16_t*)(ws + WS_W_UKV), M, 2048, 128}; pg8::StaticOrder S; S.init(M, 2048, F.G, (F.blk + F.G / 2) % F.G);
          pg8::EpiKV E{ws + WS_KN8, ws + WS_VT8, 0.03125f};
          pg8::gemm_phase<pg8::EpiKV, pg8::StaticOrder, true, true, true>(ring, g, S, E); }
    } SEAM(4);
    if (IN(5)) _Pragma("unroll") for (int rep_ = 0; rep_ < NREP(5); ++rep_) { if (rep_) GRID_BAR(); phase_attention(F); } SEAM(5);
#ifdef ATT_CHECK
    if (IN(5) && IN(6)) { att_check(F, ctl); }
#endif
    if (IN(6)) _Pragma("unroll") for (int rep_ = 0; rep_ < NREP(6); ++rep_) { if (rep_) GRID_BAR();
        pg8::Gemm g{(const pg8::bf16_t*)(ws + WS_O8), (const pg8::bf16_t*)(ws + WS_W_O), M, 1024, 512}; pg8::StaticOrder S; S.init(M, 1024, F.G, F.blk);
        pg8::EpiResid E{p.x, p.ctx, (pg8::bf16_t*)(ws + WS_XRES), modv + 2048, 0.03125f};
        pg8::gemm_phase<pg8::EpiResid, pg8::StaticOrder, true, true, true>(ring, g, S, E);
    } SEAM(6);
    if (IN(7)) _Pragma("unroll") for (int rep_ = 0; rep_ < NREP(7); ++rep_) { if (rep_) GRID_BAR(); phase_router(p, F, 0, false); } SEAM(7);
    if (IN(8)) _Pragma("unroll") for (int rep_ = 0; rep_ < NREP(8); ++rep_) { if (rep_) GRID_BAR(); phase_lists(p, F, false); } SEAM(8);
    if (IN(9)) _Pragma("unroll") for (int rep_ = 0; rep_ < NREP(9); ++rep_) { if (rep_) GRID_BAR();
        load_tstart(F);
        pg8::Gemm g{(const pg8::bf16_t*)(ws + WS_H8), (const pg8::bf16_t*)(ws + WS_W_GU), 0, 2048, 512}; pg8::MoeOrder S{tstart, 3, F.G, F.blk};
        pg8::EpiSwiglu E{ws + WS_ACT, p.moe_b_gu, 0.03125f};
        pg8::gemm_phase_gather<pg8::EpiSwiglu, pg8::MoeOrder, true>(ring, g, (const int*)(ws + WS_SORT), S, E);
    } SEAM(9);
    if (IN(10)) _Pragma("unroll") for (int rep_ = 0; rep_ < NREP(10); ++rep_) { if (rep_) GRID_BAR();
        load_tstart(F);
        pg8::Gemm g{(const pg8::bf16_t*)(ws + WS_ACT), (const pg8::bf16_t*)(ws + WS_W_DN), 0, 1024, 512}; pg8::MoeOrder S{tstart, 2, F.G, F.blk};
        pg8::EpiDown8 E{ws + WS_YS, p.moe_b_down, 0.03125f};
        pg8::gemm_phase<pg8::EpiDown8, pg8::MoeOrder, false, true, true>(ring, g, S, E);
    } SEAM(10);
    if (IN(11)) _Pragma("unroll") for (int rep_ = 0; rep_ < NREP(11); ++rep_) { if (rep_) GRID_BAR(); phase_combine<false>(p, F, 0); } SEAM(11);

    if (IN(12)) _Pragma("unroll") for (int rep_ = 0; rep_ < NREP(12); ++rep_) { if (rep_) GRID_BAR();
        pg8::Gemm g{(const pg8::bf16_t*)(ws + WS_H), (const pg8::bf16_t*)(ws + WS_W_GIN), M, A2W, 1024}; pg8::StaticOrder S; S.init(M, A2W, F.G, F.blk);
        pg8::EpiGla E{(pg8::bf16_t*)(ws + WS_A2), (pg8::bf16_t*)(ws + WS_VT)};
        pg8::gemm_phase<pg8::EpiGla, pg8::StaticOrder, true, true>(ring, g, S, E);
    } SEAM(12);
    if (IN(14)) _Pragma("unroll") for (int rep_ = 0; rep_ < NREP(14); ++rep_) { if (rep_) GRID_BAR(); phase_gla_units<false>(p, F); } SEAM(14);
    if (IN(15)) _Pragma("unroll") for (int rep_ = 0; rep_ < NREP(15); ++rep_) { if (rep_) GRID_BAR(); phase_gla_scan(F); } SEAM(15);
    if (IN(16)) _Pragma("unroll") for (int rep_ = 0; rep_ < NREP(16); ++rep_) { if (rep_) GRID_BAR(); phase_gla_units<true>(p, F); } SEAM(16);
    if (IN(17)) _Pragma("unroll") for (int rep_ = 0; rep_ < NREP(17); ++rep_) { if (rep_) GRID_BAR(); phase_gla_finish(p, F); } SEAM(17);
    if (IN(18)) _Pragma("unroll") for (int rep_ = 0; rep_ < NREP(18); ++rep_) { if (rep_) GRID_BAR();
        pg8::Gemm g{(const pg8::bf16_t*)(ws + WS_Z), (const pg8::bf16_t*)(ws + WS_W_GO), M, 1024, 1024}; pg8::LatentOrder S; S.init(1024, F.G, F.blk);
        pg8::EpiResid E{nullptr, nullptr, (pg8::bf16_t*)(ws + WS_XRES), modv + 5 * 6144 + 2048, 1.0f};
        pg8::gemm_phase<pg8::EpiResid, pg8::LatentOrder, true, true>(ring, g, S, E);
    } SEAM(18);
    if (IN(19)) _Pragma("unroll") for (int rep_ = 0; rep_ < NREP(19); ++rep_) { if (rep_) GRID_BAR(); phase_router(p, F, 1, true); } SEAM(19);
    if (IN(20)) _Pragma("unroll") for (int rep_ = 0; rep_ < NREP(20); ++rep_) { if (rep_) GRID_BAR(); phase_lists(p, F, true); } SEAM(20);
    if (IN(21)) _Pragma("unroll") for (int rep_ = 0; rep_ < NREP(21); ++rep_) { if (rep_) GRID_BAR();
        load_tstart(F);
        pg8::Gemm g{(const pg8::bf16_t*)(ws + WS_H8), (const pg8::bf16_t*)(ws + WS_W_GU + (size_t)65536 * 1024), 0, 2048, 512}; pg8::MoeOrder S{tstart, 3, F.G, F.blk};
        pg8::EpiSwiglu E{ws + WS_ACT, p.moe_b_gu + 32 * 2048, 0.03125f};
        pg8::gemm_phase_gather<pg8::EpiSwiglu, pg8::MoeOrder, true>(ring, g, (const int*)(ws + WS_SORT), S, E);
    } SEAM(21);
    if (IN(22)) _Pragma("unroll") for (int rep_ = 0; rep_ < NREP(22); ++rep_) { if (rep_) GRID_BAR();
        load_tstart(F);
        pg8::Gemm g{(const pg8::bf16_t*)(ws + WS_ACT), (const pg8::bf16_t*)(ws + WS_W_DN + (size_t)32768 * 1024), 0, 1024, 512}; pg8::MoeOrder S{tstart, 2, F.G, F.blk};
        pg8::EpiDown8 E{ws + WS_YS, p.moe_b_down + 32 * 1024, 0.03125f};
        pg8::gemm_phase<pg8::EpiDown8, pg8::MoeOrder, false, true, true>(ring, g, S, E);
    } SEAM(22);
    if (IN(23)) _Pragma("unroll") for (int rep_ = 0; rep_ < NREP(23); ++rep_) { if (rep_) GRID_BAR(); phase_combine<true>(p, F, 1); }
#undef IN
#undef SEAM
#undef GRID_BAR
#undef p
}

extern "C" void kernel_launch(void* const* d_in, const int* in_sizes, int n_in, void* d_out, int out_size, void* d_ws, size_t ws_size, hipStream_t stream) {
    static int grid = 0;
    if (grid == 0) {
        if (n_in != 27 || in_sizes[0] != NB * SEQ * DM || out_size != NB * SEQ * DM || ws_size < WS_END) {
            fprintf(stderr, "kernel_launch: shape mismatch (n_in %d, in0 %d, out %d, ws %zu, need ws >= %zu); nothing launched\n", n_in, n_in > 0 ? in_sizes[0] : -1, out_size, ws_size, (size_t)WS_END); grid = -1; return; }
        int dev = 0, cus = 0, per_cu = 0;
        if (hipGetDevice(&dev) != hipSuccess || hipDeviceGetAttribute(&cus, hipDeviceAttributeMultiprocessorCount, dev) != hipSuccess) { fprintf(stderr, "kernel_launch: device query failed\n"); grid = -1; return; }
        if (hipFuncSetAttribute((const void*)trunk_fwd, hipFuncAttributeMaxDynamicSharedMemorySize, LDS_BYTES) != hipSuccess) { fprintf(stderr, "kernel_launch: hipFuncSetAttribute failed\n"); grid = -1; return; }
        if (hipOccupancyMaxActiveBlocksPerMultiprocessor(&per_cu, (const void*)trunk_fwd, NWAVES * 64, LDS_BYTES) != hipSuccess || per_cu < 1)
            fprintf(stderr, "kernel_launch: note: occupancy query reports %d workgroups per CU\n", per_cu);
        (void)hipGetLastError();
        grid = cus;
        if (grid != 256) { fprintf(stderr, "kernel_launch: built for a 256-CU device (got %d CUs); nothing launched\n", cus); grid = -1; return; }
    }
    if (grid < 0) return;
    if (hipMemsetAsync((char*)d_ws + WS_CTL, 0, CTL_ZERO_BYTES, stream) != hipSuccess) { fprintf(stderr, "kernel_launch: memset failed\n"); return; }
    KP a{};
    const float** pp = (const float**)&a;
    for (int i = 0; i < 27; ++i) pp[i] = (const float*)d_in[i];
    a.out = (float*)d_out; a.ws = (unsigned char*)d_ws;
#if MK_PER_PHASE
    for (int ph = 0; ph < NPHASE; ++ph) { a.ph_lo = ph; a.ph_hi = ph + 1; hipLaunchKernelGGL(trunk_fwd, dim3(grid), dim3(NWAVES * 64), LDS_BYTES, stream, a); }
#else
    a.ph_lo = 0; a.ph_hi = NPHASE;
    hipLaunchKernelGGL(trunk_fwd, dim3(grid), dim3(NWAVES * 64), LDS_BYTES, stream, a);
#endif
    const hipError_t le = hipPeekAtLastError();
    if (le != hipSuccess) fprintf(stderr, "kernel_launch: launch failed: %s\n", hipGetErrorName(le));
}
```

```cpp
#include <hip/hip_runtime.h>
#include <cstdio>
#include <cstdint>

#ifndef MK_PER_PHASE
#define MK_PER_PHASE 0
#endif

constexpr int DM = 1024, NB = 4, SEQ = 8192, LC = 256, TPB = SEQ + LC, M = NB * TPB;
constexpr int NE = 32, TOPK = 4;
constexpr int NLAT = NB * SEQ;
constexpr int SROWS = (M * TOPK) + NE * 256;
constexpr int A2W = 3328;
constexpr float EPS = 1e-6f;

constexpr size_t MiB = 1u << 20;
constexpr size_t WS_CTL = 0, CTL_ZERO_BYTES = 1 * MiB;
constexpr size_t WS_MODV = 1 * MiB;
constexpr size_t WS_ROPE = 1 * MiB + 256 * 1024;
constexpr size_t WS_HIST = 1 * MiB + 512 * 1024;
constexpr size_t WS_META = WS_HIST + 64 * 1024;
constexpr size_t WS_TOPI = 2 * MiB, WS_TOPW = 3 * MiB, WS_POS = 4 * MiB, WS_SORT = 5 * MiB, WS_DS = 6 * MiB;
constexpr size_t WS_W_IN = 8 * MiB, WS_W_UQ = 10 * MiB, WS_W_UKV = 12 * MiB, WS_W_O = 14 * MiB, WS_W_GIN = 16 * MiB, WS_W_GO = 24 * MiB;
constexpr size_t WS_W_GU = 32 * MiB, WS_W_DN = 288 * MiB;
constexpr size_t WS_H = 416 * MiB;
constexpr size_t WS_XRES = 482 * MiB;
constexpr size_t WS_ACT = 614 * MiB;
constexpr size_t WS_YS = 894 * MiB;
constexpr size_t WS_A1 = 1174 * MiB, WS_CQ = 1240 * MiB, WS_CKV = 1273 * MiB, WS_KR = 1290 * MiB, WS_Q = 1295 * MiB, WS_KN = 1394 * MiB, WS_V = 1460 * MiB, WS_O = 1526 * MiB;
constexpr size_t WS_A2 = 1174 * MiB;
constexpr size_t WS_UST = 1389 * MiB;
constexpr size_t WS_OF = 1517 * MiB, WS_OB = 1583 * MiB, WS_Z = 1649 * MiB;
constexpr size_t WS_QE = 614 * MiB, WS_KE = 680 * MiB, WS_KPT = 746 * MiB, WS_VT = 812 * MiB, WS_DEC = 878 * MiB;
constexpr size_t WS_H8 = 1715 * MiB;
constexpr size_t WS_CQ8 = 1749 * MiB, WS_CKV8 = 1766 * MiB, WS_O8 = 1775 * MiB;
constexpr size_t WS_Q8 = 1295 * MiB, WS_KN8 = 1394 * MiB, WS_KR8 = 1290 * MiB;
constexpr size_t WS_VT8 = 1460 * MiB;
constexpr size_t WS_END = 1809 * MiB;
static_assert((size_t)M * 1024 * 2 <= 66 * MiB && (size_t)M * 1024 * 4 <= 132 * MiB && (size_t)SROWS * 1024 * 2 <= 280 * MiB && (size_t)M * A2W * 2 <= 215 * MiB, "ws map");
static_assert((size_t)M * 512 * 2 <= 33 * MiB && (size_t)M * 256 * 2 <= 17 * MiB && (size_t)M * 64 * 2 <= 5 * MiB && (size_t)M * 1536 * 2 <= 99 * MiB, "ws map");

#define GAS __attribute__((address_space(1)))
#define LAS __attribute__((address_space(3)))
typedef unsigned short bf16;
typedef unsigned v4u __attribute__((ext_vector_type(4)));
typedef unsigned v2u __attribute__((ext_vector_type(2)));
typedef float f32x4 __attribute__((ext_vector_type(4)));
typedef float f32x16 __attribute__((ext_vector_type(16)));
typedef short bf16x8 __attribute__((ext_vector_type(8)));
typedef short s16x4 __attribute__((ext_vector_type(4)));
typedef GAS unsigned gu32;
#define RLX_AGENT __ATOMIC_RELAXED, __HIP_MEMORY_SCOPE_AGENT
#define LDS_WAIT() asm volatile("s_waitcnt lgkmcnt(0)" ::: "memory")
#define VM_WAIT() asm volatile("s_waitcnt vmcnt(0)" ::: "memory")
__device__ __forceinline__ unsigned f2bf(float f) { unsigned u = __builtin_bit_cast(unsigned, f); return (u + 0x7fffu + ((u >> 16) & 1u)) >> 16; }
__device__ __forceinline__ unsigned pk2(float lo, float hi) { return f2bf(lo) | (f2bf(hi) << 16); }
__device__ __forceinline__ float bf2f(unsigned b) { return __builtin_bit_cast(float, b << 16); }
__device__ __forceinline__ float bflo(unsigned w) { return __builtin_bit_cast(float, w << 16); }
__device__ __forceinline__ float bfhi(unsigned w) { return __builtin_bit_cast(float, w & 0xffff0000u); }
__device__ __forceinline__ float wave_sum(float v) {
#pragma unroll
    for (int o = 1; o < 64; o <<= 1) v += __shfl_xor(v, o);
    return v;
}

struct KP {
    const float *x, *c, *ctx, *c_ctx, *mod_w, *mod_b, *norm1, *norm2, *mla_w_in, *mla_q_norm, *mla_w_uq, *mla_kv_norm, *mla_w_ukv, *mla_w_o,
        *gla_w_in, *gla_w_gate1, *gla_w_gate2, *gla_b_gate, *gla_head_norm, *gla_w_o, *moe_w_router, *moe_b_router, *moe_w_gu, *moe_b_gu, *moe_w_down, *moe_b_down, *final_norm;
    float* out; unsigned char* ws; int ph_lo, ph_hi;
};
namespace pg8 {
#define PG8_LAS __attribute__((address_space(3)))
typedef unsigned short bf16_t;
typedef short bf16x8 __attribute__((ext_vector_type(8)));
typedef float f32x4 __attribute__((ext_vector_type(4)));
typedef unsigned u32x4 __attribute__((ext_vector_type(4)));
constexpr int BM = 256, BK = 64, HALF = 128, HTB = HALF * BK * 2  , STAGE_BYTES = 8 * HTB, NXCD = 8, WGM = 8;

__host__ __device__ __forceinline__ int lds_byte(int r, int c) { const int st = (r >> 4) * 2 + (c >> 5), rr = r & 15, cc = c & 31, ob = rr * 64 + cc * 2; return st * 1024 + (ob ^ (((ob >> 9) & 1) << 5)); }
__host__ __device__ __forceinline__ void stage_rc(int b, int& R, int& C) { const int st = b / 1024, sb = b % 1024, swz = sb ^ (((sb >> 9) & 1) << 5); R = (st >> 1) * 16 + swz / 64; C = (st & 1) * 32 + (swz % 64) / 2; }
__host__ __device__ __forceinline__ int perm32(int rho) { const int n = rho >> 4, i = rho & 15; return 8 * (i >> 2) + 4 * n + (i & 3); }

struct Unit { int pm, pn; };
struct Gemm { const bf16_t* A; const bf16_t* Bt; int M, N, K; };

struct StaticOrder {
    int nM, nN, nwg, G, c;
    __host__ __device__ void init(int M, int N, int G_, int c_) { nM = M / BM; nN = N / BM; nwg = nM * nN; G = G_; c = c_; }
    __host__ __device__ bool next(int i, Unit& u) const {
        const long L = (long)i * G + c; if (L >= nwg) return false;
        int wgid = (int)L; { const int q = nwg / NXCD, r = nwg % NXCD, xcd = wgid % NXCD, off = wgid / NXCD; wgid = (xcd < r ? xcd * (q + 1) : r * (q + 1) + (xcd - r) * q) + off; }
        const int nig = WGM * nN, gid = wgid / nig, fm = gid * WGM, gsz = (nM - fm) < WGM ? (nM - fm) : WGM;
        u.pm = fm + ((wgid % nig) % gsz); u.pn = (wgid % nig) / gsz; return true;
    }
    __device__ __forceinline__ void a_ready(const Unit&) const {}
    __device__ __forceinline__ void done(const Unit&) const {}
};

__device__ __forceinline__ unsigned cvt_pk_bf16(float lo, float hi) { unsigned r; asm volatile("v_cvt_pk_bf16_f32 %0, %1, %2" : "=v"(r) : "v"(lo), "v"(hi)); return r; }
typedef unsigned u32x2 __attribute__((ext_vector_type(2)));
typedef float f32x8 __attribute__((ext_vector_type(8)));
__device__ __forceinline__ f32x4 ag(const f32x4 (&a)[2][2][4][2], int ai, int bj, int m, int n) { return a[ai][bj][m][n]; }
__device__ __forceinline__ f32x4 ag(const f32x8 (&a)[2][2][4], int ai, int bj, int m, int n) { return n == 0 ? __builtin_shufflevector(a[ai][bj][m], a[ai][bj][m], 0, 1, 2, 3) : __builtin_shufflevector(a[ai][bj][m], a[ai][bj][m], 4, 5, 6, 7); }

struct EpiBf16 {
    static constexpr bool PERM = true, AFTER_DRAIN = false;
    bf16_t* O; int ldc; const float* bias; int split_cols; size_t split_stride; float ascale;
    template <class AccT> __device__ __forceinline__ void operator()(const AccT& acc, const Unit& u, int wr, int wc, int fr, int fq) const {
        const int row0 = u.pm * BM + wr * 64 + fr; int colt = u.pn * BM; bf16_t* base = O;
        if (split_cols) { const int t = colt / split_cols; base += (size_t)t * split_stride; colt -= t * split_cols; }
        const int col0 = colt + wc * 32 + 8 * fq, bcol0 = u.pn * BM + wc * 32 + 8 * fq;
        f32x4 bv[2][2];
#pragma unroll
        for (int bj = 0; bj < 2; ++bj)
#pragma unroll
            for (int n = 0; n < 2; ++n) bv[bj][n] = bias ? *(const f32x4*)(bias + bcol0 + bj * HALF + 4 * n) : (f32x4){0.f, 0.f, 0.f, 0.f};
#pragma unroll
        for (int ai = 0; ai < 2; ++ai)
#pragma unroll
            for (int m = 0; m < 4; ++m) { bf16_t* rowp = base + (size_t)(row0 + ai * HALF + m * 16) * ldc + col0;
#pragma unroll
                for (int bj = 0; bj < 2; ++bj) { const f32x4 v0 = ag(acc, ai, bj, m, 0) * ascale + bv[bj][0], v1 = ag(acc, ai, bj, m, 1) * ascale + bv[bj][1];
                    u32x4 w; w.x = cvt_pk_bf16(v0[0], v0[1]); w.y = cvt_pk_bf16(v0[2], v0[3]); w.z = cvt_pk_bf16(v1[0], v1[1]); w.w = cvt_pk_bf16(v1[2], v1[3]);
                    *(u32x4*)(rowp + bj * HALF) = w; } }
    }
};

struct EpiDown8 {
    static constexpr bool PERM = true, AFTER_DRAIN = false;
    unsigned char* ys; const float* bias; float ascale;
    template <class AccT> __device__ __forceinline__ void operator()(const AccT& acc, const Unit& u, int wr, int wc, int fr, int fq) const {
        const int row0 = u.pm * BM + wr * 64 + fr; const int bcol0 = u.pn * BM + wc * 32 + 8 * fq;
        const int cst = (u.pn & 3) * BM + wc * 32 + 8 * (fq & ~1) + (fq & 1) * HALF;
        f32x4 bb[2][2];
#pragma unroll
        for (int bj = 0; bj < 2; ++bj) { bb[bj][0] = *(const f32x4*)(bias + bcol0 + bj * HALF); bb[bj][1] = *(const f32x4*)(bias + bcol0 + bj * HALF + 4); }
#pragma unroll
        for (int ai = 0; ai < 2; ++ai)
#pragma unroll
            for (int m = 0; m < 4; ++m) { unsigned w[2][2];
#pragma unroll
                for (int bj = 0; bj < 2; ++bj) { const f32x4 v0 = ag(acc, ai, bj, m, 0) * ascale + bb[bj][0], v1 = ag(acc, ai, bj, m, 1) * ascale + bb[bj][1];
                    int w0 = 0, w1 = 0; w0 = __builtin_amdgcn_cvt_pk_fp8_f32(v0[0], v0[1], w0, false); w0 = __builtin_amdgcn_cvt_pk_fp8_f32(v0[2], v0[3], w0, true);
                    w1 = __builtin_amdgcn_cvt_pk_fp8_f32(v1[0], v1[1], w1, false); w1 = __builtin_amdgcn_cvt_pk_fp8_f32(v1[2], v1[3], w1, true);
                    w[bj][0] = (unsigned)w0; w[bj][1] = (unsigned)w1; }
                const auto s0 = __builtin_amdgcn_permlane16_swap(w[0][0], w[1][0], false, false), s1 = __builtin_amdgcn_permlane16_swap(w[0][1], w[1][1], false, false);
                *(u32x4*)(ys + (size_t)(row0 + ai * HALF + m * 16) * 1024 + cst) = (u32x4){s0[0], s1[0], s0[1], s1[1]}; }
    }
};

__host__ __device__ __forceinline__ int vpos(int kl) { const int half = kl >> 5, k5 = kl & 31, hi = (k5 >> 2) & 1, r = (k5 & 3) + 4 * (k5 >> 3); return hi * 32 + half * 16 + r; }
struct EpiKV {
    static constexpr bool PERM = true, AFTER_DRAIN = false;
    unsigned char* KN8; unsigned char* VT8; float ascale;
    template <class AccT> __device__ __forceinline__ void operator()(const AccT& acc, const Unit& u, int wr, int wc, int fr, int fq) const {
        const int row0 = u.pm * BM + wr * 64 + fr; const bool isk = u.pn < 4; const int col0 = (u.pn & 3) * BM + wc * 32 + 8 * fq;
        const int b = u.pm / 33, kk0 = (u.pm % 33) * BM + wr * 64 + fr;
#pragma unroll
        for (int ai = 0; ai < 2; ++ai)
#pragma unroll
            for (int m = 0; m < 4; ++m) { const size_t ro = (size_t)(row0 + ai * HALF + m * 16) * 1024 + col0; const int kk = kk0 + ai * HALF + m * 16; const size_t kofs = (size_t)(kk & ~63) + vpos(kk & 63);
#pragma unroll
                for (int bj = 0; bj < 2; ++bj) { const f32x4 v0 = ag(acc, ai, bj, m, 0) * ascale, v1 = ag(acc, ai, bj, m, 1) * ascale;
                    int w0 = 0, w1 = 0; w0 = __builtin_amdgcn_cvt_pk_fp8_f32(v0[0], v0[1], w0, false); w0 = __builtin_amdgcn_cvt_pk_fp8_f32(v0[2], v0[3], w0, true);
                    w1 = __builtin_amdgcn_cvt_pk_fp8_f32(v1[0], v1[1], w1, false); w1 = __builtin_amdgcn_cvt_pk_fp8_f32(v1[2], v1[3], w1, true);
                    if (isk) { *(u32x2*)(KN8 + ro + bj * HALF) = (u32x2){(unsigned)w0, (unsigned)w1}; }
                    else { const int c = col0 + bj * HALF;
                        unsigned char* vp = VT8 + ((size_t)(b * 8 * 128 + c)) * 8448 + kofs;
#pragma unroll
                        for (int i = 0; i < 4; ++i) { vp[(size_t)i * 8448] = (unsigned char)((unsigned)w0 >> (8 * i)); vp[(size_t)(4 + i) * 8448] = (unsigned char)((unsigned)w1 >> (8 * i)); } } } }
    }
};

struct EpiQRope {
    static constexpr bool PERM = true, AFTER_DRAIN = false;
    unsigned char* O; const float* tcos; const float* tsin; float ascale;
    template <class AccT> __device__ __forceinline__ void operator()(const AccT& acc, const Unit& u, int wr, int wc, int fr, int fq) const {
        const int tt = u.pm % 33; const bool latent = tt != 32; const int t0 = tt * 256;
        const int colg = u.pn * BM + wc * 32;
#pragma unroll
        for (int bj = 0; bj < 2; ++bj) {
            const int gm = ((colg + bj * HALF) >> 5) % 6; const bool rope = latent && gm >= 4; const int axis = gm - 4;
#pragma unroll
            for (int ai = 0; ai < 2; ++ai)
#pragma unroll
                for (int m = 0; m < 4; ++m) {
                    const int rloc = ai * HALF + wr * 64 + m * 16 + fr; const int t = t0 + rloc;
                    f32x4 v0 = ag(acc, ai, bj, m, 0) * ascale, v1 = ag(acc, ai, bj, m, 1) * ascale;
                    if (rope) {
                        const int comp = axis == 0 ? (t >> 6) : (t & 63); const int fo = comp * 16 + (fq & 1) * 8;
                        { const f32x4 c0 = *(const f32x4*)(tcos + fo), s0 = *(const f32x4*)(tsin + fo); f32x4 p0;
#pragma unroll
                          for (int i = 0; i < 4; ++i) p0[i] = __shfl_xor(v0[i], 32);
                          v0 = fq < 2 ? v0 * c0 - p0 * s0 : v0 * c0 + p0 * s0; }
                        { const f32x4 c1 = *(const f32x4*)(tcos + fo + 4), s1 = *(const f32x4*)(tsin + fo + 4); f32x4 p1;
#pragma unroll
                          for (int i = 0; i < 4; ++i) p1[i] = __shfl_xor(v1[i], 32);
                          v1 = fq < 2 ? v1 * c1 - p1 * s1 : v1 * c1 + p1 * s1; }
                    }
                    int w0 = 0, w1 = 0; w0 = __builtin_amdgcn_cvt_pk_fp8_f32(v0[0], v0[1], w0, false); w0 = __builtin_amdgcn_cvt_pk_fp8_f32(v0[2], v0[3], w0, true);
                    w1 = __builtin_amdgcn_cvt_pk_fp8_f32(v1[0], v1[1], w1, false); w1 = __builtin_amdgcn_cvt_pk_fp8_f32(v1[2], v1[3], w1, true);
                    *(u32x2*)(O + (size_t)(u.pm * BM + rloc) * 1536 + colg + bj * HALF + 8 * fq) = (u32x2){(unsigned)w0, (unsigned)w1};
                }
        }
    }
};

struct EpiGla {
    static constexpr bool PERM = true, AFTER_DRAIN = false;
    bf16_t* A2; bf16_t* VT;
    template <class AccT> __device__ __forceinline__ void operator()(const AccT& acc, const Unit& u, int wr, int wc, int fr, int fq) const {
        const int row0 = u.pm * BM + wr * 64 + fr; const int col0 = u.pn * BM + wc * 32 + 8 * fq; const bool isv = (u.pn >> 2) == 1;
#pragma unroll
        for (int ai = 0; ai < 2; ++ai)
#pragma unroll
            for (int m = 0; m < 4; ++m) { const int row = row0 + ai * HALF + m * 16;
#pragma unroll
                for (int bj = 0; bj < 2; ++bj) { const f32x4 v0 = ag(acc, ai, bj, m, 0), v1 = ag(acc, ai, bj, m, 1);
                    u32x4 w; w.x = cvt_pk_bf16(v0[0], v0[1]); w.y = cvt_pk_bf16(v0[2], v0[3]); w.z = cvt_pk_bf16(v1[0], v1[1]); w.w = cvt_pk_bf16(v1[2], v1[3]);
                    if (!isv) { *(u32x4*)(A2 + (size_t)row * 3328 + col0 + bj * HALF) = w; }
                    else { bf16_t* vp = VT + ((size_t)(row >> 6) * 1024 + (col0 + bj * HALF - 1024)) * 64 + (row & 63);
                        vp[0] = (bf16_t)(w.x & 0xffffu); vp[64] = (bf16_t)(w.x >> 16); vp[128] = (bf16_t)(w.y & 0xffffu); vp[192] = (bf16_t)(w.y >> 16);
                        vp[256] = (bf16_t)(w.z & 0xffffu); vp[320] = (bf16_t)(w.z >> 16); vp[384] = (bf16_t)(w.w & 0xffffu); vp[448] = (bf16_t)(w.w >> 16); } } }
    }
};

struct EpiResid {
    static constexpr bool PERM = true, AFTER_DRAIN = false;
    const float* xin; const float* ctxin; bf16_t* xres; const float* gate; float ascale;
    template <class AccT> __device__ __forceinline__ void operator()(const AccT& acc, const Unit& u, int wr, int wc, int fr, int fq) const {
        const int b = u.pm / 33, tt = u.pm % 33; const bool isctx = tt == 32; const int bs = isctx ? 4 : b;
        bf16_t* dst = xres + (size_t)u.pm * BM * 1024;
        const float* src = xin ? (isctx ? ctxin + (size_t)b * 256 * 1024 : xin + ((size_t)b * 8192 + (size_t)tt * 256) * 1024) : nullptr;
        const float* g = gate + bs * 6144;
        const int r0 = wr * 64 + fr, c0 = u.pn * BM + wc * 32 + 8 * fq;
#pragma unroll
        for (int ai = 0; ai < 2; ++ai)
#pragma unroll
            for (int m = 0; m < 4; ++m) { const size_t ro = (size_t)(r0 + ai * HALF + m * 16) * 1024;
#pragma unroll
                for (int bj = 0; bj < 2; ++bj) { const int c = c0 + bj * HALF;
                    f32x4 x0, x1;
                    if (src) { x0 = *(const f32x4*)(src + ro + c); x1 = *(const f32x4*)(src + ro + c + 4); }
                    else { const u32x4 xb = *(const u32x4*)(dst + ro + c);
                        x0 = (f32x4){__builtin_bit_cast(float, xb.x << 16), __builtin_bit_cast(float, xb.x & 0xffff0000u), __builtin_bit_cast(float, xb.y << 16), __builtin_bit_cast(float, xb.y & 0xffff0000u)};
                        x1 = (f32x4){__builtin_bit_cast(float, xb.z << 16), __builtin_bit_cast(float, xb.z & 0xffff0000u), __builtin_bit_cast(float, xb.w << 16), __builtin_bit_cast(float, xb.w & 0xffff0000u)}; }
                    const f32x4 g0 = *(const f32x4*)(g + c), g1 = *(const f32x4*)(g + c + 4);
                    const f32x4 v0 = x0 + g0 * (ag(acc, ai, bj, m, 0) * ascale), v1 = x1 + g1 * (ag(acc, ai, bj, m, 1) * ascale);
                    u32x4 w; w.x = cvt_pk_bf16(v0[0], v0[1]); w.y = cvt_pk_bf16(v0[2], v0[3]); w.z = cvt_pk_bf16(v1[0], v1[1]); w.w = cvt_pk_bf16(v1[2], v1[3]);
                    *(u32x4*)(dst + ro + c) = w; } }
    }
};

__device__ __forceinline__ float swiglu1(float g, float up) {
    g = fminf(g, 7.0f); up = fminf(fmaxf(up, -7.0f), 7.0f);
    return (up + 1.0f) * g * __builtin_amdgcn_rcpf(1.0f + __expf(-1.702f * g));
}
struct EpiSwiglu {
    static constexpr bool PERM = true, AFTER_DRAIN = false;
    unsigned char* act; const float* bgu; float ascale;
    template <class AccT> __device__ __forceinline__ void operator()(const AccT& acc, const Unit& u, int wr, int wc, int fr, int fq) const {
        const int e = u.pn >> 3, ct = u.pn & 7; const int lc0 = ct * BM + wc * 32 + 8 * fq; const int row0 = u.pm * BM + wr * 64 + fr;
#pragma unroll
        for (int bj = 0; bj < 2; ++bj) { const int lc = lc0 + bj * HALF;
            const f32x4 b0 = *(const f32x4*)(bgu + e * 2048 + lc), b1 = *(const f32x4*)(bgu + e * 2048 + lc + 4);
#pragma unroll
            for (int ai = 0; ai < 2; ++ai) { unsigned w[4];
#pragma unroll
                for (int m = 0; m < 4; ++m) { const f32x4 v0 = ag(acc, ai, bj, m, 0) * ascale + b0, v1 = ag(acc, ai, bj, m, 1) * ascale + b1;
                    int x = 0; x = __builtin_amdgcn_cvt_pk_fp8_f32(swiglu1(v0[0], v0[1]), swiglu1(v0[2], v0[3]), x, false); x = __builtin_amdgcn_cvt_pk_fp8_f32(swiglu1(v1[0], v1[1]), swiglu1(v1[2], v1[3]), x, true);
                    w[m] = (unsigned)x; }
                const auto p02 = __builtin_amdgcn_permlane32_swap(w[0], w[2], false, false), p13 = __builtin_amdgcn_permlane32_swap(w[1], w[3], false, false);
                const auto q01 = __builtin_amdgcn_permlane16_swap(p02[0], p13[0], false, false), q23 = __builtin_amdgcn_permlane16_swap(p02[1], p13[1], false, false);
                *(u32x4*)(act + (size_t)(row0 + ai * HALF + fq * 16) * 1024 + ct * HALF + wc * 16 + bj * 64) = (u32x4){q01[0], q01[1], q23[0], q23[1]}; } }
    }
};

struct LatentOrder {
    StaticOrder so;
    __device__ void init(int N, int G_, int c_) { so.init(128 * BM, N, G_, c_); }
    __device__ bool next(int i, Unit& u) const { if (!so.next(i, u)) return false; u.pm = (u.pm >> 5) * 33 + (u.pm & 31); return true; }
    __device__ __forceinline__ void a_ready(const Unit&) const {}
    __device__ __forceinline__ void done(const Unit&) const {}
};
struct MoeOrder {
    const PG8_LAS int* tstart; int sh, G, c;
    __device__ bool next(int i, Unit& u) const {
        const int NT = tstart[32]; int rt, ct;
        if ((G & 7) == 0) { const int x = c & 7, q = c >> 3, nq = G >> 3; const int uu = i * nq + q; const int per = (NT + 7) >> 3, rl = uu >> sh; if (rl >= per) return false; rt = x * per + rl; ct = uu & ((1 << sh) - 1); }
        else { const long L = (long)i * G + c; rt = (int)(L >> sh); ct = (int)(L & ((1 << sh) - 1)); }
        if (rt >= NT) return false;
        const int e = tstart[64 + rt];
        u.pm = rt; u.pn = (e << sh) + ct; return true;
    }
    __device__ __forceinline__ void a_ready(const Unit&) const {}
    __device__ __forceinline__ void done(const Unit&) const {}
};

typedef int v8i32 __attribute__((ext_vector_type(8)));
__device__ __forceinline__ v8i32 cat8(bf16x8 lo, bf16x8 hi) { typedef int v4i32 __attribute__((ext_vector_type(4))); const v4i32 a = __builtin_bit_cast(v4i32, lo), b = __builtin_bit_cast(v4i32, hi); return (v8i32){a[0], a[1], a[2], a[3], b[0], b[1], b[2], b[3]}; }
template <class Epi, class Sched, bool ALIGN_EPI = false, bool SP2 = false, bool FP8 = false>
__device__ __forceinline__ void gemm_phase(PG8_LAS unsigned char* lds, const Gemm g, const Sched& S, const Epi& E) {
    const int tid = threadIdx.x, wid = __builtin_amdgcn_readfirstlane(tid >> 6), lane = tid & 63, wr = wid >> 2, wc = wid & 3, fr = lane & 15, fq = lane >> 4;
    const int K = g.K, nt = K / BK;
    unsigned voffA[2], voffB[2];
#pragma unroll
    for (int i = 0; i < 2; ++i) { int R, C; stage_rc(tid * 16 + i * 8192, R, C); const int Rb = Epi::PERM ? ((R & ~31) + perm32(R & 31)) : R;
        voffA[i] = (unsigned)(R * K + C) * 2u; voffB[i] = (unsigned)(Rb * K + C) * 2u; }
    const size_t kstep = (size_t)(BK * 2);
    const size_t hstep = (size_t)HALF * K * 2;
    const size_t tstep = 2 * hstep;
    const unsigned ldsw = (unsigned)wid * 1024u;
    const int aoff = lds_byte(wr * 64 + fr, fq * (FP8 ? 16 : 8)), boff = lds_byte(wc * 32 + fr, fq * (FP8 ? 16 : 8));
    const int h0off = (fq & 1) * 16, h1off = 16 - h0off;
#define PG8_SA(b, h) (((b) * 2 + (h)) * HTB)
#define PG8_SB(b, h) ((4 + (b) * 2 + (h)) * HTB)
#define PG8_STAGE(bufoff, gbase, voff) do { _Pragma("unroll") for (int _i = 0; _i < 2; ++_i) \
        __builtin_amdgcn_global_load_lds((const unsigned*)((const char*)(gbase) + (voff)[_i]), (PG8_LAS unsigned*)(lds + (bufoff) + ldsw + _i * 8192), 16, 0, 0); } while (0)
#define PG8_LDA(dst, b, h) do { if constexpr (FP8) { _Pragma("unroll") for (int m = 0; m < 4; ++m) dst##8[m] = cat8(*(const PG8_LAS bf16x8*)(lds + PG8_SA(b, h) + aoff + m * 2048 + h0off), *(const PG8_LAS bf16x8*)(lds + PG8_SA(b, h) + aoff + m * 2048 + h1off)); } else { \
        _Pragma("unroll") for (int m = 0; m < 4; ++m) _Pragma("unroll") for (int k = 0; k < 2; ++k) dst[m][k] = *(const PG8_LAS bf16x8*)(lds + PG8_SA(b, h) + aoff + m * 2048 + k * 1024); } } while (0)
#define PG8_LDB(dst, b, h) do { if constexpr (FP8) { _Pragma("unroll") for (int n = 0; n < 2; ++n) dst##8[n] = cat8(*(const PG8_LAS bf16x8*)(lds + PG8_SB(b, h) + boff + n * 2048 + h0off), *(const PG8_LAS bf16x8*)(lds + PG8_SB(b, h) + boff + n * 2048 + h1off)); } else { \
        _Pragma("unroll") for (int n = 0; n < 2; ++n) _Pragma("unroll") for (int k = 0; k < 2; ++k) dst[n][k] = *(const PG8_LAS bf16x8*)(lds + PG8_SB(b, h) + boff + n * 2048 + k * 1024); } } while (0)
#define PG8_MMA(ai, bj, At, Bt) do { __builtin_amdgcn_s_setprio(1); if constexpr (FP8) { _Pragma("unroll") for (int m = 0; m < 4; ++m) _Pragma("unroll") for (int n = 0; n < 2; ++n) \
        asm volatile("v_mfma_scale_f32_16x16x128_f8f6f4 %0, %1, %2, %0, %3, %3 op_sel_hi:[0,0,0]" : "+v"(acc[ai][bj][m][n]) : "v"(Bt##8[n]), "v"(At##8[m]), "v"(sc1_)); } else { \
        _Pragma("unroll") for (int m = 0; m < 4; ++m) _Pragma("unroll") for (int n = 0; n < 2; ++n) _Pragma("unroll") for (int k = 0; k < 2; ++k) \
        acc[ai][bj][m][n] = __builtin_amdgcn_mfma_f32_16x16x32_bf16(Bt[n][k], At[m][k], acc[ai][bj][m][n], 0, 0, 0); } __builtin_amdgcn_s_setprio(0); } while (0)
#define PG8_WAIT_V(n) asm volatile("s_waitcnt vmcnt(" #n ")" ::: "memory")
#define PG8_WAIT_L(n) asm volatile("s_waitcnt lgkmcnt(" #n ")" ::: "memory")
#define PG8_BAR __builtin_amdgcn_s_barrier()
#define PG8_SCHED __builtin_amdgcn_sched_barrier(0)
    Unit cur, nxt; int ui = 0;
    if (!S.next(0, cur)) return;
    f32x4 acc[2][2][4][2];
#pragma unroll
    for (int a = 0; a < 2; ++a)
#pragma unroll
        for (int b = 0; b < 2; ++b)
#pragma unroll
            for (int m = 0; m < 4; ++m)
#pragma unroll
                for (int n = 0; n < 2; ++n) acc[a][b][m][n] = (f32x4){0.f, 0.f, 0.f, 0.f};
    bf16x8 At[4][2], B0[2][2], B1[2][2];
    v8i32 At8[4], B08[2], B18[2];
    typedef float f32x8 __attribute__((ext_vector_type(8)));
    f32x8 acc8[2][2][4];
#define PG8_ZERO8() do { _Pragma("unroll") for (int a = 0; a < 2; ++a) _Pragma("unroll") for (int b = 0; b < 2; ++b) _Pragma("unroll") for (int m = 0; m < 4; ++m) acc8[a][b][m] = (f32x8){0.f, 0.f, 0.f, 0.f, 0.f, 0.f, 0.f, 0.f}; } while (0)
#define PG8_ACC8TO4() do { if constexpr (FP8) { _Pragma("unroll") for (int a = 0; a < 2; ++a) _Pragma("unroll") for (int b = 0; b < 2; ++b) _Pragma("unroll") for (int m = 0; m < 4; ++m) { \
        acc[a][b][m][0] = __builtin_shufflevector(acc8[a][b][m], acc8[a][b][m], 0, 1, 2, 3); acc[a][b][m][1] = __builtin_shufflevector(acc8[a][b][m], acc8[a][b][m], 4, 5, 6, 7); } PG8_ZERO8(); } } while (0)
    const int sc1_ = 0x7f7f7f7f;
    const char* cA = (const char*)g.A + (size_t)cur.pm * tstep; const char* cB = (const char*)g.Bt + (size_t)cur.pn * tstep;
    S.a_ready(cur);
    if constexpr (SP2) {
        PG8_STAGE(PG8_SB(0, 0), cB, voffB); PG8_STAGE(PG8_SB(0, 1), cB + hstep, voffB); PG8_STAGE(PG8_SA(0, 0), cA, voffA); PG8_STAGE(PG8_SA(0, 1), cA + hstep, voffA);
        if (wr == 1) PG8_BAR;
        PG8_WAIT_V(2); PG8_BAR;
        PG8_STAGE(PG8_SB(1, 0), cB + kstep, voffB); PG8_STAGE(PG8_SA(1, 0), cA + kstep, voffA); PG8_STAGE(PG8_SB(1, 1), cB + hstep + kstep, voffB);
        PG8_WAIT_V(6); PG8_BAR;
    } else {
        PG8_STAGE(PG8_SB(0, 0), cB, voffB); PG8_STAGE(PG8_SA(0, 0), cA, voffA); PG8_STAGE(PG8_SB(0, 1), cB + hstep, voffB); PG8_STAGE(PG8_SA(0, 1), cA + hstep, voffA);
        if (wr == 1) PG8_BAR;
        PG8_WAIT_V(4); PG8_BAR;
        PG8_STAGE(PG8_SB(1, 0), cB + kstep, voffB); PG8_STAGE(PG8_SA(1, 0), cA + kstep, voffA); PG8_STAGE(PG8_SB(1, 1), cB + hstep + kstep, voffB);
        PG8_WAIT_V(6); PG8_BAR;
    }
    for (;;) {
        const bool has_next = S.next(ui + 1, nxt);
        const char* nA = has_next ? (const char*)g.A + (size_t)nxt.pm * tstep : cA; const char* nB = has_next ? (const char*)g.Bt + (size_t)nxt.pn * tstep : cB;
        for (int t = 0; t < nt; t += 2) {
            const bool last = (t == nt - 2);
            const char* a1 = cA + (size_t)(t + 1) * kstep;
            const char* a2 = last ? nA : cA + (size_t)(t + 2) * kstep; const char* b2 = last ? nB : cB + (size_t)(t + 2) * kstep;
            const char* a3 = a2 + kstep; const char* b3 = b2 + kstep;
            if (last && has_next) S.a_ready(nxt);
            if constexpr (SP2) {
            PG8_LDB(B0, 0, 0); PG8_LDB(B1, 0, 1); PG8_SCHED; PG8_LDA(At, 0, 0); PG8_STAGE(PG8_SA(1, 1), a1 + hstep, voffA);
            PG8_WAIT_V(8); PG8_WAIT_L(0); PG8_BAR; PG8_MMA(0, 0, At, B0); PG8_MMA(0, 1, At, B1); PG8_BAR; PG8_SCHED;
            PG8_LDA(At, 0, 1); PG8_STAGE(PG8_SB(0, 0), b2, voffB); PG8_STAGE(PG8_SB(0, 1), b2 + hstep, voffB); PG8_STAGE(PG8_SA(0, 0), a2, voffA);
            PG8_WAIT_V(8); PG8_WAIT_L(0); PG8_BAR; PG8_MMA(1, 0, At, B0); PG8_MMA(1, 1, At, B1); PG8_BAR; PG8_SCHED;
            PG8_LDB(B0, 1, 0); PG8_LDB(B1, 1, 1); PG8_SCHED; PG8_LDA(At, 1, 0); PG8_STAGE(PG8_SA(0, 1), a2 + hstep, voffA);
            PG8_WAIT_V(8); PG8_WAIT_L(0); PG8_BAR; PG8_MMA(0, 0, At, B0); PG8_MMA(0, 1, At, B1); PG8_BAR; PG8_SCHED;
            PG8_LDA(At, 1, 1); PG8_STAGE(PG8_SB(1, 0), b3, voffB); PG8_STAGE(PG8_SB(1, 1), b3 + hstep, voffB); PG8_STAGE(PG8_SA(1, 0), a3, voffA);
            PG8_WAIT_V(8); PG8_WAIT_L(0); PG8_BAR; PG8_MMA(1, 0, At, B0); PG8_MMA(1, 1, At, B1); PG8_BAR; PG8_SCHED;
            } else {
            PG8_LDB(B0, 0, 0); PG8_SCHED; PG8_LDA(At, 0, 0); PG8_STAGE(PG8_SA(1, 1), a1 + hstep, voffA);
            PG8_WAIT_L(8); PG8_BAR; PG8_WAIT_L(0); PG8_MMA(0, 0, At, B0); PG8_BAR; PG8_SCHED;
            PG8_LDB(B1, 0, 1); PG8_STAGE(PG8_SB(0, 0), b2, voffB);
            PG8_BAR; PG8_WAIT_L(0); PG8_MMA(0, 1, At, B1); PG8_BAR;
            PG8_LDA(At, 0, 1); PG8_STAGE(PG8_SA(0, 0), a2, voffA);
            PG8_BAR; PG8_WAIT_L(0); PG8_MMA(1, 0, At, B0); PG8_BAR; PG8_SCHED;
            PG8_STAGE(PG8_SB(0, 1), b2 + hstep, voffB);
            PG8_WAIT_V(6); PG8_BAR; PG8_MMA(1, 1, At, B1); PG8_BAR;
            PG8_LDB(B0, 1, 0); PG8_SCHED; PG8_LDA(At, 1, 0); PG8_STAGE(PG8_SA(0, 1), a2 + hstep, voffA);
            PG8_WAIT_L(8); PG8_BAR; PG8_WAIT_L(0); PG8_MMA(0, 0, At, B0); PG8_BAR; PG8_SCHED;
            PG8_LDB(B1, 1, 1); PG8_STAGE(PG8_SB(1, 0), b3, voffB);
            PG8_BAR; PG8_WAIT_L(0); PG8_MMA(0, 1, At, B1); PG8_BAR;
            PG8_LDA(At, 1, 1); PG8_STAGE(PG8_SA(1, 0), a3, voffA);
            PG8_BAR; PG8_WAIT_L(0); PG8_MMA(1, 0, At, B0); PG8_BAR; PG8_SCHED;
            PG8_STAGE(PG8_SB(1, 1), b3 + hstep, voffB);
            PG8_WAIT_V(6); PG8_BAR; PG8_MMA(1, 1, At, B1); PG8_BAR;
            }
        }
        if constexpr (ALIGN_EPI) { if (wr == 0) PG8_BAR; }
        if constexpr (!Epi::AFTER_DRAIN) { if constexpr (FP8) asm volatile("s_nop 15\n\ts_nop 15" ::: "memory"); E(acc, cur, wr, wc, fr, fq); S.done(cur); }
        if (!has_next) break;
#pragma unroll
        for (int a = 0; a < 2; ++a)
#pragma unroll
            for (int b = 0; b < 2; ++b)
#pragma unroll
                for (int m = 0; m < 4; ++m)
#pragma unroll
                    for (int n = 0; n < 2; ++n) acc[a][b][m][n] = (f32x4){0.f, 0.f, 0.f, 0.f};
        cur = nxt; cA = nA; cB = nB; ++ui;
        if constexpr (ALIGN_EPI) { if (wr == 1) PG8_BAR; }
    }
    PG8_WAIT_V(0);
    if constexpr (!ALIGN_EPI) { if (wr == 0) PG8_BAR; }
    PG8_BAR;
    if constexpr (Epi::AFTER_DRAIN) { E.fused(acc, cur, wr, wc, fr, fq, lds, wid, lane); S.done(cur); }
#undef PG8_ZERO8
#undef PG8_ACC8TO4
#undef PG8_SA
#undef PG8_SB
#undef PG8_STAGE
#undef PG8_LDA
#undef PG8_LDB
#undef PG8_MMA
#undef PG8_WAIT_V
#undef PG8_WAIT_L
#undef PG8_BAR
#undef PG8_SCHED
}

template <class Epi, class Sched, bool FP8 = false>
__device__ __forceinline__ void gemm_phase_gather(PG8_LAS unsigned char* lds, const Gemm g, const int* rowidx, const Sched& S, const Epi& E) {
    const int tid = threadIdx.x, wid = __builtin_amdgcn_readfirstlane(tid >> 6), lane = tid & 63, wr = wid >> 2, wc = wid & 3, fr = lane & 15, fq = lane >> 4;
    const int K = g.K, nt = K / BK;
    int RA[2]; unsigned CA2[2], voffB[2];
#pragma unroll
    for (int i = 0; i < 2; ++i) { int R, C; stage_rc(tid * 16 + i * 8192, R, C); const int Rb = Epi::PERM ? ((R & ~31) + perm32(R & 31)) : R;
        RA[i] = R; CA2[i] = (unsigned)C * 2u; voffB[i] = (unsigned)(Rb * K + C) * 2u; }
    const size_t kstep = (size_t)(BK * 2);
    const size_t hstep = (size_t)HALF * K * 2;
    const size_t tstep = 2 * hstep;
    const unsigned ldsw = (unsigned)wid * 1024u;
    const unsigned rowb = (unsigned)K * 2u;
    const int aoff = lds_byte(wr * 64 + fr, fq * (FP8 ? 16 : 8)), boff = lds_byte(wc * 32 + fr, fq * (FP8 ? 16 : 8));
    const int h0off = (fq & 1) * 16, h1off = 16 - h0off;
#define PG8_SA(b, h) (((b) * 2 + (h)) * HTB)
#define PG8_SB(b, h) ((4 + (b) * 2 + (h)) * HTB)
#define PG8_STAGE(bufoff, gbase, voff) do { _Pragma("unroll") for (int _i = 0; _i < 2; ++_i) \
        __builtin_amdgcn_global_load_lds((const unsigned*)((const char*)(gbase) + (voff)[_i]), (PG8_LAS unsigned*)(lds + (bufoff) + ldsw + _i * 8192), 16, 0, 0); } while (0)
#define PG8_STAGEA(bufoff, offs, kb) do { _Pragma("unroll") for (int _i = 0; _i < 2; ++_i) \
        __builtin_amdgcn_global_load_lds((const unsigned*)((const char*)g.A + (size_t)(offs)[_i] + (size_t)(kb)), (PG8_LAS unsigned*)(lds + (bufoff) + ldsw + _i * 8192), 16, 0, 0); } while (0)
#define PG8_GIDX(d0, d1, pm_) do { _Pragma("unroll") for (int _i = 0; _i < 2; ++_i) { const int r0_ = rowidx[(size_t)(pm_) * BM + RA[_i]], r1_ = rowidx[(size_t)(pm_) * BM + HALF + RA[_i]]; \
        d0[_i] = (unsigned)r0_ * rowb + CA2[_i]; d1[_i] = (unsigned)r1_ * rowb + CA2[_i]; } } while (0)
#define PG8_LDA(dst, b, h) do { if constexpr (FP8) { _Pragma("unroll") for (int m = 0; m < 4; ++m) dst##8[m] = cat8(*(const PG8_LAS bf16x8*)(lds + PG8_SA(b, h) + aoff + m * 2048 + h0off), *(const PG8_LAS bf16x8*)(lds + PG8_SA(b, h) + aoff + m * 2048 + h1off)); } else { \
        _Pragma("unroll") for (int m = 0; m < 4; ++m) _Pragma("unroll") for (int k = 0; k < 2; ++k) dst[m][k] = *(const PG8_LAS bf16x8*)(lds + PG8_SA(b, h) + aoff + m * 2048 + k * 1024); } } while (0)
#define PG8_LDB(dst, b, h) do { if constexpr (FP8) { _Pragma("unroll") for (int n = 0; n < 2; ++n) dst##8[n] = cat8(*(const PG8_LAS bf16x8*)(lds + PG8_SB(b, h) + boff + n * 2048 + h0off), *(const PG8_LAS bf16x8*)(lds + PG8_SB(b, h) + boff + n * 2048 + h1off)); } else { \
        _Pragma("unroll") for (int n = 0; n < 2; ++n) _Pragma("unroll") for (int k = 0; k < 2; ++k) dst[n][k] = *(const PG8_LAS bf16x8*)(lds + PG8_SB(b, h) + boff + n * 2048 + k * 1024); } } while (0)
#define PG8_MMA(ai, bj, At, Bt) do { __builtin_amdgcn_s_setprio(1); if constexpr (FP8) { _Pragma("unroll") for (int m = 0; m < 4; ++m) _Pragma("unroll") for (int n = 0; n < 2; ++n) \
        asm volatile("v_mfma_scale_f32_16x16x128_f8f6f4 %0, %1, %2, %0, %3, %3 op_sel_hi:[0,0,0]" : "+v"(acc[ai][bj][m][n]) : "v"(Bt##8[n]), "v"(At##8[m]), "v"(sc1_)); } else { \
        _Pragma("unroll") for (int m = 0; m < 4; ++m) _Pragma("unroll") for (int n = 0; n < 2; ++n) _Pragma("unroll") for (int k = 0; k < 2; ++k) \
        acc[ai][bj][m][n] = __builtin_amdgcn_mfma_f32_16x16x32_bf16(Bt[n][k], At[m][k], acc[ai][bj][m][n], 0, 0, 0); } __builtin_amdgcn_s_setprio(0); } while (0)
#define PG8_WAIT_V(n) asm volatile("s_waitcnt vmcnt(" #n ")" ::: "memory")
#define PG8_WAIT_L(n) asm volatile("s_waitcnt lgkmcnt(" #n ")" ::: "memory")
#define PG8_BAR __builtin_amdgcn_s_barrier()
#define PG8_SCHED __builtin_amdgcn_sched_barrier(0)
    Unit cur, nxt; int ui = 0;
    if (!S.next(0, cur)) return;
    f32x4 acc[2][2][4][2];
#pragma unroll
    for (int a = 0; a < 2; ++a)
#pragma unroll
        for (int b = 0; b < 2; ++b)
#pragma unroll
            for (int m = 0; m < 4; ++m)
#pragma unroll
                for (int n = 0; n < 2; ++n) acc[a][b][m][n] = (f32x4){0.f, 0.f, 0.f, 0.f};
    bf16x8 At[4][2], B0[2][2], B1[2][2];
    v8i32 At8[4], B08[2], B18[2];
    typedef float f32x8 __attribute__((ext_vector_type(8)));
    f32x8 acc8[2][2][4];
#define PG8_ZERO8() do { _Pragma("unroll") for (int a = 0; a < 2; ++a) _Pragma("unroll") for (int b = 0; b < 2; ++b) _Pragma("unroll") for (int m = 0; m < 4; ++m) acc8[a][b][m] = (f32x8){0.f, 0.f, 0.f, 0.f, 0.f, 0.f, 0.f, 0.f}; } while (0)
#define PG8_ACC8TO4() do { if constexpr (FP8) { _Pragma("unroll") for (int a = 0; a < 2; ++a) _Pragma("unroll") for (int b = 0; b < 2; ++b) _Pragma("unroll") for (int m = 0; m < 4; ++m) { \
        acc[a][b][m][0] = __builtin_shufflevector(acc8[a][b][m], acc8[a][b][m], 0, 1, 2, 3); acc[a][b][m][1] = __builtin_shufflevector(acc8[a][b][m], acc8[a][b][m], 4, 5, 6, 7); } PG8_ZERO8(); } } while (0)
    const int sc1_ = 0x7f7f7f7f;
    unsigned ga0[2], ga1[2], gn0[2], gn1[2];
    PG8_GIDX(ga0, ga1, cur.pm);
    const char* cB = (const char*)g.Bt + (size_t)cur.pn * tstep;
    S.a_ready(cur);
    PG8_STAGE(PG8_SB(0, 0), cB, voffB); PG8_STAGE(PG8_SB(0, 1), cB + hstep, voffB); PG8_STAGEA(PG8_SA(0, 0), ga0, 0); PG8_STAGEA(PG8_SA(0, 1), ga1, 0);
    if (wr == 1) PG8_BAR;
    PG8_WAIT_V(2); PG8_BAR;
    PG8_STAGE(PG8_SB(1, 0), cB + kstep, voffB); PG8_STAGEA(PG8_SA(1, 0), ga0, kstep); PG8_STAGE(PG8_SB(1, 1), cB + hstep + kstep, voffB);
    PG8_WAIT_V(6); PG8_BAR;
    for (;;) {
        const bool has_next = S.next(ui + 1, nxt);
        if (has_next) { PG8_GIDX(gn0, gn1, nxt.pm); } else { gn0[0] = ga0[0]; gn0[1] = ga0[1]; gn1[0] = ga1[0]; gn1[1] = ga1[1]; }
        const char* nB = has_next ? (const char*)g.Bt + (size_t)nxt.pn * tstep : cB;
        for (int t = 0; t < nt; t += 2) {
            const bool last = (t == nt - 2);
            const size_t k1 = (size_t)(t + 1) * kstep;
            const size_t k2 = last ? (size_t)0 : (size_t)(t + 2) * kstep;
            unsigned s0[2], s1[2];
            s0[0] = last ? gn0[0] : ga0[0]; s0[1] = last ? gn0[1] : ga0[1]; s1[0] = last ? gn1[0] : ga1[0]; s1[1] = last ? gn1[1] : ga1[1];
            const char* b2 = last ? nB : cB + (size_t)(t + 2) * kstep;
            const char* b3 = b2 + kstep;
            if (last && has_next) S.a_ready(nxt);
            PG8_LDB(B0, 0, 0); PG8_LDB(B1, 0, 1); PG8_SCHED; PG8_LDA(At, 0, 0); PG8_STAGEA(PG8_SA(1, 1), ga1, k1);
            PG8_WAIT_V(8); PG8_WAIT_L(0); PG8_BAR; PG8_MMA(0, 0, At, B0); PG8_MMA(0, 1, At, B1); PG8_BAR; PG8_SCHED;
            PG8_LDA(At, 0, 1); PG8_STAGE(PG8_SB(0, 0), b2, voffB); PG8_STAGE(PG8_SB(0, 1), b2 + hstep, voffB); PG8_STAGEA(PG8_SA(0, 0), s0, k2);
            PG8_WAIT_V(8); PG8_WAIT_L(0); PG8_BAR; PG8_MMA(1, 0, At, B0); PG8_MMA(1, 1, At, B1); PG8_BAR; PG8_SCHED;
            PG8_LDB(B0, 1, 0); PG8_LDB(B1, 1, 1); PG8_SCHED; PG8_LDA(At, 1, 0); PG8_STAGEA(PG8_SA(0, 1), s1, k2);
            PG8_WAIT_V(8); PG8_WAIT_L(0); PG8_BAR; PG8_MMA(0, 0, At, B0); PG8_MMA(0, 1, At, B1); PG8_BAR; PG8_SCHED;
            PG8_LDA(At, 1, 1); PG8_STAGE(PG8_SB(1, 0), b3, voffB); PG8_STAGE(PG8_SB(1, 1), b3 + hstep, voffB); PG8_STAGEA(PG8_SA(1, 0), s0, k2 + kstep);
            PG8_WAIT_V(8); PG8_WAIT_L(0); PG8_BAR; PG8_MMA(1, 0, At, B0); PG8_MMA(1, 1, At, B1); PG8_BAR; PG8_SCHED;
        }
        if (wr == 0) PG8_BAR;
        if constexpr (FP8) asm volatile("s_nop 15\n\ts_nop 15" ::: "memory"); E(acc, cur, wr, wc, fr, fq); S.done(cur);
        if (!has_next) break;
#pragma unroll
        for (int a = 0; a < 2; ++a)
#pragma unroll
            for (int b = 0; b < 2; ++b)
#pragma unroll
                for (int m = 0; m < 4; ++m)
#pragma unroll
                    for (int n = 0; n < 2; ++n) acc[a][b][m][n] = (f32x4){0.f, 0.f, 0.f, 0.f};
        cur = nxt; cB = nB; ga0[0] = gn0[0]; ga0[1] = gn0[1]; ga1[0] = gn1[0]; ga1[1] = gn1[1]; ++ui;
        if (wr == 1) PG8_BAR;
    }
    PG8_WAIT_V(0);
    PG8_BAR;
#undef PG8_ZERO8
#undef PG8_ACC8TO4
#undef PG8_SA
#undef PG8_SB
#undef PG8_STAGE
#undef PG8_STAGEA
#undef PG8_GIDX
#undef PG8_LDA
#undef PG8_LDB
#undef PG8_MMA
#undef PG8_WAIT_V
#undef PG8_WAIT_L
#undef PG8_BAR
#undef PG8_SCHED
}
}
#define XB_TMO      128
#define XB_XCNT(j)  (256  + 64 * (j))
#define XB_XSUB(j)  (1280 + 64 * (j))
#define XB_XGEN(j)  (2304 + 64 * (j))
#define XB_TOP      3328
#define XB_TOPGEN   3392
#define XCD_BAR_WORDS 3456
#define XB_SPIN_CAP (1u << 18)

__device__ __forceinline__ unsigned xb_ld(unsigned* p)              { return __hip_atomic_load(p, __ATOMIC_RELAXED, __HIP_MEMORY_SCOPE_AGENT); }
__device__ __forceinline__ unsigned xb_add(unsigned* p, unsigned v) { return __hip_atomic_fetch_add(p, v, __ATOMIC_RELAXED, __HIP_MEMORY_SCOPE_AGENT); }
__device__ __forceinline__ unsigned xb_xcc_id() { return (unsigned)__builtin_amdgcn_s_getreg((3 << 11) | 20) & 0xFu; }
#define XB_SPIN(cond, bar) do { unsigned _sp = 0; while (cond) { __builtin_amdgcn_s_sleep(1); \
    if ((++_sp & 255u) == 0u) { if (xb_ld(&(bar)[XB_TMO])) break; if (_sp > XB_SPIN_CAP) { atomicAdd(&(bar)[XB_TMO], 1u); break; } } } } while (0)

struct XcdBarrier {
    unsigned* bar; unsigned x;
    volatile LAS unsigned* st;
};

__device__ __forceinline__ XcdBarrier xcd_barrier_post(unsigned* bar, volatile LAS unsigned* st) {
    XcdBarrier b; b.bar = bar; b.x = xb_xcc_id(); b.st = st;
    if (threadIdx.x == 0) (void)xb_add(&bar[XB_XCNT(b.x)], 1u);
    return b;
}
__device__ __forceinline__ void xcd_barrier_complete(unsigned* bar, unsigned x, unsigned& nloc, unsigned& nx) {
    const unsigned G = gridDim.x * gridDim.y * gridDim.z;
    unsigned sum, cnt, mine, sp = 0u;
    for (;;) {
        sum = 0u; cnt = 0u; mine = 0u;
#pragma unroll
        for (unsigned j = 0; j < 16; ++j) { const unsigned c = xb_ld(&bar[XB_XCNT(j)]); sum += c; cnt += (c > 0u) ? 1u : 0u; mine = (j == x) ? c : mine; }
        if (sum == G) break;
        __builtin_amdgcn_s_sleep(1);
        if ((++sp & 255u) == 0u) { if (xb_ld(&bar[XB_TMO])) break; if (sp > XB_SPIN_CAP) { atomicAdd(&bar[XB_TMO], 1u); break; } }
    }
    nloc = mine > 0u ? mine : 1u; nx = cnt > 0u ? cnt : 1u;
}

__device__ __forceinline__ void xcd_barrier(const XcdBarrier& b) {
    asm volatile("s_waitcnt vmcnt(0)" ::: "memory");
    __syncthreads();
    if (threadIdx.x == 0) {
        unsigned* bar = b.bar;
        __builtin_amdgcn_s_waitcnt(0);
        unsigned nloc = b.st[0], nx = b.st[1];
        if (nloc == 0u) { xcd_barrier_complete(bar, b.x, nloc, nx); b.st[0] = nloc; b.st[1] = nx; }
        const unsigned old = xb_add(&bar[XB_XSUB(b.x)], 1u);
        const unsigned gen = old / nloc;
        if (old + 1u == (gen + 1u) * nloc) {
            __builtin_amdgcn_fence(__ATOMIC_RELEASE, "agent");
            asm volatile("s_waitcnt vmcnt(0)" ::: "memory");
            const unsigned og = xb_add(&bar[XB_TOP], 1u);
            const unsigned tg = og / nx;
            if (og + 1u == (tg + 1u) * nx) xb_add(&bar[XB_TOPGEN], 1u);
            else XB_SPIN(xb_ld(&bar[XB_TOPGEN]) == tg, bar);
            __builtin_amdgcn_fence(__ATOMIC_ACQUIRE, "agent");
            xb_add(&bar[XB_XGEN(b.x)], 1u);
            asm volatile("s_waitcnt vmcnt(0)" ::: "memory");
        } else {
            XB_SPIN(xb_ld(&bar[XB_XGEN(b.x)]) == gen, bar);
            __builtin_amdgcn_fence(__ATOMIC_ACQUIRE, "agent");
            asm volatile("s_waitcnt vmcnt(0)" ::: "memory");
        }
    }
    __syncthreads();
}

struct Ctx {
    LAS unsigned char* lds; unsigned char* ws; int tid, lane, wave, G, blk;
};
__device__ __forceinline__ int tok2row(int tok, bool latent_only) { return latent_only ? (tok >> 13) * TPB + (tok & 8191) : tok; }

__device__ __forceinline__ void p0_transpose_item(const float* W, int K, int N, bf16* WT, int row_off, LAS float* scr, int item, int lane) {
    const int nblk = N / 32, kb = item / nblk, nb = item % nblk, k0 = 64 * kb, n0 = 32 * nb;
#pragma unroll 8
    for (int i = 0; i < 32; ++i) { const int kk = 2 * i + (lane >> 5); scr[kk * 33 + (lane & 31)] = W[(size_t)(k0 + kk) * N + n0 + (lane & 31)]; }
    LDS_WAIT(); asm volatile("" ::: "memory");
    const int c = lane & 7;
#pragma unroll
    for (int j = 0; j < 4; ++j) { const int n = (lane >> 3) + 8 * j; const LAS float* s = scr + (8 * c) * 33 + n;
        v4u o; o.x = pk2(s[0 * 33], s[1 * 33]); o.y = pk2(s[2 * 33], s[3 * 33]); o.z = pk2(s[4 * 33], s[5 * 33]); o.w = pk2(s[6 * 33], s[7 * 33]);
        *(GAS v4u*)(WT + (size_t)(row_off + n0 + n) * K + k0 + 8 * c) = o; }
    LDS_WAIT(); asm volatile("" ::: "memory");
}

__device__ __forceinline__ void p0_transpose_item8(const float* W, int K, int N, unsigned char* WT, int row_off, LAS float* scr, int item, int lane) {
    const int nblk = N / 32, kb = item / nblk, nb = item % nblk, k0 = 64 * kb, n0 = 32 * nb;
#pragma unroll 8
    for (int i = 0; i < 32; ++i) { const int kk = 2 * i + (lane >> 5); scr[kk * 33 + (lane & 31)] = W[(size_t)(k0 + kk) * N + n0 + (lane & 31)]; }
    LDS_WAIT(); asm volatile("" ::: "memory");
    const int c = lane & 3;
#pragma unroll
    for (int j = 0; j < 2; ++j) { const int n = (lane >> 2) + 16 * j; const LAS float* s = scr + (16 * c) * 33 + n;
        int w[4];
#pragma unroll
        for (int q = 0; q < 4; ++q) { int x = 0; x = __builtin_amdgcn_cvt_pk_fp8_f32(32.0f * s[(4 * q) * 33], 32.0f * s[(4 * q + 1) * 33], x, false); x = __builtin_amdgcn_cvt_pk_fp8_f32(32.0f * s[(4 * q + 2) * 33], 32.0f * s[(4 * q + 3) * 33], x, true); w[q] = x; }
        *(GAS v4u*)(WT + (size_t)(row_off + n0 + n) * K + k0 + 16 * c) = (v4u){(unsigned)w[0], (unsigned)w[1], (unsigned)w[2], (unsigned)w[3]}; }
    LDS_WAIT(); asm volatile("" ::: "memory");
}

__device__ __forceinline__ void phase_prologue(const KP& p, const Ctx& F) {
    unsigned char* ws = F.ws;
    if (F.blk < 192) {
        LAS float* sc = (LAS float*)F.lds;
        LAS float* part = (LAS float*)(F.lds + 20480);
        for (int i = F.tid; i < 5120; i += 512) { const int bs = i >> 10, k = i & 1023; const float cv = bs < 4 ? p.c[bs * 1024 + k] : p.c_ctx[k]; sc[i] = cv / (1.0f + expf(-cv)); }
        __syncthreads();
        float* modv = (float*)(ws + WS_MODV);
        for (int u = F.blk; u < 192; u += F.G) {
            const int layer = u / 96, n0 = (u % 96) * 64;
            float a0 = 0.f, a1 = 0.f, a2 = 0.f, a3 = 0.f, a4 = 0.f;
            const float* W = p.mod_w + (size_t)layer * 1024 * 6144 + n0 + F.lane;
#pragma unroll 32
            for (int kk = 0; kk < 128; ++kk) { const int k = F.wave * 128 + kk; const float w = W[(size_t)k * 6144];
                a0 += sc[k] * w; a1 += sc[1024 + k] * w; a2 += sc[2048 + k] * w; a3 += sc[3072 + k] * w; a4 += sc[4096 + k] * w; }
            part[(F.wave * 5 + 0) * 64 + F.lane] = a0; part[(F.wave * 5 + 1) * 64 + F.lane] = a1; part[(F.wave * 5 + 2) * 64 + F.lane] = a2;
            part[(F.wave * 5 + 3) * 64 + F.lane] = a3; part[(F.wave * 5 + 4) * 64 + F.lane] = a4;
            __syncthreads();
            if (F.tid < 320) { const int bs = F.tid >> 6, l = F.tid & 63; float s = 0.f;
#pragma unroll
                for (int w = 0; w < 8; ++w) s += part[(w * 5 + bs) * 64 + l];
                modv[(size_t)(layer * 5 + bs) * 6144 + n0 + l] = s + p.mod_b[layer * 6144 + n0 + l]; }
            __syncthreads();
        }
    }
    __syncthreads();
    const int gt = F.blk * 512 + F.tid, NGT = F.G * 512;
    { float* tc = (float*)(ws + WS_ROPE); float* tsn = tc + 2048;
      for (int i = gt; i < 2048; i += NGT) { const int comp = i >> 4, f = i & 15; const float inv = powf(10000.0f, -(float)f / 16.0f); const float ang = (float)comp * inv; tc[i] = cosf(ang); tsn[i] = sinf(ang); } }
    { bf16* WG = (bf16*)(ws + WS_W_GIN); bf16* WI = (bf16*)(ws + WS_W_IN);
      for (int i = gt; i < 32 * 1024; i += NGT) { const int rr = i >> 10, k = i & 1023; const int dir = rr >> 4, j = rr & 15;
          WG[(size_t)(3072 + rr) * 1024 + k] = (bf16)f2bf(p.gla_w_gate1[((size_t)dir * 1024 + k) * 16 + j]); }
      for (int i = gt; i < 224 * 1024 / 8; i += NGT) *(v4u*)(WG + (size_t)3104 * 1024 + (size_t)i * 8) = (v4u){0u, 0u, 0u, 0u};
      for (int i = gt; i < 192 * 1024 / 16; i += NGT) *(v4u*)((unsigned char*)WI + (size_t)832 * 1024 + (size_t)i * 16) = (v4u){0u, 0u, 0u, 0u}; }
    LAS float* scr = (LAS float*)(F.lds + F.wave * 16384);
    const int gw = F.blk * 8 + F.wave, NGW = F.G * 8;
    constexpr int I_IN = 16 * 26, I_UQ = 8 * 48, I_UKV = 4 * 64, I_O = 16 * 32, I_GIN = 16 * 96, I_GO = 16 * 32, I_GU = 16 * 64, I_DN = 16 * 32;
    constexpr int I_SMALL = I_IN + I_UQ + I_UKV + I_O + I_GIN + I_GO;
    constexpr int NITEMS = I_SMALL + 64 * I_GU + 64 * I_DN;
    for (int it = gw; it < NITEMS; it += NGW) {
        int r = it;
        if (r < I_IN) { p0_transpose_item8(p.mla_w_in, 1024, 832, ws + WS_W_IN, 0, scr, r, F.lane); continue; } r -= I_IN;
        if (r < I_UQ) { p0_transpose_item8(p.mla_w_uq, 512, 1536, ws + WS_W_UQ, 0, scr, r, F.lane); continue; } r -= I_UQ;
        if (r < I_UKV) { p0_transpose_item8(p.mla_w_ukv, 256, 2048, ws + WS_W_UKV, 0, scr, r, F.lane); continue; } r -= I_UKV;
        if (r < I_O) { p0_transpose_item8(p.mla_w_o, 1024, 1024, ws + WS_W_O, 0, scr, r, F.lane); continue; } r -= I_O;
        if (r < I_GIN) { p0_transpose_item(p.gla_w_in, 1024, 3072, (bf16*)(ws + WS_W_GIN), 0, scr, r, F.lane); continue; } r -= I_GIN;
        if (r < I_GO) { p0_transpose_item(p.gla_w_o, 1024, 1024, (bf16*)(ws + WS_W_GO), 0, scr, r, F.lane); continue; } r -= I_GO;
        if (r < 64 * I_GU) { const int mat = r / I_GU, rr = r % I_GU;
            p0_transpose_item8(p.moe_w_gu + (size_t)mat * 1024 * 2048, 1024, 2048, ws + WS_W_GU, mat * 2048, scr, rr, F.lane); continue; } r -= 64 * I_GU;
        { const int mat = r / I_DN, rr = r % I_DN;
            p0_transpose_item8(p.moe_w_down + (size_t)mat * 1024 * 1024, 1024, 1024, ws + WS_W_DN, mat * 1024, scr, rr, F.lane); }
    }
}

__device__ __forceinline__ void norm_mod_store(const f32x4 (&v)[4], const float* gw, const float* scv, const float* shv, bf16* orow, int lane) {
    float ss = 0.f;
#pragma unroll
    for (int j = 0; j < 4; ++j) ss += (v[j].x * v[j].x + v[j].y * v[j].y) + (v[j].z * v[j].z + v[j].w * v[j].w);
    const float rstd = 1.0f / sqrtf(wave_sum(ss) * (1.0f / 1024.0f) + EPS);
#pragma unroll
    for (int j = 0; j < 4; ++j) { const int c = 4 * lane + 256 * j;
        const f32x4 g = *(const f32x4*)(gw + c), sc = *(const f32x4*)(scv + c), sh = *(const f32x4*)(shv + c);
        const f32x4 h = (v[j] * rstd) * g * (sc + 1.0f) + sh;
        v2u o; o.x = pk2(h.x, h.y); o.y = pk2(h.z, h.w); *(v2u*)(orow + c) = o; }
}

__device__ __forceinline__ void norm_mod_store8(const f32x4 (&v)[4], const float* gw, const float* scv, const float* shv, unsigned char* orow, int lane) {
    float ss = 0.f;
#pragma unroll
    for (int j = 0; j < 4; ++j) ss += (v[j].x * v[j].x + v[j].y * v[j].y) + (v[j].z * v[j].z + v[j].w * v[j].w);
    const float rstd = 1.0f / sqrtf(wave_sum(ss) * (1.0f / 1024.0f) + EPS);
#pragma unroll
    for (int j = 0; j < 4; ++j) { const int c = 4 * lane + 256 * j;
        const f32x4 g = *(const f32x4*)(gw + c), sc = *(const f32x4*)(scv + c), sh = *(const f32x4*)(shv + c);
        const f32x4 h = (v[j] * rstd) * g * (sc + 1.0f) + sh;
        int w8 = 0; w8 = __builtin_amdgcn_cvt_pk_fp8_f32(h.x, h.y, w8, false); w8 = __builtin_amdgcn_cvt_pk_fp8_f32(h.z, h.w, w8, true); *(int*)(orow + c) = w8; }
}

__device__ __forceinline__ void phase_norm1_l0(const KP& p, const Ctx& F) {
    const float* modv = (const float*)(F.ws + WS_MODV); unsigned char* H8 = F.ws + WS_H8;
    const int gw = F.blk * 8 + F.wave, NGW = F.G * 8;
    for (int r = gw; r < M; r += NGW) {
        const int b = r / TPB, t = r % TPB; const bool lat = t < SEQ; const int bs = lat ? b : 4;
        const float* xr = lat ? p.x + ((size_t)b * SEQ + t) * 1024 : p.ctx + ((size_t)b * LC + (t - SEQ)) * 1024;
        f32x4 v[4];
#pragma unroll
        for (int j = 0; j < 4; ++j) v[j] = *(const f32x4*)(xr + 4 * F.lane + 256 * j);
        const float* mv = modv + (size_t)bs * 6144;
        norm_mod_store8(v, p.norm1, mv + 1024, mv, H8 + (size_t)r * 1024, F.lane);
    }
}

__device__ __forceinline__ void phase_mla_thin(const KP& p, const Ctx& F) {
    const bf16* A1 = (const bf16*)(F.ws + WS_A1); unsigned char* CQ8 = F.ws + WS_CQ8; unsigned char* CKV8 = F.ws + WS_CKV8; unsigned char* KR8 = F.ws + WS_KR8;
    const float* tc = (const float*)(F.ws + WS_ROPE); const float* tsn = tc + 2048;
    const int gw = F.blk * 8 + F.wave, NGW = F.G * 8, lane = F.lane;
    for (int r = gw; r < M; r += NGW) {
        const bf16* ar = A1 + (size_t)r * 1024; const int t = r % TPB;
        const v4u qa = *(const v4u*)(ar + 8 * lane);
        float q[8] = {bflo(qa.x), bfhi(qa.x), bflo(qa.y), bfhi(qa.y), bflo(qa.z), bfhi(qa.z), bflo(qa.w), bfhi(qa.w)};
        float ss = 0.f;
#pragma unroll
        for (int i = 0; i < 8; ++i) ss += q[i] * q[i];
        const float rq = 1.0f / sqrtf(wave_sum(ss) * (1.0f / 512.0f) + EPS);
        const f32x4 g0 = *(const f32x4*)(p.mla_q_norm + 8 * lane), g1 = *(const f32x4*)(p.mla_q_norm + 8 * lane + 4);
        { int a = 0, b2 = 0; a = __builtin_amdgcn_cvt_pk_fp8_f32(q[0] * rq * g0.x, q[1] * rq * g0.y, a, false); a = __builtin_amdgcn_cvt_pk_fp8_f32(q[2] * rq * g0.z, q[3] * rq * g0.w, a, true);
          b2 = __builtin_amdgcn_cvt_pk_fp8_f32(q[4] * rq * g1.x, q[5] * rq * g1.y, b2, false); b2 = __builtin_amdgcn_cvt_pk_fp8_f32(q[6] * rq * g1.z, q[7] * rq * g1.w, b2, true);
          *(v2u*)(CQ8 + (size_t)r * 512 + 8 * lane) = (v2u){(unsigned)a, (unsigned)b2}; }
        const v2u ka = *(const v2u*)(ar + 512 + 4 * lane);
        const float k0 = bflo(ka.x), k1 = bfhi(ka.x), k2 = bflo(ka.y), k3 = bfhi(ka.y);
        const float rk = 1.0f / sqrtf(wave_sum(k0 * k0 + k1 * k1 + k2 * k2 + k3 * k3) * (1.0f / 256.0f) + EPS);
        const f32x4 gk = *(const f32x4*)(p.mla_kv_norm + 4 * lane);
        { int a = 0; a = __builtin_amdgcn_cvt_pk_fp8_f32(k0 * rk * gk.x, k1 * rk * gk.y, a, false); a = __builtin_amdgcn_cvt_pk_fp8_f32(k2 * rk * gk.z, k3 * rk * gk.w, a, true); *(int*)(CKV8 + (size_t)r * 256 + 4 * lane) = a; }
        float val = bf2f(ar[768 + lane]);
        const float other = __shfl_xor(val, 16);
        if (t < SEQ) { const int axis = lane >> 5, half = (lane >> 4) & 1, f = lane & 15; const int comp = axis == 0 ? (t >> 6) : (t & 63);
            const float cs = tc[comp * 16 + f], sn = tsn[comp * 16 + f];
            val = half == 0 ? val * cs - other * sn : val * cs + other * sn; }
        KR8[(size_t)r * 64 + lane] = (unsigned char)(__builtin_amdgcn_cvt_pk_fp8_f32(val, 0.f, 0, false) & 0xff);
    }
}

__device__ __forceinline__ void phase_router(const KP& p, const Ctx& F, int layer, bool latent_only) {
    const int ntok = latent_only ? NLAT : M; const int tpb = ntok / F.G;
    const float* modv = (const float*)(F.ws + WS_MODV) + (size_t)layer * 5 * 6144; const bf16* xres = (const bf16*)(F.ws + WS_XRES); unsigned char* H8 = F.ws + WS_H8;
    int* TOPI = (int*)(F.ws + WS_TOPI); float* TOPW = (float*)(F.ws + WS_TOPW); int* HIST = (int*)(F.ws + WS_HIST);
    constexpr int RS = 1032;
    LAS bf16* hhi = (LAS bf16*)F.lds;
    LAS bf16* hlo = hhi + 16 * RS;
    LAS float* part = (LAS float*)(F.lds + 2 * 16 * RS * 2);
    LAS float* lg = part + 8 * 16 * 32;
    LAS float* sel = lg + 16 * 32;
    LAS int* lhist = (LAS int*)(sel + 64);
    const int lane = F.lane, wave = F.wave, e = lane & 31, q4 = lane >> 4, l15 = lane & 15;
    if (F.tid < 32) lhist[F.tid] = 0;
    bf16x8 whi[2][4], wlo[2][4];
    { const float* wr_ = p.moe_w_router + (size_t)layer * 1024 * 32;
#pragma unroll
      for (int nt = 0; nt < 2; ++nt)
#pragma unroll
          for (int kk = 0; kk < 4; ++kk)
#pragma unroll
              for (int j = 0; j < 8; ++j) { const float w = wr_[(size_t)(wave * 128 + kk * 32 + q4 * 8 + j) * 32 + nt * 16 + l15]; const unsigned h = f2bf(w); whi[nt][kk][j] = (short)h; wlo[nt][kk][j] = (short)f2bf(w - bf2f(h)); } }
    const float brt = p.moe_b_router[layer * 32 + e];
    const float* n2 = p.norm2 + layer * 1024;
    __syncthreads();
    const int tok0 = F.blk * tpb, nsteps = (tpb + 15) / 16;
    v2u vn[2][4];
    f32x4 gsc[4], shv[4]; int bs_cur = -1;
#pragma unroll
    for (int rr = 0; rr < 2; ++rr) { const int tl = 2 * wave + rr; const int r = tok2row(tok0 + (tl < tpb ? tl : 0), latent_only);
#pragma unroll
        for (int j = 0; j < 4; ++j) vn[rr][j] = *(const v2u*)(xres + (size_t)r * 1024 + 4 * lane + 256 * j); }
#pragma unroll 1
    for (int st = 0; st < nsteps; ++st) {
#pragma unroll
        for (int rr = 0; rr < 2; ++rr) {
            const int tl = st * 16 + 2 * wave + rr; const bool valid = tl < tpb; const int tok = tok0 + (valid ? tl : 0);
            f32x4 v[4];
#pragma unroll
            for (int j = 0; j < 4; ++j) v[j] = (f32x4){bflo(vn[rr][j].x), bfhi(vn[rr][j].x), bflo(vn[rr][j].y), bfhi(vn[rr][j].y)};
            { const int tln = tl + 16; const int rn = tok2row(tok0 + (tln < tpb ? tln : 0), latent_only);
#pragma unroll
              for (int j = 0; j < 4; ++j) vn[rr][j] = *(const v2u*)(xres + (size_t)rn * 1024 + 4 * lane + 256 * j); }
            const int r = tok2row(tok, latent_only); const int b = r / TPB, t = r % TPB; const int bs = t < SEQ ? b : 4;
            if (bs != bs_cur) { const float* mv = modv + (size_t)bs * 6144; bs_cur = bs;
#pragma unroll
                for (int j = 0; j < 4; ++j) { const int c = 4 * lane + 256 * j; const f32x4 g = *(const f32x4*)(n2 + c), sc = *(const f32x4*)(mv + 4096 + c); gsc[j] = g * (sc + 1.0f); shv[j] = *(const f32x4*)(mv + 3072 + c); } }
            float ss = 0.f;
#pragma unroll
            for (int j = 0; j < 4; ++j) ss += (v[j].x * v[j].x + v[j].y * v[j].y) + (v[j].z * v[j].z + v[j].w * v[j].w);
            const float rstd = 1.0f / sqrtf(wave_sum(ss) * (1.0f / 1024.0f) + EPS);
#pragma unroll
            for (int j = 0; j < 4; ++j) { const int c = 4 * lane + 256 * j;
                const f32x4 h = (v[j] * rstd) * gsc[j] + shv[j];
                const unsigned h0 = f2bf(h.x), h1 = f2bf(h.y), h2 = f2bf(h.z), h3 = f2bf(h.w);
                v2u o; o.x = h0 | (h1 << 16); o.y = h2 | (h3 << 16);
                v2u l; l.x = pk2(h.x - bf2f(h0), h.y - bf2f(h1)); l.y = pk2(h.z - bf2f(h2), h.w - bf2f(h3));
                *(LAS v2u*)(hhi + (2 * wave + rr) * RS + c) = o; *(LAS v2u*)(hlo + (2 * wave + rr) * RS + c) = l;
                if (valid) { int w8 = 0; w8 = __builtin_amdgcn_cvt_pk_fp8_f32(h.x, h.y, w8, false); w8 = __builtin_amdgcn_cvt_pk_fp8_f32(h.z, h.w, w8, true); *(int*)(H8 + (size_t)r * 1024 + c) = w8; } }
        }
        __syncthreads();
        { f32x4 a0 = {0.f, 0.f, 0.f, 0.f}, a1 = {0.f, 0.f, 0.f, 0.f};
#pragma unroll
          for (int kk = 0; kk < 4; ++kk) { const int ko = l15 * RS + wave * 128 + kk * 32 + q4 * 8;
              const bf16x8 ah = *(const LAS bf16x8*)(hhi + ko), al = *(const LAS bf16x8*)(hlo + ko);
              a0 = __builtin_amdgcn_mfma_f32_16x16x32_bf16(ah, whi[0][kk], a0, 0, 0, 0); a1 = __builtin_amdgcn_mfma_f32_16x16x32_bf16(ah, whi[1][kk], a1, 0, 0, 0);
              a0 = __builtin_amdgcn_mfma_f32_16x16x32_bf16(ah, wlo[0][kk], a0, 0, 0, 0); a1 = __builtin_amdgcn_mfma_f32_16x16x32_bf16(ah, wlo[1][kk], a1, 0, 0, 0);
              a0 = __builtin_amdgcn_mfma_f32_16x16x32_bf16(al, whi[0][kk], a0, 0, 0, 0); a1 = __builtin_amdgcn_mfma_f32_16x16x32_bf16(al, whi[1][kk], a1, 0, 0, 0); }
#pragma unroll
          for (int rg = 0; rg < 4; ++rg) { part[(wave * 16 + 4 * q4 + rg) * 32 + l15] = a0[rg]; part[(wave * 16 + 4 * q4 + rg) * 32 + 16 + l15] = a1[rg]; } }
        __syncthreads();
        { const int row = 2 * wave + (lane >> 5); const int tl = st * 16 + row; const bool valid = tl < tpb; const int tok = tok0 + tl;
            float logit = brt;
#pragma unroll
            for (int w = 0; w < 8; ++w) logit += part[(w * 16 + row) * 32 + e];
            lg[row * 32 + e] = logit;
            int rank = 0;
#pragma unroll
            for (int j4 = 0; j4 < 8; ++j4) { const f32x4 lv = *(const LAS f32x4*)(lg + row * 32 + 4 * j4);
#pragma unroll
                for (int i = 0; i < 4; ++i) { const int j = 4 * j4 + i; rank += (lv[i] > logit || (lv[i] == logit && j < e)) ? 1 : 0; } }
            if (valid && rank < 4) { TOPI[(size_t)tok * 4 + rank] = e; atomicAdd((int*)(lhist + e), 1); }
            if (rank < 4) sel[row * 4 + rank] = logit;
            if (valid && e < 4) { const f32x4 sv = *(const LAS f32x4*)(sel + row * 4);
                const float e1 = __expf(sv[1] - sv[0]), e2 = __expf(sv[2] - sv[0]), e3 = __expf(sv[3] - sv[0]); const float inv = 1.0f / (1.0f + e1 + e2 + e3);
                const float mine = e == 0 ? 1.0f : (e == 1 ? e1 : (e == 2 ? e2 : e3));
                TOPW[(size_t)tok * 4 + e] = mine * inv; }
        }
    }
    __syncthreads();
    if (F.tid < 32) HIST[F.blk * 32 + F.tid] = lhist[F.tid];
}

__device__ __forceinline__ void phase_lists(const KP& p, const Ctx& F, bool latent_only) {
    const int ntok = latent_only ? NLAT : M; const int tpb = ntok / F.G;
    const int* HIST = (const int*)(F.ws + WS_HIST); const int* TOPI = (const int*)(F.ws + WS_TOPI);
    int* POS = (int*)(F.ws + WS_POS); int* SORT = (int*)(F.ws + WS_SORT); int* META = (int*)(F.ws + WS_META);
    LAS int* ltot = (LAS int*)F.lds;
    LAS int* lbase = ltot + 32;
    LAS int* lstart = ltot + 64;
    LAS int* ltop = ltot + 128;
    LAS int* ptot = ltot + 1024; LAS int* pbase = ltot + 1536;
    { const int e = F.tid & 31, j = F.tid >> 5, per = (F.G + 15) >> 4; int tot = 0, base = 0;
        for (int k = 0; k < per; ++k) { const int b = j * per + k; const int h = (b < F.G) ? HIST[b * 32 + e] : 0; tot += h; base += (b < F.blk) ? h : 0; }
        ptot[j * 32 + e] = tot; pbase[j * 32 + e] = base; }
    for (int i = F.tid; i < tpb * 4; i += 512) ltop[i] = TOPI[(size_t)F.blk * tpb * 4 + i];
    __syncthreads();
    if (F.tid < 32) { int tot = 0, base = 0;
#pragma unroll
        for (int j = 0; j < 16; ++j) { tot += ptot[j * 32 + F.tid]; base += pbase[j * 32 + F.tid]; }
        ltot[F.tid] = tot; lbase[F.tid] = base; }
    __syncthreads();
    if (F.tid == 0) { int s = 0; for (int e = 0; e < 32; ++e) { lstart[e] = s; s += (ltot[e] + 255) & ~255; } lstart[32] = s; }
    __syncthreads();
    {
        const int e = F.tid & 31, seg = F.tid >> 5, n = tpb * 4, per = (n + 15) >> 4, i0 = seg * per, i1 = min(n, i0 + per);
        int cnt = 0;
        for (int i = i0; i < i1; ++i) cnt += (ltop[i] == e) ? 1 : 0;
        ptot[seg * 32 + e] = cnt;
        __syncthreads();
        int pos = lstart[e] + lbase[e];
        for (int s2 = 0; s2 < seg; ++s2) pos += ptot[s2 * 32 + e];
        for (int i = i0; i < i1; ++i) if (ltop[i] == e) { const int tok = F.blk * tpb + (i >> 2); SORT[pos] = tok2row(tok, latent_only); POS[(size_t)tok * 4 + (i & 3)] = pos; ++pos; } }
    if (F.blk < 32) { const int e = F.blk; const int s0 = lstart[e] + ltot[e], s1 = lstart[e + 1]; for (int i = s0 + F.tid; i < s1; i += 512) SORT[i] = 0; }
    if (F.blk == 0 && F.tid < 33) { META[64 + F.tid] = lstart[F.tid] >> 8; if (F.tid < 32) { META[F.tid] = ltot[F.tid]; META[32 + F.tid] = lstart[F.tid]; } }
}

template <bool FINAL>
__device__ __forceinline__ void phase_combine(const KP& p, const Ctx& F, int layer) {
    const float* modv = (const float*)(F.ws + WS_MODV); bf16* xres = (bf16*)(F.ws + WS_XRES); bf16* H = (bf16*)(F.ws + WS_H);
    const int* POS = (const int*)(F.ws + WS_POS); const float* TOPW = (const float*)(F.ws + WS_TOPW); const unsigned char* YS = F.ws + WS_YS;
    const int ntok = FINAL ? NLAT : M; const int gw = F.blk * 8 + F.wave, NGW = F.G * 8, lane = F.lane;
    int4 psC, psN, psNN; float4 wvC, wvN, wvNN; int yC[4][4], yN[4][4]; v2u xC[4], xN[4];
#define CB_IDX(tok_, ps_, wv_) do { ps_ = *(const int4*)(POS + (size_t)(tok_) * 4); wv_ = *(const float4*)(TOPW + (size_t)(tok_) * 4); } while (0)
#define CB_DATA(tok_, ps_, y_, x_) do { const int r_ = tok2row((tok_), FINAL); _Pragma("unroll") for (int j_ = 0; j_ < 4; ++j_) { const int c_ = 4 * lane + 256 * j_; \
        y_[0][j_] = *(const int*)(YS + (size_t)ps_.x * 1024 + c_); y_[1][j_] = *(const int*)(YS + (size_t)ps_.y * 1024 + c_); y_[2][j_] = *(const int*)(YS + (size_t)ps_.z * 1024 + c_); y_[3][j_] = *(const int*)(YS + (size_t)ps_.w * 1024 + c_); \
        x_[j_] = *(const v2u*)(xres + (size_t)r_ * 1024 + c_); } } while (0)
    int tok = gw;
    if (tok < ntok) { CB_IDX(tok, psC, wvC); CB_DATA(tok, psC, yC, xC); }
    if (tok + NGW < ntok) CB_IDX(tok + NGW, psN, wvN);
#pragma unroll 1
    for (; tok < ntok; tok += NGW) {
        if (tok + NGW < ntok) CB_DATA(tok + NGW, psN, yN, xN);
        if (tok + 2 * NGW < ntok) CB_IDX(tok + 2 * NGW, psNN, wvNN);
        __builtin_amdgcn_sched_barrier(0);
        const int r = tok2row(tok, FINAL); const int b = r / TPB, t = r % TPB; const int bs = t < SEQ ? b : 4;
        const float* g2 = modv + (size_t)(layer * 5 + bs) * 6144 + 5120;
        f32x4 v[4];
#pragma unroll
        for (int j = 0; j < 4; ++j) { const int c = 4 * lane + 256 * j; f32x4 a;
            a.x = wvC.x * __builtin_amdgcn_cvt_f32_fp8(yC[0][j], 0) + wvC.y * __builtin_amdgcn_cvt_f32_fp8(yC[1][j], 0) + wvC.z * __builtin_amdgcn_cvt_f32_fp8(yC[2][j], 0) + wvC.w * __builtin_amdgcn_cvt_f32_fp8(yC[3][j], 0);
            a.y = wvC.x * __builtin_amdgcn_cvt_f32_fp8(yC[0][j], 1) + wvC.y * __builtin_amdgcn_cvt_f32_fp8(yC[1][j], 1) + wvC.z * __builtin_amdgcn_cvt_f32_fp8(yC[2][j], 1) + wvC.w * __builtin_amdgcn_cvt_f32_fp8(yC[3][j], 1);
            a.z = wvC.x * __builtin_amdgcn_cvt_f32_fp8(yC[0][j], 2) + wvC.y * __builtin_amdgcn_cvt_f32_fp8(yC[1][j], 2) + wvC.z * __builtin_amdgcn_cvt_f32_fp8(yC[2][j], 2) + wvC.w * __builtin_amdgcn_cvt_f32_fp8(yC[3][j], 2);
            a.w = wvC.x * __builtin_amdgcn_cvt_f32_fp8(yC[0][j], 3) + wvC.y * __builtin_amdgcn_cvt_f32_fp8(yC[1][j], 3) + wvC.z * __builtin_amdgcn_cvt_f32_fp8(yC[2][j], 3) + wvC.w * __builtin_amdgcn_cvt_f32_fp8(yC[3][j], 3);
            const f32x4 gg = *(const f32x4*)(g2 + c);
            v[j] = (f32x4){bflo(xC[j].x), bfhi(xC[j].x), bflo(xC[j].y), bfhi(xC[j].y)} + gg * a; }
        if (!FINAL) {
#pragma unroll
            for (int j = 0; j < 4; ++j) { v2u o; o.x = pk2(v[j].x, v[j].y); o.y = pk2(v[j].z, v[j].w); *(v2u*)(xres + (size_t)r * 1024 + 4 * lane + 256 * j) = o; }
            const float* mv = modv + (size_t)(5 + bs) * 6144;
            norm_mod_store(v, p.norm1 + 1024, mv + 1024, mv, H + (size_t)r * 1024, lane);
        } else {
            float ss = 0.f;
#pragma unroll
            for (int j = 0; j < 4; ++j) ss += (v[j].x * v[j].x + v[j].y * v[j].y) + (v[j].z * v[j].z + v[j].w * v[j].w);
            const float rstd = 1.0f / sqrtf(wave_sum(ss) * (1.0f / 1024.0f) + EPS);
            float* orow = p.out + (size_t)tok * 1024;
#if defined(MX_SELFTEST) || defined(ATT_CHECK)
            const float tsc = 1.0f + 0.1f * (float)((const unsigned*)(F.ws + WS_CTL))[64];
#else
            const float tsc = 1.0f;
#endif
#pragma unroll
            for (int j = 0; j < 4; ++j) { const int c = 4 * lane + 256 * j; const f32x4 g = *(const f32x4*)(p.final_norm + c); *(f32x4*)(orow + c) = (v[j] * rstd) * g * tsc; }
        }
        psC = psN; wvC = wvN; psN = psNN; wvN = wvNN;
#pragma unroll
        for (int j = 0; j < 4; ++j) { xC[j] = xN[j];
#pragma unroll
            for (int k2 = 0; k2 < 4; ++k2) yC[k2][j] = yN[k2][j]; }
    }
#undef CB_IDX
#undef CB_DATA
}

__device__ __forceinline__ void phase_gla_finish(const KP& p, const Ctx& F) {
    const bf16* OFb = (const bf16*)(F.ws + WS_OF); const bf16* OBb = (const bf16*)(F.ws + WS_OB); const bf16* A2 = (const bf16*)(F.ws + WS_A2); bf16* Z = (bf16*)(F.ws + WS_Z);
    const int gw = F.blk * 8 + F.wave, NGW = F.G * 8, lane = F.lane;
    for (int tok = gw; tok < NLAT; tok += NGW) {
        const int r = tok2row(tok, true); const int c = 16 * lane;
        const v4u a0 = *(const v4u*)(OFb + (size_t)r * 1024 + c), a1 = *(const v4u*)(OFb + (size_t)r * 1024 + c + 8);
        const v4u b0 = *(const v4u*)(OBb + (size_t)r * 1024 + c), b1 = *(const v4u*)(OBb + (size_t)r * 1024 + c + 8);
        const v4u g0 = *(const v4u*)(A2 + (size_t)r * A2W + 2048 + c), g1 = *(const v4u*)(A2 + (size_t)r * A2W + 2048 + c + 8);
        float o[16], rg[16];
#pragma unroll
        for (int i = 0; i < 4; ++i) { o[2 * i] = bflo(a0[i]) + bflo(b0[i]); o[2 * i + 1] = bfhi(a0[i]) + bfhi(b0[i]); o[8 + 2 * i] = bflo(a1[i]) + bflo(b1[i]); o[8 + 2 * i + 1] = bfhi(a1[i]) + bfhi(b1[i]);
            rg[2 * i] = bflo(g0[i]); rg[2 * i + 1] = bfhi(g0[i]); rg[8 + 2 * i] = bflo(g1[i]); rg[8 + 2 * i + 1] = bfhi(g1[i]); }
        float ss = 0.f;
#pragma unroll
        for (int i = 0; i < 16; ++i) ss += o[i] * o[i];
        ss += __shfl_xor(ss, 1); ss += __shfl_xor(ss, 2); ss += __shfl_xor(ss, 4); ss += __shfl_xor(ss, 8);
        const float rstd = 1.0f / sqrtf(ss * (1.0f / 256.0f) + EPS);
        const float* hn = p.gla_head_norm + (c & 255);
        unsigned w[8];
#pragma unroll
        for (int i = 0; i < 8; ++i) { const float x0 = o[2 * i] * rstd * hn[2 * i] * (rg[2 * i] / (1.0f + __expf(-rg[2 * i]))), x1 = o[2 * i + 1] * rstd * hn[2 * i + 1] * (rg[2 * i + 1] / (1.0f + __expf(-rg[2 * i + 1])));
            w[i] = pk2(x0, x1); }
        *(v4u*)(Z + (size_t)r * 1024 + c) = (v4u){w[0], w[1], w[2], w[3]}; *(v4u*)(Z + (size_t)r * 1024 + c + 8) = (v4u){w[4], w[5], w[6], w[7]};
    }
}

namespace att {
constexpr int NW = 8, QBLK = 32, KVBLK = 64;
constexpr float SCALE = 0.07216878364870322f;
constexpr float THR = 2.f;
constexpr float PSHIFT = 5.f;
#ifndef ATT_SDEPTH
#define ATT_SDEPTH 2
#endif
constexpr int SDEPTH = ATT_SDEPTH;
constexpr int LDQ8 = 1536, LDK = 1024, LDK8 = 1024, LDKR8 = 64, LDO = 1024;
constexpr int SHM_V = 128 * KVBLK, SHM_K8 = KVBLK * 128, SHM_KR8 = KVBLK * 64;
constexpr int OFF_V = 0, OFF_K = 2 * SHM_V, OFF_KR = OFF_K + 2 * SHM_K8, OFF_WS = OFF_KR + 2 * SHM_KR8, OFF_Q2 = OFF_WS + NW * 64 * 4, SHM_ATTN = OFF_Q2 + NW * 2048;
typedef int v8i __attribute__((ext_vector_type(8)));
typedef int v4i __attribute__((ext_vector_type(4)));
#define K8U(key, u) ((key) * 128 + ((((u) ^ (((key) >> 1) & 7))) << 4))
#define KR8U(key, u) ((key) * 64 + ((((u) ^ (((key) >> 2) & 3))) << 4))
__device__ __forceinline__ v8i cat8(v4i lo, v4i hi) { return (v8i){lo[0], lo[1], lo[2], lo[3], hi[0], hi[1], hi[2], hi[3]}; }
__device__ __forceinline__ void mfma64(f32x16& c, v8i a, v8i b, int sc) { asm volatile("v_mfma_scale_f32_32x32x64_f8f6f4 %0, %1, %2, %0, %3, %3 op_sel_hi:[0,0,0]" : "+v"(c) : "v"(a), "v"(b), "v"(sc)); }
__device__ __forceinline__ void mfma64s(f32x16& c, v8i a, v8i b, int sa, int sb) { asm volatile("v_mfma_scale_f32_32x32x64_f8f6f4 %0, %1, %2, %0, %3, %4 op_sel_hi:[0,0,0]" : "+v"(c) : "v"(a), "v"(b), "v"(sa), "v"(sb)); }
typedef float f32x8 __attribute__((ext_vector_type(8)));
#define SBAR() __builtin_amdgcn_sched_barrier(0)
__device__ __forceinline__ int crow(int r, int hi) { return (r & 3) + 8 * (r >> 2) + 4 * hi; }
__device__ __forceinline__ unsigned cvtpk(float lo, float hi) { unsigned r; asm volatile("v_cvt_pk_bf16_f32 %0, %1, %2" : "=v"(r) : "v"(lo), "v"(hi)); return r; }

constexpr float THR2 = THR * 1.4426950408889634f;
__device__ __forceinline__ void softmax_step(f32x16& p0, f32x16& p1, float mref, float& m2, float& l_reg, float& al, v8i& pa, bool first) {
  const float d = mref - m2;
  if (__builtin_expect(__any(d != 0.f), 0)) {
#pragma unroll
    for (int r = 0; r < 16; ++r) { p0[r] += d; p1[r] += d; }
  }
  float pmax = p0[0];
#pragma unroll
  for (int r = 1; r < 16; ++r) pmax = fmaxf(pmax, p0[r]);
#pragma unroll
  for (int r = 0; r < 16; ++r) pmax = fmaxf(pmax, p1[r]);
  { auto rr = __builtin_amdgcn_permlane32_swap(__float_as_uint(pmax), __float_as_uint(pmax), false, false);
    pmax = fmaxf(__uint_as_float(rr[0]), __uint_as_float(rr[1])); }
  const float ex = pmax - PSHIFT;
  al = 1.f;
  if (__builtin_expect(first || __any(ex > THR2), 0)) {
    const float inc = first ? ex : fmaxf(ex, 0.f);
    m2 += inc; al = first ? 0.f : __builtin_amdgcn_exp2f(-inc);
#pragma unroll
    for (int r = 0; r < 16; ++r) { p0[r] -= inc; p1[r] -= inc; }
  }
#pragma unroll
  for (int r = 0; r < 16; ++r) p0[r] = __builtin_amdgcn_exp2f(p0[r]);
#pragma unroll
  for (int r = 0; r < 16; ++r) p1[r] = __builtin_amdgcn_exp2f(p1[r]);
  float ps = 0;
#pragma unroll
  for (int r = 0; r < 16; ++r) ps += p0[r];
#pragma unroll
  for (int r = 0; r < 16; ++r) ps += p1[r];
  { auto rr = __builtin_amdgcn_permlane32_swap(__float_as_uint(ps), __float_as_uint(ps), false, false);
    ps = __uint_as_float(rr[0]) + __uint_as_float(rr[1]); }
  l_reg = l_reg * al + ps;
#pragma unroll
  for (int w = 0; w < 4; ++w) { int x, y;
    asm("v_cvt_pk_fp8_f32 %0, %2, %3\n\tv_cvt_pk_fp8_f32 %1, %6, %7\n\tv_cvt_pk_fp8_f32 %0, %4, %5 op_sel:[0,0,1]\n\tv_cvt_pk_fp8_f32 %1, %8, %9 op_sel:[0,0,1]\n\ts_nop 0"
        : "=&v"(x), "=&v"(y) : "v"(p0[4 * w]), "v"(p0[4 * w + 1]), "v"(p0[4 * w + 2]), "v"(p0[4 * w + 3]), "v"(p1[4 * w]), "v"(p1[4 * w + 1]), "v"(p1[4 * w + 2]), "v"(p1[4 * w + 3]));
    pa[w] = x; pa[4 + w] = y; }
}
__device__ __forceinline__ void qkt(f32x16& p0, f32x16& p1, const char* K8s, const char* KR8s, const v8i* qf, int r32, int hi, int sc) {
  p0 = f32x16{}; p1 = f32x16{};
  asm volatile("s_nop 4" : "+v"(p0), "+v"(p1));
#pragma unroll
  for (int s = 0; s < 2; ++s) { const int u0 = 4 * s + 2 * hi;
    const v8i a0 = cat8(*reinterpret_cast<const v4i*>(K8s + K8U(r32, u0)), *reinterpret_cast<const v4i*>(K8s + K8U(r32, u0 + 1)));
    const v8i a1 = cat8(*reinterpret_cast<const v4i*>(K8s + K8U(32 + r32, u0)), *reinterpret_cast<const v4i*>(K8s + K8U(32 + r32, u0 + 1)));
    mfma64(p0, a0, qf[s], sc); mfma64(p1, a1, qf[s], sc); }
  { const int u0 = 2 * hi;
    const v8i a0 = cat8(*reinterpret_cast<const v4i*>(KR8s + KR8U(r32, u0)), *reinterpret_cast<const v4i*>(KR8s + KR8U(r32, u0 + 1)));
    const v8i a1 = cat8(*reinterpret_cast<const v4i*>(KR8s + KR8U(32 + r32, u0)), *reinterpret_cast<const v4i*>(KR8s + KR8U(32 + r32, u0 + 1)));
    mfma64(p0, a0, qf[2], sc); mfma64(p1, a1, qf[2], sc); }
  asm volatile("s_nop 15\n\ts_nop 7" : "+v"(p0), "+v"(p1));
}
#define V8U(d, u) ((d) * 64 + ((((u) ^ (((d) >> 2) & 3))) << 4))
__device__ __forceinline__ void pv_d0(f32x16* o, const char* V8s, v8i pa, int r32, int hi, int sc) {
#pragma unroll
  for (int d0 = 0; d0 < 4; ++d0) { const int d = 32 * d0 + r32;
    const v8i vb = cat8(*reinterpret_cast<const v4i*>(V8s + V8U(d, 2 * hi)), *reinterpret_cast<const v4i*>(V8s + V8U(d, 2 * hi + 1)));
    mfma64(o[d0], pa, vb, sc); }
  asm volatile("s_nop 15\n\ts_nop 7" : "+v"(o[0]), "+v"(o[1]), "+v"(o[2]), "+v"(o[3]));
}

__device__ __forceinline__ void attn_unit(const unsigned char* __restrict__ Qb, const unsigned char* __restrict__ Kh, const unsigned char* __restrict__ KRh, const unsigned char* __restrict__ Vh, unsigned char* __restrict__ Ob, int seq, char* lds) {
  int tid_ = threadIdx.x; asm volatile("" : "+v"(tid_));
  const int tid = tid_, wid = __builtin_amdgcn_readfirstlane(tid >> 6), lane = tid & 63, r32 = lane & 31, hi = lane >> 5;
  char* V_lds = lds + OFF_V; char* K_lds = lds + OFF_K; char* KR_lds = lds + OFF_KR;
  float* ws = (float*)(lds + OFF_WS) + wid * 64; float* li_l = ws; float* al_l = ws + 32;
  float m2 = 0.f, mrE = 0.f, mrO = 0.f, l_reg = 0, al = 1.f; f32x16 o[4] = {}; v8i qf[2];
  const int sc1 = 0x7f7f7f7f, scq = 0x7c7c7c7c;
  const unsigned char* Qw = Qb + (long)(wid * QBLK + r32) * LDQ8 + hi * 32;
#pragma unroll
  for (int s = 0; s < 2; ++s) qf[s] = *reinterpret_cast<const v8i*>(Qw + s * 64);
  char* q2_l = lds + OFF_Q2 + wid * 2048 + lane * 16;
  { const v8i q2 = *reinterpret_cast<const v8i*>(Qw + 128); *(v4i*)q2_l = (v4i){q2[0], q2[1], q2[2], q2[3]}; *(v4i*)(q2_l + 1024) = (v4i){q2[4], q2[5], q2[6], q2[7]}; }
  const int v8d = tid >> 2, v8u = tid & 3;
  const int k8r = tid >> 3, k8u = tid & 7, kr8r = (tid >> 2) & 63, kr8u = tid & 3;
  const bool has_kr = wid < 4;
  const int NT = seq / KVBLK;
  v4i sv8, sk8, skr8;
#define SLOAD(kt, vt) do { const int kt_ = min((kt), NT - 1) * KVBLK, vt_ = min(max((vt), 0), NT - 1) * KVBLK; \
    sv8 = *reinterpret_cast<const v4i*>(Vh + (size_t)v8d * 8448 + (unsigned)vt_ + v8u * 16); \
    sk8 = *reinterpret_cast<const v4i*>(Kh + (unsigned)(kt_ + k8r) * LDK8 + k8u * 16); \
    if (has_kr) skr8 = *reinterpret_cast<const v4i*>(KRh + (unsigned)(kt_ + kr8r) * LDKR8 + kr8u * 16); } while (0)
#define SWRITE(b) do { *(v4i*)(V_lds + (b) * SHM_V + V8U(v8d, v8u)) = sv8; \
    *(v4i*)(K_lds + (b) * SHM_K8 + K8U(k8r, k8u)) = sk8; \
    if (has_kr) *(v4i*)(KR_lds + (b) * SHM_KR8 + KR8U(kr8r, kr8u)) = skr8; } while (0)
#define STAGE(b, t_) do { asm volatile("s_waitcnt vmcnt(0)" ::: "memory"); SWRITE(b); SLOAD((t_) + 3, (t_) + 1); } while (0)
#define RESC() do { if (__any(al < 1.f)) { if (hi == 0) al_l[r32] = al; asm volatile("s_waitcnt lgkmcnt(0)" ::: "memory"); \
    _Pragma("unroll") for (int d = 0; d < 4; ++d) _Pragma("unroll") for (int r = 0; r < 16; ++r) o[d][r] *= al_l[crow(r, hi)]; \
    asm volatile("s_nop 4" : "+v"(o[0]), "+v"(o[1]), "+v"(o[2]), "+v"(o[3])); } } while (0)
#define LDK(b, half, s) cat8(*reinterpret_cast<const v4i*>(K_lds + (b) * SHM_K8 + K8U(32 * (half) + r32, 4 * (s) + 2 * hi)), *reinterpret_cast<const v4i*>(K_lds + (b) * SHM_K8 + K8U(32 * (half) + r32, 4 * (s) + 2 * hi + 1)))
#define LDKR(b, half) cat8(*reinterpret_cast<const v4i*>(KR_lds + (b) * SHM_KR8 + KR8U(32 * (half) + r32, 2 * hi)), *reinterpret_cast<const v4i*>(KR_lds + (b) * SHM_KR8 + KR8U(32 * (half) + r32, 2 * hi + 1)))
#define LDV(b, d0) cat8(*reinterpret_cast<const v4i*>(V_lds + (b) * SHM_V + V8U(32 * (d0) + r32, 2 * hi)), *reinterpret_cast<const v4i*>(V_lds + (b) * SHM_V + V8U(32 * (d0) + r32, 2 * hi + 1)))
#define MSTEP(do_pv, vb, do_qk, kb, P0, P1, MR, sb, st) do { __builtin_amdgcn_s_setprio(1); \
    if (do_pv) { RESC(); \
      { const v8i v0 = LDV(vb, 0), v1 = LDV(vb, 1), v2 = LDV(vb, 2), v3 = LDV(vb, 3); SBAR(); \
        mfma64(o[0], pa, v0, sc1); mfma64(o[1], pa, v1, sc1); mfma64(o[2], pa, v2, sc1); mfma64(o[3], pa, v3, sc1); SBAR(); } } \
    STAGE(sb, st); SBAR(); \
    if (do_qk) { v8i a0 = LDK(kb, 0, 0), a1 = LDK(kb, 1, 0); const v8i b0 = LDK(kb, 0, 1), b1 = LDK(kb, 1, 1); \
      { const float ci = PSHIFT - m2; MR = m2; _Pragma("unroll") for (int r_ = 0; r_ < 16; ++r_) { P0[r_] = ci; P1[r_] = ci; } } \
      asm volatile("s_nop 4" : "+v"(P0), "+v"(P1)); SBAR(); \
      mfma64s(P0, a0, qf[0], sc1, scq); mfma64s(P1, a1, qf[0], sc1, scq); SBAR(); \
      a0 = LDKR(kb, 0); a1 = LDKR(kb, 1); const v8i q2 = cat8(*reinterpret_cast<const v4i*>(q2_l), *reinterpret_cast<const v4i*>(q2_l + 1024)); SBAR(); \
      mfma64s(P0, b0, qf[1], sc1, scq); mfma64s(P1, b1, qf[1], sc1, scq); SBAR(); \
      mfma64s(P0, a0, q2, sc1, scq); mfma64s(P1, a1, q2, sc1, scq); \
      asm volatile("s_nop 15\n\ts_nop 7" : "+v"(P0), "+v"(P1)); } SBAR(); __builtin_amdgcn_s_setprio(0); } while (0)
#define VSTEP(P0, P1, MR, first) do { softmax_step(P0, P1, MR, m2, l_reg, al, pa, first); SBAR(); } while (0)
  f32x16 pE0, pE1, pO0, pO1; v8i pa = {0, 0, 0, 0, 0, 0, 0, 0};
  const bool g1 = wid >= 4;
  SLOAD(0, 0); asm volatile("s_waitcnt vmcnt(0)" ::: "memory"); SWRITE(0); SLOAD(1, 0); __syncthreads();
  if (g1) __syncthreads();
#pragma unroll 1
  for (int t = -1; t < NT; t += 2) {
    MSTEP(t >= 1, 0, t + 1 < NT, 0, pE0, pE1, mrE, 1, t);
    __syncthreads();
    if (t >= 1) VSTEP(pO0, pO1, mrO, false);
    __syncthreads();
    MSTEP(t >= 0, 1, t + 2 < NT, 1, pO0, pO1, mrO, 0, t + 1);
    __syncthreads();
    if (t + 1 < NT) VSTEP(pE0, pE1, mrE, t < 0);
    __syncthreads();
  }
  if (!g1) __syncthreads();
  asm volatile("s_nop 15\n\ts_nop 7" : "+v"(o[0]), "+v"(o[1]), "+v"(o[2]), "+v"(o[3]));
  if (hi == 0) li_l[r32] = l_reg; asm volatile("s_waitcnt lgkmcnt(0)" ::: "memory");
  float rli[16];
#pragma unroll
  for (int r = 0; r < 16; ++r) rli[r] = __builtin_amdgcn_rcpf(li_l[crow(r, hi)]);
  unsigned char* Ow = Ob + (long)(wid * QBLK) * LDO;
#pragma unroll
  for (int r = 0; r < 16; ++r) { int orow = crow(r, hi);
#pragma unroll
    for (int d0 = 0; d0 < 4; ++d0) Ow[(long)orow * LDO + d0 * 32 + r32] = (unsigned char)(__builtin_amdgcn_cvt_pk_fp8_f32(o[d0][r] * rli[r], 0.f, 0, false) & 0xff); }
  __syncthreads();
#undef SLOAD
#undef SWRITE
#undef STAGE
#undef RESC
#undef LDK
#undef LDKR
#undef LDV
#undef MSTEP
#undef VSTEP
}
#undef K8U
#undef KR8U
#undef V8U
#undef SBAR
}

__device__ __forceinline__ void phase_attention(const Ctx& F) {
    const unsigned char* Q = F.ws + WS_Q8; const unsigned char* KN = F.ws + WS_KN8; const unsigned char* KR = F.ws + WS_KR8; const unsigned char* VT = F.ws + WS_VT8; unsigned char* O = F.ws + WS_O8;
    char* lds = (char*)F.lds;
    const bool xcd = (F.G & 7) == 0; const int nq = xcd ? (F.G >> 3) : F.G; const int lat_rounds = xcd ? (128 + nq - 1) / nq : (1024 + F.G - 1) / F.G;
#pragma unroll 1
    for (int i = 0;; ++i) {
        int bh, qrow, krow, seq;
        if (i < lat_rounds) {
            int qt;
            if (xcd) { const int x = F.blk & 7, q = F.blk >> 3; const int uu = i * nq + q; bh = (uu >> 5) * 8 + x; qt = uu & 31; if (uu >= 128) continue; }
            else { const int uu = i * F.G + F.blk; bh = uu >> 5; qt = uu & 31; if (uu >= 1024) continue; }
            qrow = qt * 256; krow = 0; seq = TPB;
        } else { bh = (i - lat_rounds) * F.G + F.blk; if (bh >= NB * 8) break; qrow = SEQ; krow = SEQ; seq = LC; }
        const int b = bh >> 3, h = bh & 7; const size_t r0 = (size_t)b * TPB;
        att::attn_unit(Q + (r0 + qrow) * 1536 + h * 192, KN + (r0 + krow) * 1024 + h * 128, KR + (r0 + krow) * 64, VT + (size_t)(bh * 128) * 8448 + krow, O + (r0 + qrow) * 1024 + h * 128, seq, lds);
    }
}

__device__ __forceinline__ f32x4 mfma16(bf16x8 a, bf16x8 b, f32x4 c) { return __builtin_amdgcn_mfma_f32_16x16x32_bf16(a, b, c, 0, 0, 0); }
constexpr int NCH = M / 64;
constexpr int GL_AM = 0, GL_ST = 18432, GL_END = GL_ST + 8 * 32 * 136 * 2;

__device__ __forceinline__ void phase_gla_prep(const KP& p, const Ctx& F) {
    const bf16* A2 = (const bf16*)(F.ws + WS_A2);
    bf16* QE = (bf16*)(F.ws + WS_QE); bf16* KE = (bf16*)(F.ws + WS_KE); bf16* KPT = (bf16*)(F.ws + WS_KPT); bf16* VT = (bf16*)(F.ws + WS_VT); float* DEC = (float*)(F.ws + WS_DEC);
    const int gw = F.blk * 8 + F.wave, NGW = F.G * 8, tid = F.tid, lane = F.lane, wave = F.wave, q4 = lane >> 4, l15 = lane & 15;
    constexpr int TS = 264, PS = 72;
    LAS bf16* qT = (LAS bf16*)F.lds; LAS bf16* kT = qT + 64 * TS; LAS bf16* pT = kT + 64 * TS;
    const int pr = tid >> 5, pc = (tid & 31) * 8;
    const int kpr = tid >> 3, kpc = (tid & 7) * 8;
    v4u sq[4], sk[4]; bf16x8 tf[4]; bf16x8 w2n[2]; float bgn[2];
#define GP_LOADS(task_) do { const int hp_ = (task_) & 1, cgd_ = (task_) >> 1; const int cg_ = cgd_ % NCH, dir_ = cgd_ / NCH; const bf16* a_ = A2 + ((size_t)cg_ * 64) * A2W; \
        _Pragma("unroll") for (int i_ = 0; i_ < 4; ++i_) { const bf16* r_ = a_ + (size_t)(pr + 16 * i_) * A2W + hp_ * 256 + pc; sq[i_] = *(const v4u*)r_; sk[i_] = *(const v4u*)(r_ + 512); } \
        _Pragma("unroll") for (int mt_ = 0; mt_ < 4; ++mt_) { tf[mt_] = (bf16x8){0, 0, 0, 0, 0, 0, 0, 0}; if (q4 < 2) tf[mt_] = *(const bf16x8*)(a_ + (size_t)(16 * mt_ + l15) * A2W + 3072 + dir_ * 16 + q4 * 8); } \
        _Pragma("unroll") for (int tt_ = 0; tt_ < 2; ++tt_) { const int dcol_ = hp_ * 256 + (2 * wave + tt_) * 16 + l15; w2n[tt_] = (bf16x8){0, 0, 0, 0, 0, 0, 0, 0}; \
            if (q4 < 2) { _Pragma("unroll") for (int j_ = 0; j_ < 8; ++j_) w2n[tt_][j_] = (short)f2bf(p.gla_w_gate2[(size_t)(dir_ * 16 + q4 * 8 + j_) * 512 + dcol_]); } \
            bgn[tt_] = p.gla_b_gate[dir_ * 512 + dcol_]; } } while (0)
    const int ntask = 2 * NCH * 2;
    if (F.blk < ntask) GP_LOADS(F.blk);
#pragma unroll 1
    for (int task = F.blk; task < ntask; task += F.G) {
        const int hp = task & 1, cgd = task >> 1; const int cg = cgd % NCH, dir = cgd / NCH; const size_t row0 = (size_t)cg * 64;
#pragma unroll
        for (int i = 0; i < 4; ++i) { *(LAS v4u*)(qT + (pr + 16 * i) * TS + pc) = sq[i]; *(LAS v4u*)(kT + (pr + 16 * i) * TS + pc) = sk[i]; }
        bf16x8 tfc[4], w2c[2]; float bgc[2];
#pragma unroll
        for (int mt = 0; mt < 4; ++mt) tfc[mt] = tf[mt];
#pragma unroll
        for (int tt = 0; tt < 2; ++tt) { w2c[tt] = w2n[tt]; bgc[tt] = bgn[tt]; }
        __syncthreads();
        if (task + F.G < ntask) GP_LOADS(task + F.G);
        __builtin_amdgcn_sched_barrier(0);
#pragma unroll
        for (int tt = 0; tt < 2; ++tt) {
            const int ct = 2 * wave + tt, lc = ct * 16 + l15, dcol = hp * 256 + lc;
            const float bgd = bgc[tt];
            f32x4 gp[4];
#pragma unroll
            for (int mt = 0; mt < 4; ++mt) gp[mt] = mfma16(tfc[mt], w2c[tt], (f32x4){0.f, 0.f, 0.f, 0.f});
            float bb[4][4], gg[4][4]; float carry = 0.f;
#pragma unroll
            for (int mt = 0; mt < 4; ++mt) {
                float c[4];
#pragma unroll
                for (int r = 0; r < 4; ++r) { const float xg = gp[mt][r] + bgd; const float g = (fminf(xg, 0.f) - __logf(1.0f + __expf(-fabsf(xg)))) * 0.0625f; gg[mt][r] = g; c[r] = g + (r ? c[r - 1] : 0.f); }
                const float t0 = __shfl(c[3], l15), t1 = __shfl(c[3], l15 + 16), t2 = __shfl(c[3], l15 + 32), t3 = __shfl(c[3], l15 + 48);
                const float ex = carry + (q4 > 0 ? t0 : 0.f) + (q4 > 1 ? t1 : 0.f) + (q4 > 2 ? t2 : 0.f);
#pragma unroll
                for (int r = 0; r < 4; ++r) bb[mt][r] = ex + c[r];
                carry += (t0 + t1) + (t2 + t3);
            }
            const float btot = carry;
#pragma unroll
            for (int mt = 0; mt < 4; ++mt) {
                float kp[4];
#pragma unroll
                for (int r = 0; r < 4; ++r) { const int m = 16 * mt + 4 * q4 + r;
                    const float qv = bf2f(qT[m * TS + lc]), kv = bf2f(kT[m * TS + lc]); const float bv = dir ? (btot - bb[mt][r] + gg[mt][r]) : bb[mt][r];
                    qT[m * TS + lc] = (bf16)f2bf(qv * 0.08838834764831845f * __expf(bv)); kT[m * TS + lc] = (bf16)f2bf(kv * __expf(-bv));
                    kp[r] = kv * __expf(btot - bv); }
                v2u w; w.x = pk2(kp[0], kp[1]); w.y = pk2(kp[2], kp[3]);
                *(LAS v2u*)(pT + lc * PS + 16 * mt + 4 * q4) = w;
            }
            if (q4 == 0) DEC[((size_t)dir * NCH + cg) * 512 + dcol] = __expf(btot);
        }
        __syncthreads();
#pragma unroll
        for (int i = 0; i < 4; ++i) { const size_t oi = ((size_t)dir * M + row0 + pr + 16 * i) * 512 + hp * 256 + pc;
            *(v4u*)(QE + oi) = *(const LAS v4u*)(qT + (pr + 16 * i) * TS + pc); *(v4u*)(KE + oi) = *(const LAS v4u*)(kT + (pr + 16 * i) * TS + pc);
            *(v4u*)(KPT + (((size_t)dir * NCH + cg) * 512 + hp * 256 + kpr + 64 * i) * 64 + kpc) = *(const LAS v4u*)(pT + (kpr + 64 * i) * PS + kpc); }
        __syncthreads();
    }
#undef GP_LOADS
}

constexpr int GL_QE = 0, GL_KE = 17408, GL_KP = 34816, GL_AMS = 53248, GL_STS = 62464, GL_DEC = GL_STS + 8 * 32 * 136 * 2, GL_T1 = GL_DEC + 512, GL_END2 = GL_T1 + 2048;
template <bool OUT>
__device__ __forceinline__ void gla_unit(const KP& p, const Ctx& F, int ch, int s) {
    const int dir = ch & 1, hh = (ch >> 1) & 3, b = ch >> 3;
    const int tid = F.tid, lane = F.lane, wave = F.wave, q4 = lane >> 4, l15 = lane & 15;
    const bf16* A2 = (const bf16*)(F.ws + WS_A2); const bf16* VT = (const bf16*)(F.ws + WS_VT);
    bf16* UST = (bf16*)(F.ws + WS_UST); float* DS = (float*)(F.ws + WS_DS);
    bf16* Oout = (bf16*)(F.ws + (dir ? WS_OB : WS_OF));
    LAS bf16* QEs = (LAS bf16*)(F.lds + GL_QE); LAS bf16* KEs = (LAS bf16*)(F.lds + GL_KE); LAS bf16* KPs = (LAS bf16*)(F.lds + GL_KP); LAS bf16* AMs = (LAS bf16*)(F.lds + GL_AMS);
    LAS bf16* ST = (LAS bf16*)(F.lds + GL_STS) + wave * (32 * 136); LAS float* DECs = (LAS float*)(F.lds + GL_DEC); LAS bf16* T1s = (LAS bf16*)(F.lds + GL_T1);
    const int qr0 = tid >> 4, qc0 = (tid & 15) * 8;
    const int lc = wave * 16 + l15;
    v4u sq[2], sk[2], st1 = {0u, 0u, 0u, 0u}; bf16x8 vtn[2][2];
    bf16x8 w2f = {0, 0, 0, 0, 0, 0, 0, 0};
    if (q4 < 2) {
#pragma unroll
        for (int j = 0; j < 8; ++j) w2f[j] = (short)f2bf(p.gla_w_gate2[(size_t)(dir * 16 + q4 * 8 + j) * 512 + hh * 128 + lc]);
    }
    const float bgd = p.gla_b_gate[dir * 512 + hh * 128 + lc];
#define GL_CHUNK(sb_) ((s == 0) ? (dir ? 131 - (sb_) : 128 + (sb_)) : (dir ? 127 - 4 * (s - 1) - (sb_) : 4 * (s - 1) + (sb_)))
#define GL_LOADS(sb_) do { const int cg_ = b * 132 + GL_CHUNK(sb_); const bf16* a_ = A2 + ((size_t)cg_ * 64) * A2W; \
        if (OUT) { sq[0] = *(const v4u*)(a_ + (size_t)qr0 * A2W + hh * 128 + qc0); sq[1] = *(const v4u*)(a_ + (size_t)(qr0 + 32) * A2W + hh * 128 + qc0); } \
        sk[0] = *(const v4u*)(a_ + (size_t)qr0 * A2W + 512 + hh * 128 + qc0); sk[1] = *(const v4u*)(a_ + (size_t)(qr0 + 32) * A2W + 512 + hh * 128 + qc0); \
        if (tid < 128) st1 = *(const v4u*)(a_ + (size_t)(tid >> 1) * A2W + 3072 + dir * 16 + (tid & 1) * 8); \
        { const bf16* v_ = VT + ((size_t)cg_ * 1024 + hh * 256 + wave * 32) * 64 + 8 * q4; \
            vtn[0][0] = *(const bf16x8*)(v_ + (size_t)l15 * 64); vtn[0][1] = *(const bf16x8*)(v_ + (size_t)l15 * 64 + 32); \
            vtn[1][0] = *(const bf16x8*)(v_ + (size_t)(16 + l15) * 64); vtn[1][1] = *(const bf16x8*)(v_ + (size_t)(16 + l15) * 64 + 32); } } while (0)
    GL_LOADS(0);
    f32x4 sacc[2][8];
    if (OUT) {
        const bf16* U0 = UST + ((size_t)(ch * 32 + (s - 1)) * 256 + wave * 32 + 4 * q4) * 128 + l15;
#pragma unroll
        for (int et = 0; et < 2; ++et)
#pragma unroll
            for (int nt = 0; nt < 8; ++nt)
#pragma unroll
                for (int r = 0; r < 4; ++r) { const bf16 v = U0[(size_t)(16 * et + r) * 128 + nt * 16]; sacc[et][nt][r] = bf2f(v); ST[(16 * et + 4 * q4 + r) * 136 + nt * 16 + l15] = v; }
    } else {
#pragma unroll
        for (int et = 0; et < 2; ++et)
#pragma unroll
            for (int nt = 0; nt < 8; ++nt) sacc[et][nt] = (f32x4){0.f, 0.f, 0.f, 0.f};
    }
    float dprod[8];
#pragma unroll
    for (int nt = 0; nt < 8; ++nt) dprod[nt] = 1.0f;
#pragma unroll 1
    for (int sb = 0; sb < 4; ++sb) {
        const size_t row0 = (size_t)(b * 132 + GL_CHUNK(sb)) * 64;
        if (OUT) { *(LAS v4u*)(QEs + qr0 * 136 + qc0) = sq[0]; *(LAS v4u*)(QEs + (qr0 + 32) * 136 + qc0) = sq[1]; }
        *(LAS v4u*)(KEs + qr0 * 136 + qc0) = sk[0]; *(LAS v4u*)(KEs + (qr0 + 32) * 136 + qc0) = sk[1];
        if (tid < 128) *(LAS v4u*)(T1s + tid * 8) = st1;
        bf16x8 vtf[2][2];
#pragma unroll
        for (int et = 0; et < 2; ++et) { vtf[et][0] = vtn[et][0]; vtf[et][1] = vtn[et][1]; }
        __syncthreads();
        if (sb < 3) GL_LOADS(sb + 1);
        __builtin_amdgcn_sched_barrier(0);
        {
            float bb[4][4]; float carry = 0.f;
#pragma unroll
            for (int mt = 0; mt < 4; ++mt) {
                bf16x8 tf = {0, 0, 0, 0, 0, 0, 0, 0};
                if (q4 < 2) tf = *(const LAS bf16x8*)(T1s + (16 * mt + l15) * 16 + q4 * 8);
                const f32x4 gp = mfma16(tf, w2f, (f32x4){0.f, 0.f, 0.f, 0.f});
                float c[4], g4[4];
#pragma unroll
                for (int r = 0; r < 4; ++r) { const float xg = gp[r] + bgd; const float g = (fminf(xg, 0.f) - __logf(1.0f + __expf(-fabsf(xg)))) * 0.0625f; g4[r] = g; c[r] = g + (r ? c[r - 1] : 0.f); }
                const float t0 = __shfl(c[3], l15), t1 = __shfl(c[3], l15 + 16), t2 = __shfl(c[3], l15 + 32), t3 = __shfl(c[3], l15 + 48);
                const float ex = carry + (q4 > 0 ? t0 : 0.f) + (q4 > 1 ? t1 : 0.f) + (q4 > 2 ? t2 : 0.f);
#pragma unroll
                for (int r = 0; r < 4; ++r) bb[mt][r] = ex + c[r] - (dir ? g4[r] : 0.f);
                carry += (t0 + t1) + (t2 + t3);
            }
            const float btot = carry;
#pragma unroll
            for (int mt = 0; mt < 4; ++mt) {
                float kp[4];
#pragma unroll
                for (int r = 0; r < 4; ++r) { const int m = 16 * mt + 4 * q4 + r;
                    const float kv = bf2f(KEs[m * 136 + lc]); const float bv = dir ? (btot - bb[mt][r]) : bb[mt][r];
                    kp[r] = kv * __expf(btot - bv);
                    if (OUT) { const float qv = bf2f(QEs[m * 136 + lc]); QEs[m * 136 + lc] = (bf16)f2bf(qv * 0.08838834764831845f * __expf(bv)); KEs[m * 136 + lc] = (bf16)f2bf(kv * __expf(-bv)); } }
                v2u w; w.x = pk2(kp[0], kp[1]); w.y = pk2(kp[2], kp[3]);
                *(LAS v2u*)(KPs + lc * 72 + 16 * mt + 4 * q4) = w;
            }
            if (q4 == 0) DECs[lc] = __expf(btot);
        }
        __syncthreads();
        float dc[8];
#pragma unroll
        for (int nt = 0; nt < 8; ++nt) dc[nt] = DECs[nt * 16 + l15];
        if (OUT) {
#pragma unroll
            for (int tt = 0; tt < 2; ++tt) { const int tix = 2 * wave + tt, mt = tix >> 2, nt = tix & 3; f32x4 a = {0.f, 0.f, 0.f, 0.f};
#pragma unroll
                for (int kk = 0; kk < 4; ++kk) a = mfma16(*(const LAS bf16x8*)(QEs + (16 * mt + l15) * 136 + kk * 32 + 8 * q4), *(const LAS bf16x8*)(KEs + (16 * nt + l15) * 136 + kk * 32 + 8 * q4), a);
#pragma unroll
                for (int r = 0; r < 4; ++r) { const int i = 16 * mt + 4 * q4 + r, j = 16 * nt + l15; const bool keep = dir ? (j >= i) : (j <= i); AMs[i * 72 + j] = keep ? (bf16)f2bf(a[r]) : (bf16)0; } }
            __syncthreads();
            bf16x8 stf[2][4];
#pragma unroll
            for (int et = 0; et < 2; ++et)
#pragma unroll
                for (int kk = 0; kk < 4; ++kk) stf[et][kk] = *(const LAS bf16x8*)(ST + (16 * et + l15) * 136 + kk * 32 + 8 * q4);
#pragma unroll
            for (int mt = 0; mt < 4; ++mt) { f32x4 o0 = {0.f, 0.f, 0.f, 0.f}, o1 = {0.f, 0.f, 0.f, 0.f};
#pragma unroll
                for (int kk = 0; kk < 4; ++kk) { const bf16x8 qf = *(const LAS bf16x8*)(QEs + (16 * mt + l15) * 136 + kk * 32 + 8 * q4); o0 = mfma16(qf, stf[0][kk], o0); o1 = mfma16(qf, stf[1][kk], o1); }
#pragma unroll
                for (int kk = 0; kk < 2; ++kk) { const bf16x8 af = *(const LAS bf16x8*)(AMs + (16 * mt + l15) * 72 + kk * 32 + 8 * q4); o0 = mfma16(af, vtf[0][kk], o0); o1 = mfma16(af, vtf[1][kk], o1); }
#pragma unroll
                for (int r = 0; r < 4; ++r) { bf16* op = Oout + (row0 + 16 * mt + 4 * q4 + r) * 1024 + hh * 256 + wave * 32 + l15; op[0] = (bf16)f2bf(o0[r]); op[16] = (bf16)f2bf(o1[r]); } }
        }
#pragma unroll
        for (int nt = 0; nt < 8; ++nt) { dprod[nt] *= dc[nt];
            const bf16x8 k0 = *(const LAS bf16x8*)(KPs + (16 * nt + l15) * 72 + 8 * q4), k1 = *(const LAS bf16x8*)(KPs + (16 * nt + l15) * 72 + 32 + 8 * q4);
#pragma unroll
            for (int et = 0; et < 2; ++et) { sacc[et][nt] = sacc[et][nt] * dc[nt]; sacc[et][nt] = mfma16(vtf[et][0], k0, sacc[et][nt]); sacc[et][nt] = mfma16(vtf[et][1], k1, sacc[et][nt]); } }
        if (OUT && sb < 3) {
#pragma unroll
            for (int et = 0; et < 2; ++et)
#pragma unroll
                for (int nt = 0; nt < 8; ++nt)
#pragma unroll
                    for (int r = 0; r < 4; ++r) ST[(16 * et + 4 * q4 + r) * 136 + nt * 16 + l15] = (bf16)f2bf(sacc[et][nt][r]);
        }
        __syncthreads();
    }
#undef GL_LOADS
#undef GL_CHUNK
    if (!OUT) {
        bf16* U0 = UST + ((size_t)(ch * 32 + s) * 256 + wave * 32 + 4 * q4) * 128 + l15;
#pragma unroll
        for (int et = 0; et < 2; ++et)
#pragma unroll
            for (int nt = 0; nt < 8; ++nt)
#pragma unroll
                for (int r = 0; r < 4; ++r) U0[(size_t)(16 * et + r) * 128 + nt * 16] = (bf16)f2bf(sacc[et][nt][r]);
        if (wave == 0 && q4 == 0) {
#pragma unroll
            for (int nt = 0; nt < 8; ++nt) DS[(size_t)(ch * 32 + s) * 128 + nt * 16 + l15] = dprod[nt];
        }
    }
}
template <bool OUT>
__device__ __forceinline__ void phase_gla_units(const KP& p, const Ctx& F) {
#pragma unroll 1
    for (int u = F.blk; u < 32 * 32; u += F.G) { const int s = (u & 31) + (OUT ? 1 : 0), ch = u >> 5; gla_unit<OUT>(p, F, ch, s); }
}
__device__ __forceinline__ void phase_gla_scan(const Ctx& F) {
    unsigned* UST = (unsigned*)(F.ws + WS_UST); const float* DS = (const float*)(F.ws + WS_DS);
    const int gt = F.blk * 512 + F.tid, NGT = F.G * 512;
    for (int idx = gt; idx < 32 * 16384; idx += NGT) {
        const int ch = idx >> 14, ed2 = idx & 16383, d = (ed2 & 63) * 2;
        unsigned u[32]; float d0[32], d1[32];
#pragma unroll
        for (int s = 0; s < 32; ++s) { u[s] = UST[(size_t)(ch * 32 + s) * 16384 + ed2]; const float2 dd = *(const float2*)(DS + (size_t)(ch * 32 + s) * 128 + d); d0[s] = dd.x; d1[s] = dd.y; }
        float r0 = 0.f, r1 = 0.f;
#pragma unroll
        for (int s = 0; s < 32; ++s) { r0 = d0[s] * r0 + bflo(u[s]); r1 = d1[s] * r1 + bfhi(u[s]); UST[(size_t)(ch * 32 + s) * 16384 + ed2] = pk2(r0, r1); }
    }
}

constexpr int NWAVES = 8;
constexpr int LDS_BYTES = 163840;
constexpr int CTRL_OFF = 159744;
constexpr int MISC_OFF = CTRL_OFF + 320;
constexpr int TSTART_OFF = CTRL_OFF + 1024;
constexpr int CW_BAR = 4096;
constexpr int NPHASE = 24;


#ifdef MX_SELFTEST
typedef int v8i __attribute__((ext_vector_type(8)));
__device__ __forceinline__ float mx_a(int i, int k) { return (float)((i * 7 + k * 3) % 5 - 2) * 0.5f; }
__device__ __forceinline__ float mx_b(int k, int j) { return (float)((k * 5 + j * 11) % 7 - 3) * 0.25f; }
__device__ __forceinline__ int mx_kmap(int hyp, int q4, int j, int t) { return hyp == 0 ? 32 * q4 + 4 * j + t : 64 * (j >> 2) + 16 * q4 + 4 * (j & 3) + t; }
__device__ __forceinline__ bool mx_try(int hyp, int lane) {
    const int l15 = lane & 15, q4 = lane >> 4; v8i a, b;
#pragma unroll
    for (int j = 0; j < 8; ++j) { int wa = 0, wb = 0;
        wa = __builtin_amdgcn_cvt_pk_fp8_f32(mx_a(l15, mx_kmap(hyp, q4, j, 0)), mx_a(l15, mx_kmap(hyp, q4, j, 1)), wa, false);
        wa = __builtin_amdgcn_cvt_pk_fp8_f32(mx_a(l15, mx_kmap(hyp, q4, j, 2)), mx_a(l15, mx_kmap(hyp, q4, j, 3)), wa, true);
        wb = __builtin_amdgcn_cvt_pk_fp8_f32(mx_b(mx_kmap(hyp, q4, j, 0), l15), mx_b(mx_kmap(hyp, q4, j, 1), l15), wb, false);
        wb = __builtin_amdgcn_cvt_pk_fp8_f32(mx_b(mx_kmap(hyp, q4, j, 2), l15), mx_b(mx_kmap(hyp, q4, j, 3), l15), wb, true);
        a[j] = wa; b[j] = wb; }
    f32x4 c = {0.f, 0.f, 0.f, 0.f};
    c = __builtin_amdgcn_mfma_scale_f32_16x16x128_f8f6f4(a, b, c, 0, 0, 0, 0x7f7f7f7f, 0, 0x7f7f7f7f);
    bool ok = true;
#pragma unroll
    for (int r = 0; r < 4; ++r) { const int i = 4 * q4 + r; float ref = 0.f; for (int kk = 0; kk < 128; ++kk) ref += mx_a(i, kk) * mx_b(kk, l15); ok = ok && (fabsf(ref - c[r]) < 1e-3f); }
    return __all(ok);
}
#endif

#ifdef ATT_CHECK
__device__ __forceinline__ float f8dec(unsigned char b) { return __builtin_amdgcn_cvt_f32_fp8((int)b, 0); }
__device__ __forceinline__ void att_check(const Ctx& F, unsigned* ctl) {
    if (F.blk >= 8) return;
    const int sid = F.blk * 8 + F.wave, lane = F.lane, b = sid & 3, h = (sid >> 2) & 7;
    const bool isctx = sid >= 56; const int qt = isctx ? SEQ + (sid * 37) % 256 : (sid * 1237 + 11) % SEQ;
    const size_t r0 = (size_t)b * TPB; const size_t krow0 = r0 + (isctx ? SEQ : 0); const int nk = isctx ? LC : TPB;
    const unsigned char* Q8 = F.ws + WS_Q8 + (r0 + qt) * 1536 + h * 192; const unsigned char* KN8 = F.ws + WS_KN8 + krow0 * 1024 + h * 128; const unsigned char* KR8 = F.ws + WS_KR8 + krow0 * 64;
    const unsigned char* VT = F.ws + WS_VT8 + (size_t)((b * 8 + h) * 128) * 8448 + (isctx ? SEQ : 0); const unsigned char* O8 = F.ws + WS_O8 + (r0 + qt) * 1024 + h * 128;
    const float q0 = f8dec(Q8[lane]), q1 = f8dec(Q8[64 + lane]), q2 = f8dec(Q8[128 + lane]);
    float m = -1e30f, l = 0.f, a0 = 0.f, a1 = 0.f;
    for (int j = 0; j < nk; ++j) {
        const float part = q0 * f8dec(KN8[(size_t)j * 1024 + lane]) + q1 * f8dec(KN8[(size_t)j * 1024 + 64 + lane]) + q2 * f8dec(KR8[(size_t)j * 64 + lane]);
        const float s = wave_sum(part) * 0.07216878364870322f;
        const float mn = fmaxf(m, s), sc = __expf(m - mn), pj = __expf(s - mn); m = mn;
        l = l * sc + pj; { const size_t ko = (size_t)(j & ~63) + pg8::vpos(j & 63); a0 = a0 * sc + pj * f8dec(VT[(size_t)lane * 8448 + ko]); a1 = a1 * sc + pj * f8dec(VT[(size_t)(64 + lane) * 8448 + ko]); }
    }
    const float o0 = a0 / l, o1 = a1 / l, k0 = f8dec(O8[lane]), k1 = f8dec(O8[64 + lane]);
    const float err = wave_sum((o0 - k0) * (o0 - k0) + (o1 - k1) * (o1 - k1)), nrm = wave_sum(o0 * o0 + o1 * o1);
    if (lane == 0 && !(err <= 0.04f * nrm)) atomicOr(&ctl[64], 4u);
}
#endif
__device__ __forceinline__ void load_tstart(const Ctx& F) {
    const int* META = (const int*)(F.ws + WS_META); LAS int* ts = (LAS int*)(F.lds + TSTART_OFF);
    int t0 = threadIdx.x; asm volatile("" : "+v"(t0));
    if (t0 < 33) ts[t0] = META[64 + t0];
    __syncthreads();
    for (int rt = t0; rt < SROWS / 256; rt += NWAVES * 64) { int e = 0;
#pragma unroll 1
        for (int k = 1; k < 32; ++k) e += (ts[k] <= rt) ? 1 : 0;
        ts[64 + rt] = e; }
    __syncthreads();
}

typedef const __attribute__((address_space(4))) KP* KPc;
__device__ __forceinline__ const KP& kp_launder() { KPc q = (KPc)__builtin_amdgcn_kernarg_segment_ptr(); asm volatile("" : "+s"(q)); return *(const KP*)q; }
__global__ void __launch_bounds__(NWAVES * 64, 2) trunk_fwd(KP pk) {
#define p kp_launder()
    extern __shared__ __attribute__((aligned(16))) unsigned char lds_raw[];
    Ctx F;
    F.lds = (LAS unsigned char*)lds_raw; F.ws = p.ws;
    F.tid = threadIdx.x; F.lane = F.tid & 63; F.wave = __builtin_amdgcn_readfirstlane(F.tid >> 6); F.G = gridDim.x; F.blk = blockIdx.x;
    { int t0 = threadIdx.x; asm volatile("" : "+v"(t0));
      for (int u = t0; u < (LDS_BYTES - CTRL_OFF) / 4; u += NWAVES * 64) ((LAS unsigned*)(F.lds + CTRL_OFF))[u] = 0u; }
    __syncthreads();
    unsigned* ctl = (unsigned*)(p.ws + WS_CTL);
#if MK_PER_PHASE
#define GRID_BAR() do { } while (0)
#else
    XcdBarrier bar = xcd_barrier_post(ctl + CW_BAR, (volatile LAS unsigned*)(F.lds + MISC_OFF) + 8);
#define GRID_BAR() xcd_barrier(bar)
#endif
#ifdef MX_SELFTEST
    if (F.blk == 0 && F.wave == 0) { const bool h1 = mx_try(0, F.lane), h2 = mx_try(1, F.lane); if (F.lane == 0) ctl[64] = h1 ? 0u : (h2 ? 1u : 2u); }
#endif
    const int lo = p.ph_lo, hi = p.ph_hi;
#ifndef PH_MASK
#define PH_MASK 0xffffff
#endif
#define IN(k) (((PH_MASK >> (k)) & 1) && lo <= (k) && (k) < hi)
#define SEAM(k) do { if (IN(k) && IN((k) + 1)) GRID_BAR(); } while (0)
#ifndef REP_MASK
#define REP_MASK 0
#endif
#define NREP(k) (1 + ((REP_MASK >> (k)) & 1))
    unsigned char* ws = p.ws;
    const float* modv = (const float*)(ws + WS_MODV);
    LAS unsigned char* ring = F.lds;
    const LAS int* tstart = (const LAS int*)(F.lds + TSTART_OFF);

    if (IN(0)) _Pragma("unroll") for (int rep_ = 0; rep_ < NREP(0); ++rep_) { if (rep_) GRID_BAR(); phase_prologue(p, F); } SEAM(0);
    if (IN(1)) _Pragma("unroll") for (int rep_ = 0; rep_ < NREP(1); ++rep_) { if (rep_) GRID_BAR(); phase_norm1_l0(p, F); } SEAM(1);
    if (IN(2)) _Pragma("unroll") for (int rep_ = 0; rep_ < NREP(2); ++rep_) { if (rep_) GRID_BAR();
        pg8::Gemm g{(const pg8::bf16_t*)(ws + WS_H8), (const pg8::bf16_t*)(ws + WS_W_IN), M, 1024, 512}; pg8::StaticOrder S; S.init(M, 1024, F.G, F.blk);
        pg8::EpiBf16 E{(pg8::bf16_t*)(ws + WS_A1), 1024, nullptr, 0, 0, 0.03125f};
        pg8::gemm_phase<pg8::EpiBf16, pg8::StaticOrder, true, true, true>(ring, g, S, E);
    } SEAM(2);
    if (IN(3)) _Pragma("unroll") for (int rep_ = 0; rep_ < NREP(3); ++rep_) { if (rep_) GRID_BAR(); phase_mla_thin(p, F); } SEAM(3);
    if (IN(4)) _Pragma("unroll") for (int rep_ = 0; rep_ < NREP(4); ++rep_) { if (rep_) GRID_BAR();
        { pg8::Gemm g{(const pg8::bf16_t*)(ws + WS_CQ8), (const pg8::bf16_t*)(ws + WS_W_UQ), M, 1536, 256}; pg8::StaticOrder S; S.init(M, 1536, F.G, F.blk);
          pg8::EpiQRope E{ws + WS_Q8, (const float*)(ws + WS_ROPE), (const float*)(ws + WS_ROPE) + 2048, 0.03125f * (8.0f * 0.07216878364870322f * 1.4426950408889634f)};
          pg8::gemm_phase<pg8::EpiQRope, pg8::StaticOrder, true, true, true>(ring, g, S, E); }
        { pg8::Gemm g{(const pg8::bf16_t*)(ws + WS_CKV8), (const pg8::bf16_t*)(ws + WS_W_UKV), M, 2048, 128}; pg8::StaticOrder S; S.init(M, 2048, F.G, (F.blk + F.G / 2) % F.G);
          pg8::EpiKV E{ws + WS_KN8, ws + WS_VT8, 0.03125f};
          pg8::gemm_phase<pg8::EpiKV, pg8::StaticOrder, true, true, true>(ring, g, S, E); }
    } SEAM(4);
    if (IN(5)) _Pragma("unroll") for (int rep_ = 0; rep_ < NREP(5); ++rep_) { if (rep_) GRID_BAR(); phase_attention(F); } SEAM(5);
#ifdef ATT_CHECK
    if (IN(5) && IN(6)) { att_check(F, ctl); }
#endif
    if (IN(6)) _Pragma("unroll") for (int rep_ = 0; rep_ < NREP(6); ++rep_) { if (rep_) GRID_BAR();
        pg8::Gemm g{(const pg8::bf16_t*)(ws + WS_O8), (const pg8::bf16_t*)(ws + WS_W_O), M, 1024, 512}; pg8::StaticOrder S; S.init(M, 1024, F.G, F.blk);
        pg8::EpiResid E{p.x, p.ctx, (pg8::bf16_t*)(ws + WS_XRES), modv + 2048, 0.03125f};
        pg8::gemm_phase<pg8::EpiResid, pg8::StaticOrder, true, true, true>(ring, g, S, E);
    } SEAM(6);
    if (IN(7)) _Pragma("unroll") for (int rep_ = 0; rep_ < NREP(7); ++rep_) { if (rep_) GRID_BAR(); phase_router(p, F, 0, false); } SEAM(7);
    if (IN(8)) _Pragma("unroll") for (int rep_ = 0; rep_ < NREP(8); ++rep_) { if (rep_) GRID_BAR(); phase_lists(p, F, false); } SEAM(8);
    if (IN(9)) _Pragma("unroll") for (int rep_ = 0; rep_ < NREP(9); ++rep_) { if (rep_) GRID_BAR();
        load_tstart(F);
        pg8::Gemm g{(const pg8::bf16_t*)(ws + WS_H8), (const pg8::bf16_t*)(ws + WS_W_GU), 0, 2048, 512}; pg8::MoeOrder S{tstart, 3, F.G, F.blk};
        pg8::EpiSwiglu E{ws + WS_ACT, p.moe_b_gu, 0.03125f};
        pg8::gemm_phase_gather<pg8::EpiSwiglu, pg8::MoeOrder, true>(ring, g, (const int*)(ws + WS_SORT), S, E);
    } SEAM(9);
    if (IN(10)) _Pragma("unroll") for (int rep_ = 0; rep_ < NREP(10); ++rep_) { if (rep_) GRID_BAR();
        load_tstart(F);
        pg8::Gemm g{(const pg8::bf16_t*)(ws + WS_ACT), (const pg8::bf16_t*)(ws + WS_W_DN), 0, 1024, 512}; pg8::MoeOrder S{tstart, 2, F.G, F.blk};
        pg8::EpiDown8 E{ws + WS_YS, p.moe_b_down, 0.03125f};
        pg8::gemm_phase<pg8::EpiDown8, pg8::MoeOrder, true, true, true>(ring, g, S, E);
    } SEAM(10);
    if (IN(11)) _Pragma("unroll") for (int rep_ = 0; rep_ < NREP(11); ++rep_) { if (rep_) GRID_BAR(); phase_combine<false>(p, F, 0); } SEAM(11);

    if (IN(12)) _Pragma("unroll") for (int rep_ = 0; rep_ < NREP(12); ++rep_) { if (rep_) GRID_BAR();
        pg8::Gemm g{(const pg8::bf16_t*)(ws + WS_H), (const pg8::bf16_t*)(ws + WS_W_GIN), M, A2W, 1024}; pg8::StaticOrder S; S.init(M, A2W, F.G, F.blk);
        pg8::EpiGla E{(pg8::bf16_t*)(ws + WS_A2), (pg8::bf16_t*)(ws + WS_VT)};
        pg8::gemm_phase<pg8::EpiGla, pg8::StaticOrder, true, true>(ring, g, S, E);
    } SEAM(12);
    if (IN(14)) _Pragma("unroll") for (int rep_ = 0; rep_ < NREP(14); ++rep_) { if (rep_) GRID_BAR(); phase_gla_units<false>(p, F); } SEAM(14);
    if (IN(15)) _Pragma("unroll") for (int rep_ = 0; rep_ < NREP(15); ++rep_) { if (rep_) GRID_BAR(); phase_gla_scan(F); } SEAM(15);
    if (IN(16)) _Pragma("unroll") for (int rep_ = 0; rep_ < NREP(16); ++rep_) { if (rep_) GRID_BAR(); phase_gla_units<true>(p, F); } SEAM(16);
    if (IN(17)) _Pragma("unroll") for (int rep_ = 0; rep_ < NREP(17); ++rep_) { if (rep_) GRID_BAR(); phase_gla_finish(p, F); } SEAM(17);
    if (IN(18)) _Pragma("unroll") for (int rep_ = 0; rep_ < NREP(18); ++rep_) { if (rep_) GRID_BAR();
        pg8::Gemm g{(const pg8::bf16_t*)(ws + WS_Z), (const pg8::bf16_t*)(ws + WS_W_GO), M, 1024, 1024}; pg8::LatentOrder S; S.init(1024, F.G, F.blk);
        pg8::EpiResid E{nullptr, nullptr, (pg8::bf16_t*)(ws + WS_XRES), modv + 5 * 6144 + 2048, 1.0f};
        pg8::gemm_phase<pg8::EpiResid, pg8::LatentOrder, true, true>(ring, g, S, E);
    } SEAM(18);
    if (IN(19)) _Pragma("unroll") for (int rep_ = 0; rep_ < NREP(19); ++rep_) { if (rep_) GRID_BAR(); phase_router(p, F, 1, true); } SEAM(19);
    if (IN(20)) _Pragma("unroll") for (int rep_ = 0; rep_ < NREP(20); ++rep_) { if (rep_) GRID_BAR(); phase_lists(p, F, true); } SEAM(20);
    if (IN(21)) _Pragma("unroll") for (int rep_ = 0; rep_ < NREP(21); ++rep_) { if (rep_) GRID_BAR();
        load_tstart(F);
        pg8::Gemm g{(const pg8::bf16_t*)(ws + WS_H8), (const pg8::bf16_t*)(ws + WS_W_GU + (size_t)65536 * 1024), 0, 2048, 512}; pg8::MoeOrder S{tstart, 3, F.G, F.blk};
        pg8::EpiSwiglu E{ws + WS_ACT, p.moe_b_gu + 32 * 2048, 0.03125f};
        pg8::gemm_phase_gather<pg8::EpiSwiglu, pg8::MoeOrder, true>(ring, g, (const int*)(ws + WS_SORT), S, E);
    } SEAM(21);
    if (IN(22)) _Pragma("unroll") for (int rep_ = 0; rep_ < NREP(22); ++rep_) { if (rep_) GRID_BAR();
        load_tstart(F);
        pg8::Gemm g{(const pg8::bf16_t*)(ws + WS_ACT), (const pg8::bf16_t*)(ws + WS_W_DN + (size_t)32768 * 1024), 0, 1024, 512}; pg8::MoeOrder S{tstart, 2, F.G, F.blk};
        pg8::EpiDown8 E{ws + WS_YS, p.moe_b_down + 32 * 1024, 0.03125f};
        pg8::gemm_phase<pg8::EpiDown8, pg8::MoeOrder, true, true, true>(ring, g, S, E);
    } SEAM(22);
    if (IN(23)) _Pragma("unroll") for (int rep_ = 0; rep_ < NREP(23); ++rep_) { if (rep_) GRID_BAR(); phase_combine<true>(p, F, 1); }
#undef IN
#undef SEAM
#undef GRID_BAR
#undef p
}

extern "C" void kernel_launch(void* const* d_in, const int* in_sizes, int n_in, void* d_out, int out_size, void* d_ws, size_t ws_size, hipStream_t stream) {
    static int grid = 0;
    if (grid == 0) {
        if (n_in != 27 || in_sizes[0] != NB * SEQ * DM || out_size != NB * SEQ * DM || ws_size < WS_END) {
            fprintf(stderr, "kernel_launch: shape mismatch (n_in %d, in0 %d, out %d, ws %zu, need ws >= %zu); nothing launched\n", n_in, n_in > 0 ? in_sizes[0] : -1, out_size, ws_size, (size_t)WS_END); grid = -1; return; }
        int dev = 0, cus = 0, per_cu = 0;
        if (hipGetDevice(&dev) != hipSuccess || hipDeviceGetAttribute(&cus, hipDeviceAttributeMultiprocessorCount, dev) != hipSuccess) { fprintf(stderr, "kernel_launch: device query failed\n"); grid = -1; return; }
        if (hipFuncSetAttribute((const void*)trunk_fwd, hipFuncAttributeMaxDynamicSharedMemorySize, LDS_BYTES) != hipSuccess) { fprintf(stderr, "kernel_launch: hipFuncSetAttribute failed\n"); grid = -1; return; }
        if (hipOccupancyMaxActiveBlocksPerMultiprocessor(&per_cu, (const void*)trunk_fwd, NWAVES * 64, LDS_BYTES) != hipSuccess || per_cu < 1)
            fprintf(stderr, "kernel_launch: note: occupancy query reports %d workgroups per CU\n", per_cu);
        (void)hipGetLastError();
        grid = cus;
        if (grid != 256) { fprintf(stderr, "kernel_launch: built for a 256-CU device (got %d CUs); nothing launched\n", cus); grid = -1; return; }
    }
    if (grid < 0) return;
    if (hipMemsetAsync((char*)d_ws + WS_CTL, 0, CTL_ZERO_BYTES, stream) != hipSuccess) { fprintf(stderr, "kernel_launch: memset failed\n"); return; }
    KP a{};
    const float** pp = (const float**)&a;
    for (int i = 0; i < 27; ++i) pp[i] = (const float*)d_in[i];
    a.out = (float*)d_out; a.ws = (unsigned char*)d_ws;
#if MK_PER_PHASE
    for (int ph = 0; ph < NPHASE; ++ph) { a.ph_lo = ph; a.ph_hi = ph + 1; hipLaunchKernelGGL(trunk_fwd, dim3(grid), dim3(NWAVES * 64), LDS_BYTES, stream, a); }
#else
    a.ph_lo = 0; a.ph_hi = NPHASE;
    hipLaunchKernelGGL(trunk_fwd, dim3(grid), dim3(NWAVES * 64), LDS_BYTES, stream, a);
#endif
    const hipError_t le = hipPeekAtLastError();
    if (le != hipSuccess) fprintf(stderr, "kernel_launch: launch failed: %s\n", hipGetErrorName(le));
}
```

```cpp
#include <hip/hip_runtime.h>
#include <cstdio>
#include <cstdint>

#ifndef MK_PER_PHASE
#define MK_PER_PHASE 0
#endif

constexpr int DM = 1024, NB = 4, SEQ = 8192, LC = 256, TPB = SEQ + LC, M = NB * TPB;
constexpr int NE = 32, TOPK = 4;
constexpr int NLAT = NB * SEQ;
constexpr int SROWS = (M * TOPK) + NE * 256;
constexpr int A2W = 3328;
constexpr float EPS = 1e-6f;

constexpr size_t MiB = 1u << 20;
constexpr size_t WS_CTL = 0, CTL_ZERO_BYTES = 1 * MiB;
constexpr size_t WS_MODV = 1 * MiB;
constexpr size_t WS_ROPE = 1 * MiB + 256 * 1024;
constexpr size_t WS_HIST = 1 * MiB + 512 * 1024;
constexpr size_t WS_META = WS_HIST + 64 * 1024;
constexpr size_t WS_TOPI = 2 * MiB, WS_TOPW = 3 * MiB, WS_POS = 4 * MiB, WS_SORT = 5 * MiB, WS_DS = 6 * MiB;
constexpr size_t WS_W_IN = 8 * MiB, WS_W_UQ = 10 * MiB, WS_W_UKV = 12 * MiB, WS_W_O = 14 * MiB, WS_W_GIN = 16 * MiB, WS_W_GO = 24 * MiB;
constexpr size_t WS_W_GU = 32 * MiB, WS_W_DN = 288 * MiB;
constexpr size_t WS_H = 416 * MiB;
constexpr size_t WS_XRES = 482 * MiB;
constexpr size_t WS_ACT = 614 * MiB;
constexpr size_t WS_YS = 894 * MiB;
constexpr size_t WS_A1 = 1174 * MiB, WS_CQ = 1240 * MiB, WS_CKV = 1273 * MiB, WS_KR = 1290 * MiB, WS_Q = 1295 * MiB, WS_KN = 1394 * MiB, WS_V = 1460 * MiB, WS_O = 1526 * MiB;
constexpr size_t WS_A2 = 1174 * MiB;
constexpr size_t WS_UST = 1389 * MiB;
constexpr size_t WS_OF = 1517 * MiB, WS_OB = 1583 * MiB, WS_Z = 1649 * MiB;
constexpr size_t WS_QE = 614 * MiB, WS_KE = 680 * MiB, WS_KPT = 746 * MiB, WS_VT = 812 * MiB, WS_DEC = 878 * MiB;
constexpr size_t WS_H8 = 1715 * MiB;
constexpr size_t WS_CQ8 = 1749 * MiB, WS_CKV8 = 1766 * MiB, WS_O8 = 1775 * MiB;
constexpr size_t WS_Q8 = 1295 * MiB, WS_KN8 = 1394 * MiB, WS_KR8 = 1290 * MiB;
constexpr size_t WS_VT8 = 1460 * MiB;
constexpr size_t WS_END = 1809 * MiB;
static_assert((size_t)M * 1024 * 2 <= 66 * MiB && (size_t)M * 1024 * 4 <= 132 * MiB && (size_t)SROWS * 1024 * 2 <= 280 * MiB && (size_t)M * A2W * 2 <= 215 * MiB, "ws map");
static_assert((size_t)M * 512 * 2 <= 33 * MiB && (size_t)M * 256 * 2 <= 17 * MiB && (size_t)M * 64 * 2 <= 5 * MiB && (size_t)M * 1536 * 2 <= 99 * MiB, "ws map");

#define GAS __attribute__((address_space(1)))
#define LAS __attribute__((address_space(3)))
typedef unsigned short bf16;
typedef unsigned v4u __attribute__((ext_vector_type(4)));
typedef unsigned v2u __attribute__((ext_vector_type(2)));
typedef float f32x4 __attribute__((ext_vector_type(4)));
typedef float f32x16 __attribute__((ext_vector_type(16)));
typedef short bf16x8 __attribute__((ext_vector_type(8)));
typedef short s16x4 __attribute__((ext_vector_type(4)));
typedef GAS unsigned gu32;
#define RLX_AGENT __ATOMIC_RELAXED, __HIP_MEMORY_SCOPE_AGENT
#define LDS_WAIT() asm volatile("s_waitcnt lgkmcnt(0)" ::: "memory")
#define VM_WAIT() asm volatile("s_waitcnt vmcnt(0)" ::: "memory")
__device__ __forceinline__ unsigned f2bf(float f) { unsigned u = __builtin_bit_cast(unsigned, f); return (u + 0x7fffu + ((u >> 16) & 1u)) >> 16; }
__device__ __forceinline__ unsigned pk2(float lo, float hi) { return f2bf(lo) | (f2bf(hi) << 16); }
__device__ __forceinline__ unsigned pk2h(float lo, float hi) { unsigned r; asm volatile("v_cvt_pk_bf16_f32 %0, %1, %2" : "=v"(r) : "v"(lo), "v"(hi)); return r; }
__device__ __forceinline__ float bf2f(unsigned b) { return __builtin_bit_cast(float, b << 16); }
__device__ __forceinline__ float bflo(unsigned w) { return __builtin_bit_cast(float, w << 16); }
__device__ __forceinline__ float bfhi(unsigned w) { return __builtin_bit_cast(float, w & 0xffff0000u); }
__device__ __forceinline__ float wave_sum(float v) {
#pragma unroll
    for (int o = 1; o < 64; o <<= 1) v += __shfl_xor(v, o);
    return v;
}

struct KP {
    const float *x, *c, *ctx, *c_ctx, *mod_w, *mod_b, *norm1, *norm2, *mla_w_in, *mla_q_norm, *mla_w_uq, *mla_kv_norm, *mla_w_ukv, *mla_w_o,
        *gla_w_in, *gla_w_gate1, *gla_w_gate2, *gla_b_gate, *gla_head_norm, *gla_w_o, *moe_w_router, *moe_b_router, *moe_w_gu, *moe_b_gu, *moe_w_down, *moe_b_down, *final_norm;
    float* out; unsigned char* ws; int ph_lo, ph_hi;
};
namespace pg8 {
#define PG8_LAS __attribute__((address_space(3)))
typedef unsigned short bf16_t;
typedef short bf16x8 __attribute__((ext_vector_type(8)));
typedef float f32x4 __attribute__((ext_vector_type(4)));
typedef unsigned u32x4 __attribute__((ext_vector_type(4)));
constexpr int BM = 256, BK = 64, HALF = 128, HTB = HALF * BK * 2  , STAGE_BYTES = 8 * HTB, NXCD = 8, WGM = 8;

__host__ __device__ __forceinline__ int lds_byte(int r, int c) { const int st = (r >> 4) * 2 + (c >> 5), rr = r & 15, cc = c & 31, ob = rr * 64 + cc * 2; return st * 1024 + (ob ^ (((ob >> 9) & 1) << 5)); }
__host__ __device__ __forceinline__ void stage_rc(int b, int& R, int& C) { const int st = b / 1024, sb = b % 1024, swz = sb ^ (((sb >> 9) & 1) << 5); R = (st >> 1) * 16 + swz / 64; C = (st & 1) * 32 + (swz % 64) / 2; }
__host__ __device__ __forceinline__ int perm32(int rho) { const int n = rho >> 4, i = rho & 15; return 8 * (i >> 2) + 4 * n + (i & 3); }

struct Unit { int pm, pn; };
struct Gemm { const bf16_t* A; const bf16_t* Bt; int M, N, K; };

struct StaticOrder {
    int nM, nN, nwg, G, c;
    __host__ __device__ void init(int M, int N, int G_, int c_) { nM = M / BM; nN = N / BM; nwg = nM * nN; G = G_; c = c_; }
    __host__ __device__ bool next(int i, Unit& u) const {
        const long L = (long)i * G + c; if (L >= nwg) return false;
        int wgid = (int)L; { const int q = nwg / NXCD, r = nwg % NXCD, xcd = wgid % NXCD, off = wgid / NXCD; wgid = (xcd < r ? xcd * (q + 1) : r * (q + 1) + (xcd - r) * q) + off; }
        const int nig = WGM * nN, gid = wgid / nig, fm = gid * WGM, gsz = (nM - fm) < WGM ? (nM - fm) : WGM;
        u.pm = fm + ((wgid % nig) % gsz); u.pn = (wgid % nig) / gsz; return true;
    }
    __device__ __forceinline__ void a_ready(const Unit&) const {}
    __device__ __forceinline__ void done(const Unit&) const {}
};

__device__ __forceinline__ unsigned cvt_pk_bf16(float lo, float hi) { unsigned r; asm volatile("v_cvt_pk_bf16_f32 %0, %1, %2" : "=v"(r) : "v"(lo), "v"(hi)); return r; }
typedef unsigned u32x2 __attribute__((ext_vector_type(2)));
typedef float f32x8 __attribute__((ext_vector_type(8)));
__device__ __forceinline__ f32x4 ag(const f32x4 (&a)[2][2][4][2], int ai, int bj, int m, int n) { return a[ai][bj][m][n]; }
__device__ __forceinline__ f32x4 ag(const f32x8 (&a)[2][2][4], int ai, int bj, int m, int n) { return n == 0 ? __builtin_shufflevector(a[ai][bj][m], a[ai][bj][m], 0, 1, 2, 3) : __builtin_shufflevector(a[ai][bj][m], a[ai][bj][m], 4, 5, 6, 7); }

struct EpiBf16 {
    static constexpr bool PERM = true, AFTER_DRAIN = false;
    bf16_t* O; int ldc; const float* bias; int split_cols; size_t split_stride; float ascale;
    template <class AccT> __device__ __forceinline__ void operator()(const AccT& acc, const Unit& u, int wr, int wc, int fr, int fq) const {
        const int row0 = u.pm * BM + wr * 64 + fr; int colt = u.pn * BM; bf16_t* base = O;
        if (split_cols) { const int t = colt / split_cols; base += (size_t)t * split_stride; colt -= t * split_cols; }
        const int col0 = colt + wc * 32 + 8 * fq, bcol0 = u.pn * BM + wc * 32 + 8 * fq;
        f32x4 bv[2][2];
#pragma unroll
        for (int bj = 0; bj < 2; ++bj)
#pragma unroll
            for (int n = 0; n < 2; ++n) bv[bj][n] = bias ? *(const f32x4*)(bias + bcol0 + bj * HALF + 4 * n) : (f32x4){0.f, 0.f, 0.f, 0.f};
#pragma unroll
        for (int ai = 0; ai < 2; ++ai)
#pragma unroll
            for (int m = 0; m < 4; ++m) { bf16_t* rowp = base + (size_t)(row0 + ai * HALF + m * 16) * ldc + col0;
#pragma unroll
                for (int bj = 0; bj < 2; ++bj) { const f32x4 v0 = ag(acc, ai, bj, m, 0) * ascale + bv[bj][0], v1 = ag(acc, ai, bj, m, 1) * ascale + bv[bj][1];
                    u32x4 w; w.x = cvt_pk_bf16(v0[0], v0[1]); w.y = cvt_pk_bf16(v0[2], v0[3]); w.z = cvt_pk_bf16(v1[0], v1[1]); w.w = cvt_pk_bf16(v1[2], v1[3]);
                    *(u32x4*)(rowp + bj * HALF) = w; } }
    }
};

struct EpiDown8 {
    static constexpr bool PERM = true, AFTER_DRAIN = false;
    unsigned char* ys; const float* bias; float ascale;
    template <class AccT> __device__ __forceinline__ void operator()(const AccT& acc, const Unit& u, int wr, int wc, int fr, int fq) const {
        const int row0 = u.pm * BM + wr * 64 + fr;
        const int cst = (u.pn & 3) * BM + wc * 32 + 8 * (fq & ~1) + (fq & 1) * HALF;
#pragma unroll
        for (int ai = 0; ai < 2; ++ai)
#pragma unroll
            for (int m = 0; m < 4; ++m) { unsigned w[2][2];
#pragma unroll
                for (int bj = 0; bj < 2; ++bj) { const f32x4 v0 = ag(acc, ai, bj, m, 0), v1 = ag(acc, ai, bj, m, 1);
                    int w0 = 0, w1 = 0; w0 = __builtin_amdgcn_cvt_pk_fp8_f32(v0[0], v0[1], w0, false); w0 = __builtin_amdgcn_cvt_pk_fp8_f32(v0[2], v0[3], w0, true);
                    w1 = __builtin_amdgcn_cvt_pk_fp8_f32(v1[0], v1[1], w1, false); w1 = __builtin_amdgcn_cvt_pk_fp8_f32(v1[2], v1[3], w1, true);
                    w[bj][0] = (unsigned)w0; w[bj][1] = (unsigned)w1; }
                const auto s0 = __builtin_amdgcn_permlane16_swap(w[0][0], w[1][0], false, false), s1 = __builtin_amdgcn_permlane16_swap(w[0][1], w[1][1], false, false);
                *(u32x4*)(ys + (size_t)(row0 + ai * HALF + m * 16) * 1024 + cst) = (u32x4){s0[0], s1[0], s0[1], s1[1]}; }
    }
};

__host__ __device__ __forceinline__ int vpos(int kl) { const int half = kl >> 5, k5 = kl & 31, hi = (k5 >> 2) & 1, r = (k5 & 3) + 4 * (k5 >> 3); return hi * 32 + half * 16 + r; }
struct EpiKV {
    static constexpr bool PERM = true, AFTER_DRAIN = false;
    unsigned char* KN8; unsigned char* VT8; float ascale;
    template <class AccT> __device__ __forceinline__ void operator()(const AccT& acc, const Unit& u, int wr, int wc, int fr, int fq) const {
        const int row0 = u.pm * BM + wr * 64 + fr; const bool isk = u.pn < 4; const int col0 = (u.pn & 3) * BM + wc * 32 + 8 * fq;
        const int cst = (u.pn & 3) * BM + wc * 32 + 8 * (fq & ~1) + (fq & 1) * HALF;
        const int b = u.pm / 33, kk0 = (u.pm % 33) * BM + wr * 64 + fr;
#pragma unroll
        for (int ai = 0; ai < 2; ++ai)
#pragma unroll
            for (int m = 0; m < 4; ++m) { const size_t rrow = (size_t)(row0 + ai * HALF + m * 16) * 1024; const int kk = kk0 + ai * HALF + m * 16; const size_t kofs = (size_t)(kk & ~63) + vpos(kk & 63);
                unsigned w[2][2];
#pragma unroll
                for (int bj = 0; bj < 2; ++bj) { const f32x4 v0 = ag(acc, ai, bj, m, 0), v1 = ag(acc, ai, bj, m, 1);
                    int w0 = 0, w1 = 0; w0 = __builtin_amdgcn_cvt_pk_fp8_f32(v0[0], v0[1], w0, false); w0 = __builtin_amdgcn_cvt_pk_fp8_f32(v0[2], v0[3], w0, true);
                    w1 = __builtin_amdgcn_cvt_pk_fp8_f32(v1[0], v1[1], w1, false); w1 = __builtin_amdgcn_cvt_pk_fp8_f32(v1[2], v1[3], w1, true);
                    w[bj][0] = (unsigned)w0; w[bj][1] = (unsigned)w1; }
                if (isk) {
                    const auto s0 = __builtin_amdgcn_permlane16_swap(w[0][0], w[1][0], false, false), s1 = __builtin_amdgcn_permlane16_swap(w[0][1], w[1][1], false, false);
                    *(u32x4*)(KN8 + rrow + cst) = (u32x4){s0[0], s1[0], s0[1], s1[1]};
                } else {
#pragma unroll
                    for (int bj = 0; bj < 2; ++bj) { const int c = col0 + bj * HALF;
                        unsigned char* vp = VT8 + ((size_t)(b * 8 * 128 + c)) * 8448 + kofs;
#pragma unroll
                        for (int i = 0; i < 4; ++i) { vp[(size_t)i * 8448] = (unsigned char)(w[bj][0] >> (8 * i)); vp[(size_t)(4 + i) * 8448] = (unsigned char)(w[bj][1] >> (8 * i)); } } } }
    }
};

struct EpiQRope {
    static constexpr bool PERM = true, AFTER_DRAIN = false;
    unsigned char* O; const float* tcos; const float* tsin; float ascale;
    template <class AccT> __device__ __forceinline__ void operator()(const AccT& acc, const Unit& u, int wr, int wc, int fr, int fq) const {
        const int tt = u.pm % 33; const bool latent = tt != 32; const int t0 = tt * 256;
        const int colg = u.pn * BM + wc * 32;
#pragma unroll
        for (int bj = 0; bj < 2; ++bj) {
            const int gm = ((colg + bj * HALF) >> 5) % 6; const bool rope = latent && gm >= 4; const int axis = gm - 4;
#pragma unroll
            for (int ai = 0; ai < 2; ++ai)
#pragma unroll
                for (int m = 0; m < 4; ++m) {
                    const int rloc = ai * HALF + wr * 64 + m * 16 + fr; const int t = t0 + rloc;
                    f32x4 v0 = ag(acc, ai, bj, m, 0) * ascale, v1 = ag(acc, ai, bj, m, 1) * ascale;
                    if (rope) {
                        const int comp = axis == 0 ? (t >> 6) : (t & 63); const int fo = comp * 16 + (fq & 1) * 8;
                        { const f32x4 c0 = *(const f32x4*)(tcos + fo), s0 = *(const f32x4*)(tsin + fo); f32x4 p0;
#pragma unroll
                          for (int i = 0; i < 4; ++i) p0[i] = __shfl_xor(v0[i], 32);
                          v0 = fq < 2 ? v0 * c0 - p0 * s0 : v0 * c0 + p0 * s0; }
                        { const f32x4 c1 = *(const f32x4*)(tcos + fo + 4), s1 = *(const f32x4*)(tsin + fo + 4); f32x4 p1;
#pragma unroll
                          for (int i = 0; i < 4; ++i) p1[i] = __shfl_xor(v1[i], 32);
                          v1 = fq < 2 ? v1 * c1 - p1 * s1 : v1 * c1 + p1 * s1; }
                    }
                    int w0 = 0, w1 = 0; w0 = __builtin_amdgcn_cvt_pk_fp8_f32(v0[0], v0[1], w0, false); w0 = __builtin_amdgcn_cvt_pk_fp8_f32(v0[2], v0[3], w0, true);
                    w1 = __builtin_amdgcn_cvt_pk_fp8_f32(v1[0], v1[1], w1, false); w1 = __builtin_amdgcn_cvt_pk_fp8_f32(v1[2], v1[3], w1, true);
                    *(u32x2*)(O + (size_t)(u.pm * BM + rloc) * 1536 + colg + bj * HALF + 8 * fq) = (u32x2){(unsigned)w0, (unsigned)w1};
                }
        }
    }
};

struct EpiGla {
    static constexpr bool PERM = true, AFTER_DRAIN = false;
    bf16_t* A2; bf16_t* VT;
    template <class AccT> __device__ __forceinline__ void operator()(const AccT& acc, const Unit& u, int wr, int wc, int fr, int fq) const {
        const int row0 = u.pm * BM + wr * 64 + fr; const int col0 = u.pn * BM + wc * 32 + 8 * fq; const bool isv = (u.pn >> 2) == 1;
#pragma unroll
        for (int ai = 0; ai < 2; ++ai)
#pragma unroll
            for (int m = 0; m < 4; ++m) { const int row = row0 + ai * HALF + m * 16;
#pragma unroll
                for (int bj = 0; bj < 2; ++bj) { const f32x4 v0 = ag(acc, ai, bj, m, 0), v1 = ag(acc, ai, bj, m, 1);
                    u32x4 w; w.x = cvt_pk_bf16(v0[0], v0[1]); w.y = cvt_pk_bf16(v0[2], v0[3]); w.z = cvt_pk_bf16(v1[0], v1[1]); w.w = cvt_pk_bf16(v1[2], v1[3]);
                    if (!isv) { *(u32x4*)(A2 + (size_t)row * 3328 + col0 + bj * HALF) = w; }
                    else { bf16_t* vp = VT + ((size_t)(row >> 6) * 1024 + (col0 + bj * HALF - 1024)) * 64 + (row & 63);
                        vp[0] = (bf16_t)(w.x & 0xffffu); vp[64] = (bf16_t)(w.x >> 16); vp[128] = (bf16_t)(w.y & 0xffffu); vp[192] = (bf16_t)(w.y >> 16);
                        vp[256] = (bf16_t)(w.z & 0xffffu); vp[320] = (bf16_t)(w.z >> 16); vp[384] = (bf16_t)(w.w & 0xffffu); vp[448] = (bf16_t)(w.w >> 16); } } }
    }
};

struct EpiResid {
    static constexpr bool PERM = true, AFTER_DRAIN = false;
    const float* xin; const float* ctxin; bf16_t* xres; const float* gate; float ascale;
    template <class AccT> __device__ __forceinline__ void operator()(const AccT& acc, const Unit& u, int wr, int wc, int fr, int fq) const {
        const int b = u.pm / 33, tt = u.pm % 33; const bool isctx = tt == 32; const int bs = isctx ? 4 : b;
        bf16_t* dst = xres + (size_t)u.pm * BM * 1024;
        const float* src = xin ? (isctx ? ctxin + (size_t)b * 256 * 1024 : xin + ((size_t)b * 8192 + (size_t)tt * 256) * 1024) : nullptr;
        const float* g = gate + bs * 6144;
        const int r0 = wr * 64 + fr, c0 = u.pn * BM + wc * 32 + 8 * fq;
#pragma unroll
        for (int ai = 0; ai < 2; ++ai)
#pragma unroll
            for (int m = 0; m < 4; ++m) { const size_t ro = (size_t)(r0 + ai * HALF + m * 16) * 1024;
#pragma unroll
                for (int bj = 0; bj < 2; ++bj) { const int c = c0 + bj * HALF;
                    f32x4 x0, x1;
                    if (src) { x0 = *(const f32x4*)(src + ro + c); x1 = *(const f32x4*)(src + ro + c + 4); }
                    else { const u32x4 xb = *(const u32x4*)(dst + ro + c);
                        x0 = (f32x4){__builtin_bit_cast(float, xb.x << 16), __builtin_bit_cast(float, xb.x & 0xffff0000u), __builtin_bit_cast(float, xb.y << 16), __builtin_bit_cast(float, xb.y & 0xffff0000u)};
                        x1 = (f32x4){__builtin_bit_cast(float, xb.z << 16), __builtin_bit_cast(float, xb.z & 0xffff0000u), __builtin_bit_cast(float, xb.w << 16), __builtin_bit_cast(float, xb.w & 0xffff0000u)}; }
                    const f32x4 g0 = *(const f32x4*)(g + c), g1 = *(const f32x4*)(g + c + 4);
                    const f32x4 v0 = x0 + g0 * ag(acc, ai, bj, m, 0), v1 = x1 + g1 * ag(acc, ai, bj, m, 1);
                    u32x4 w; w.x = cvt_pk_bf16(v0[0], v0[1]); w.y = cvt_pk_bf16(v0[2], v0[3]); w.z = cvt_pk_bf16(v1[0], v1[1]); w.w = cvt_pk_bf16(v1[2], v1[3]);
                    *(u32x4*)(dst + ro + c) = w; } }
    }
};

__device__ __forceinline__ float swiglu1(float g, float up) {
    g = fminf(g, 7.0f); up = fminf(fmaxf(up, -7.0f), 7.0f);
    return (up + 1.0f) * g * __builtin_amdgcn_rcpf(1.0f + __expf(-1.702f * g));
}
__device__ __forceinline__ float swiglu1p(float g, float up1) {
    g = fminf(g, 7.0f); up1 = fminf(fmaxf(up1, -6.0f), 8.0f);
    return up1 * g * __builtin_amdgcn_rcpf(1.0f + __expf(-1.702f * g));
}
struct EpiSwiglu {
    static constexpr bool PERM = true, AFTER_DRAIN = false;
    unsigned char* act; const float* bgu; float ascale;
    template <class AccT> __device__ __forceinline__ void operator()(const AccT& acc, const Unit& u, int wr, int wc, int fr, int fq) const {
        const int e = u.pn >> 3, ct = u.pn & 7; const int lc0 = ct * BM + wc * 32 + 8 * fq; const int row0 = u.pm * BM + wr * 64 + fr;
#pragma unroll
        for (int bj = 0; bj < 2; ++bj) { const int lc = lc0 + bj * HALF;
#pragma unroll
            for (int ai = 0; ai < 2; ++ai) { unsigned w[4];
#pragma unroll
                for (int m = 0; m < 4; ++m) { const f32x4 v0 = ag(acc, ai, bj, m, 0), v1 = ag(acc, ai, bj, m, 1);
                    int x = 0; x = __builtin_amdgcn_cvt_pk_fp8_f32(swiglu1p(v0[0], v0[1]), swiglu1p(v0[2], v0[3]), x, false); x = __builtin_amdgcn_cvt_pk_fp8_f32(swiglu1p(v1[0], v1[1]), swiglu1p(v1[2], v1[3]), x, true);
                    w[m] = (unsigned)x; }
                const auto p02 = __builtin_amdgcn_permlane32_swap(w[0], w[2], false, false), p13 = __builtin_amdgcn_permlane32_swap(w[1], w[3], false, false);
                const auto q01 = __builtin_amdgcn_permlane16_swap(p02[0], p13[0], false, false), q23 = __builtin_amdgcn_permlane16_swap(p02[1], p13[1], false, false);
                *(u32x4*)(act + (size_t)(row0 + ai * HALF + fq * 16) * 1024 + ct * HALF + wc * 16 + bj * 64) = (u32x4){q01[0], q01[1], q23[0], q23[1]}; } }
    }
};

struct LatentOrder {
    StaticOrder so;
    __device__ void init(int N, int G_, int c_) { so.init(128 * BM, N, G_, c_); }
    __device__ bool next(int i, Unit& u) const { if (!so.next(i, u)) return false; u.pm = (u.pm >> 5) * 33 + (u.pm & 31); return true; }
    __device__ __forceinline__ void a_ready(const Unit&) const {}
    __device__ __forceinline__ void done(const Unit&) const {}
};
struct MoeOrder {
    const PG8_LAS int* tstart; int sh, G, c;
    __device__ bool next(int i, Unit& u) const {
        const int NT = tstart[32]; int rt, ct;
        if ((G & 7) == 0) { const int x = c & 7, q = c >> 3, nq = G >> 3; const int uu = i * nq + q; const int per = (NT + 7) >> 3, rl = uu >> sh; if (rl >= per) return false; rt = x * per + rl; ct = uu & ((1 << sh) - 1); }
        else { const long L = (long)i * G + c; rt = (int)(L >> sh); ct = (int)(L & ((1 << sh) - 1)); }
        if (rt >= NT) return false;
        const int e = tstart[64 + rt];
        u.pm = rt; u.pn = (e << sh) + ct; return true;
    }
    __device__ __forceinline__ void a_ready(const Unit&) const {}
    __device__ __forceinline__ void done(const Unit&) const {}
};

typedef int v8i32 __attribute__((ext_vector_type(8)));
__device__ __forceinline__ v8i32 cat8(bf16x8 lo, bf16x8 hi) { typedef int v4i32 __attribute__((ext_vector_type(4))); const v4i32 a = __builtin_bit_cast(v4i32, lo), b = __builtin_bit_cast(v4i32, hi); return (v8i32){a[0], a[1], a[2], a[3], b[0], b[1], b[2], b[3]}; }
template <class Epi> __device__ __forceinline__ void acc_init(const Epi&, f32x4 (&acc)[2][2][4][2], const Unit&, int, int, int, int) {
#pragma unroll
    for (int a = 0; a < 2; ++a)
#pragma unroll
        for (int b = 0; b < 2; ++b)
#pragma unroll
            for (int m = 0; m < 4; ++m)
#pragma unroll
                for (int n = 0; n < 2; ++n) acc[a][b][m][n] = (f32x4){0.f, 0.f, 0.f, 0.f};
}
__device__ __forceinline__ void acc_init(const EpiSwiglu& E, f32x4 (&acc)[2][2][4][2], const Unit& u, int wr, int wc, int fr, int fq) {
    const int e = u.pn >> 3, ct = u.pn & 7; const int lc0 = ct * BM + wc * 32 + 8 * fq; (void)wr; (void)fr;
#pragma unroll
    for (int b = 0; b < 2; ++b) { const f32x4 one = {0.f, 1.f, 0.f, 1.f};
        const f32x4 b0 = *(const f32x4*)(E.bgu + e * 2048 + lc0 + b * HALF) + one, b1 = *(const f32x4*)(E.bgu + e * 2048 + lc0 + b * HALF + 4) + one;
#pragma unroll
        for (int a = 0; a < 2; ++a)
#pragma unroll
            for (int m = 0; m < 4; ++m) { acc[a][b][m][0] = b0; acc[a][b][m][1] = b1; } }
}
__device__ __forceinline__ void acc_init(const EpiDown8& E, f32x4 (&acc)[2][2][4][2], const Unit& u, int wr, int wc, int fr, int fq) {
    const int bcol0 = u.pn * BM + wc * 32 + 8 * fq; (void)wr; (void)fr;
#pragma unroll
    for (int b = 0; b < 2; ++b) { const f32x4 b0 = *(const f32x4*)(E.bias + bcol0 + b * HALF), b1 = *(const f32x4*)(E.bias + bcol0 + b * HALF + 4);
#pragma unroll
        for (int a = 0; a < 2; ++a)
#pragma unroll
            for (int m = 0; m < 4; ++m) { acc[a][b][m][0] = b0; acc[a][b][m][1] = b1; } }
}
template <class Epi, class Sched, bool ALIGN_EPI = false, bool SP2 = false, bool FP8 = false>
__device__ __forceinline__ void gemm_phase(PG8_LAS unsigned char* lds, const Gemm g, const Sched& S, const Epi& E) {
    const int tid = threadIdx.x, wid = __builtin_amdgcn_readfirstlane(tid >> 6), lane = tid & 63, wr = wid >> 2, wc = wid & 3, fr = lane & 15, fq = lane >> 4;
    const int K = g.K, nt = K / BK;
    unsigned voffA[2], voffB[2];
#pragma unroll
    for (int i = 0; i < 2; ++i) { int R, C; stage_rc(tid * 16 + i * 8192, R, C); const int Rb = Epi::PERM ? ((R & ~31) + perm32(R & 31)) : R;
        voffA[i] = (unsigned)(R * K + C) * 2u; voffB[i] = (unsigned)(Rb * K + C) * 2u; }
    const size_t kstep = (size_t)(BK * 2);
    const size_t hstep = (size_t)HALF * K * 2;
    const size_t tstep = 2 * hstep;
    const unsigned ldsw = (unsigned)wid * 1024u;
    const int aoff = lds_byte(wr * 64 + fr, fq * (FP8 ? 16 : 8)), boff = lds_byte(wc * 32 + fr, fq * (FP8 ? 16 : 8));
    const int h0off = (fq & 1) * 16, h1off = 16 - h0off;
#define PG8_SA(b, h) (((b) * 2 + (h)) * HTB)
#define PG8_SB(b, h) ((4 + (b) * 2 + (h)) * HTB)
#define PG8_STAGE(bufoff, gbase, voff) do { _Pragma("unroll") for (int _i = 0; _i < 2; ++_i) \
        __builtin_amdgcn_global_load_lds((const unsigned*)((const char*)(gbase) + (voff)[_i]), (PG8_LAS unsigned*)(lds + (bufoff) + ldsw + _i * 8192), 16, 0, 0); } while (0)
#define PG8_LDA(dst, b, h) do { if constexpr (FP8) { _Pragma("unroll") for (int m = 0; m < 4; ++m) dst##8[m] = cat8(*(const PG8_LAS bf16x8*)(lds + PG8_SA(b, h) + aoff + m * 2048 + h0off), *(const PG8_LAS bf16x8*)(lds + PG8_SA(b, h) + aoff + m * 2048 + h1off)); } else { \
        _Pragma("unroll") for (int m = 0; m < 4; ++m) _Pragma("unroll") for (int k = 0; k < 2; ++k) dst[m][k] = *(const PG8_LAS bf16x8*)(lds + PG8_SA(b, h) + aoff + m * 2048 + k * 1024); } } while (0)
#define PG8_LDB(dst, b, h) do { if constexpr (FP8) { _Pragma("unroll") for (int n = 0; n < 2; ++n) dst##8[n] = cat8(*(const PG8_LAS bf16x8*)(lds + PG8_SB(b, h) + boff + n * 2048 + h0off), *(const PG8_LAS bf16x8*)(lds + PG8_SB(b, h) + boff + n * 2048 + h1off)); } else { \
        _Pragma("unroll") for (int n = 0; n < 2; ++n) _Pragma("unroll") for (int k = 0; k < 2; ++k) dst[n][k] = *(const PG8_LAS bf16x8*)(lds + PG8_SB(b, h) + boff + n * 2048 + k * 1024); } } while (0)
#define PG8_MMA(ai, bj, At, Bt) do { __builtin_amdgcn_s_setprio(1); if constexpr (FP8) { _Pragma("unroll") for (int m = 0; m < 4; ++m) _Pragma("unroll") for (int n = 0; n < 2; ++n) \
        asm volatile("v_mfma_scale_f32_16x16x128_f8f6f4 %0, %1, %2, %0, %3, %4 op_sel_hi:[0,0,0]" : "+v"(acc[ai][bj][m][n]) : "v"(Bt##8[n]), "v"(At##8[m]), "v"(scw_), "v"(sc1_)); } else { \
        _Pragma("unroll") for (int m = 0; m < 4; ++m) _Pragma("unroll") for (int n = 0; n < 2; ++n) _Pragma("unroll") for (int k = 0; k < 2; ++k) \
        acc[ai][bj][m][n] = __builtin_amdgcn_mfma_f32_16x16x32_bf16(Bt[n][k], At[m][k], acc[ai][bj][m][n], 0, 0, 0); } __builtin_amdgcn_s_setprio(0); } while (0)
#define PG8_WAIT_V(n) asm volatile("s_waitcnt vmcnt(" #n ")" ::: "memory")
#define PG8_WAIT_L(n) asm volatile("s_waitcnt lgkmcnt(" #n ")" ::: "memory")
#define PG8_BAR __builtin_amdgcn_s_barrier()
#define PG8_SCHED __builtin_amdgcn_sched_barrier(0)
    Unit cur, nxt; int ui = 0;
    if (!S.next(0, cur)) return;
    f32x4 acc[2][2][4][2];
    acc_init(E, acc, cur, wr, wc, fr, fq);
    bf16x8 At[4][2], B0[2][2], B1[2][2];
    v8i32 At8[4], B08[2], B18[2];
    typedef float f32x8 __attribute__((ext_vector_type(8)));
    f32x8 acc8[2][2][4];
#define PG8_ZERO8() do { _Pragma("unroll") for (int a = 0; a < 2; ++a) _Pragma("unroll") for (int b = 0; b < 2; ++b) _Pragma("unroll") for (int m = 0; m < 4; ++m) acc8[a][b][m] = (f32x8){0.f, 0.f, 0.f, 0.f, 0.f, 0.f, 0.f, 0.f}; } while (0)
#define PG8_ACC8TO4() do { if constexpr (FP8) { _Pragma("unroll") for (int a = 0; a < 2; ++a) _Pragma("unroll") for (int b = 0; b < 2; ++b) _Pragma("unroll") for (int m = 0; m < 4; ++m) { \
        acc[a][b][m][0] = __builtin_shufflevector(acc8[a][b][m], acc8[a][b][m], 0, 1, 2, 3); acc[a][b][m][1] = __builtin_shufflevector(acc8[a][b][m], acc8[a][b][m], 4, 5, 6, 7); } PG8_ZERO8(); } } while (0)
    const int sc1_ = 0x7f7f7f7f, scw_ = 0x7a7a7a7a;
    const char* cA = (const char*)g.A + (size_t)cur.pm * tstep; const char* cB = (const char*)g.Bt + (size_t)cur.pn * tstep;
    S.a_ready(cur);
    if constexpr (SP2) {
        PG8_STAGE(PG8_SB(0, 0), cB, voffB); PG8_STAGE(PG8_SB(0, 1), cB + hstep, voffB); PG8_STAGE(PG8_SA(0, 0), cA, voffA); PG8_STAGE(PG8_SA(0, 1), cA + hstep, voffA);
        if (wr == 1) PG8_BAR;
        PG8_WAIT_V(2); PG8_BAR;
        PG8_STAGE(PG8_SB(1, 0), cB + kstep, voffB); PG8_STAGE(PG8_SA(1, 0), cA + kstep, voffA); PG8_STAGE(PG8_SB(1, 1), cB + hstep + kstep, voffB);
        PG8_WAIT_V(6); PG8_BAR;
    } else {
        PG8_STAGE(PG8_SB(0, 0), cB, voffB); PG8_STAGE(PG8_SA(0, 0), cA, voffA); PG8_STAGE(PG8_SB(0, 1), cB + hstep, voffB); PG8_STAGE(PG8_SA(0, 1), cA + hstep, voffA);
        if (wr == 1) PG8_BAR;
        PG8_WAIT_V(4); PG8_BAR;
        PG8_STAGE(PG8_SB(1, 0), cB + kstep, voffB); PG8_STAGE(PG8_SA(1, 0), cA + kstep, voffA); PG8_STAGE(PG8_SB(1, 1), cB + hstep + kstep, voffB);
        PG8_WAIT_V(6); PG8_BAR;
    }
    for (;;) {
        const bool has_next = S.next(ui + 1, nxt);
        const char* nA = has_next ? (const char*)g.A + (size_t)nxt.pm * tstep : cA; const char* nB = has_next ? (const char*)g.Bt + (size_t)nxt.pn * tstep : cB;
        for (int t = 0; t < nt; t += 2) {
            const bool last = (t == nt - 2);
            const char* a1 = cA + (size_t)(t + 1) * kstep;
            const char* a2 = last ? nA : cA + (size_t)(t + 2) * kstep; const char* b2 = last ? nB : cB + (size_t)(t + 2) * kstep;
            const char* a3 = a2 + kstep; const char* b3 = b2 + kstep;
            if (last && has_next) S.a_ready(nxt);
            if constexpr (SP2) {
            PG8_LDB(B0, 0, 0); PG8_LDB(B1, 0, 1); PG8_SCHED; PG8_LDA(At, 0, 0); PG8_STAGE(PG8_SA(1, 1), a1 + hstep, voffA);
            PG8_WAIT_V(8); PG8_WAIT_L(0); PG8_BAR; PG8_MMA(0, 0, At, B0); PG8_MMA(0, 1, At, B1); PG8_BAR; PG8_SCHED;
            PG8_LDA(At, 0, 1); PG8_STAGE(PG8_SB(0, 0), b2, voffB); PG8_STAGE(PG8_SB(0, 1), b2 + hstep, voffB); PG8_STAGE(PG8_SA(0, 0), a2, voffA);
            PG8_WAIT_V(8); PG8_WAIT_L(0); PG8_BAR; PG8_MMA(1, 0, At, B0); PG8_MMA(1, 1, At, B1); PG8_BAR; PG8_SCHED;
            PG8_LDB(B0, 1, 0); PG8_LDB(B1, 1, 1); PG8_SCHED; PG8_LDA(At, 1, 0); PG8_STAGE(PG8_SA(0, 1), a2 + hstep, voffA);
            PG8_WAIT_V(8); PG8_WAIT_L(0); PG8_BAR; PG8_MMA(0, 0, At, B0); PG8_MMA(0, 1, At, B1); PG8_BAR; PG8_SCHED;
            PG8_LDA(At, 1, 1); PG8_STAGE(PG8_SB(1, 0), b3, voffB); PG8_STAGE(PG8_SB(1, 1), b3 + hstep, voffB); PG8_STAGE(PG8_SA(1, 0), a3, voffA);
            PG8_WAIT_V(8); PG8_WAIT_L(0); PG8_BAR; PG8_MMA(1, 0, At, B0); PG8_MMA(1, 1, At, B1); PG8_BAR; PG8_SCHED;
            } else {
            PG8_LDB(B0, 0, 0); PG8_SCHED; PG8_LDA(At, 0, 0); PG8_STAGE(PG8_SA(1, 1), a1 + hstep, voffA);
            PG8_WAIT_L(8); PG8_BAR; PG8_WAIT_L(0); PG8_MMA(0, 0, At, B0); PG8_BAR; PG8_SCHED;
            PG8_LDB(B1, 0, 1); PG8_STAGE(PG8_SB(0, 0), b2, voffB);
            PG8_BAR; PG8_WAIT_L(0); PG8_MMA(0, 1, At, B1); PG8_BAR;
            PG8_LDA(At, 0, 1); PG8_STAGE(PG8_SA(0, 0), a2, voffA);
            PG8_BAR; PG8_WAIT_L(0); PG8_MMA(1, 0, At, B0); PG8_BAR; PG8_SCHED;
            PG8_STAGE(PG8_SB(0, 1), b2 + hstep, voffB);
            PG8_WAIT_V(6); PG8_BAR; PG8_MMA(1, 1, At, B1); PG8_BAR;
            PG8_LDB(B0, 1, 0); PG8_SCHED; PG8_LDA(At, 1, 0); PG8_STAGE(PG8_SA(0, 1), a2 + hstep, voffA);
            PG8_WAIT_L(8); PG8_BAR; PG8_WAIT_L(0); PG8_MMA(0, 0, At, B0); PG8_BAR; PG8_SCHED;
            PG8_LDB(B1, 1, 1); PG8_STAGE(PG8_SB(1, 0), b3, voffB);
            PG8_BAR; PG8_WAIT_L(0); PG8_MMA(0, 1, At, B1); PG8_BAR;
            PG8_LDA(At, 1, 1); PG8_STAGE(PG8_SA(1, 0), a3, voffA);
            PG8_BAR; PG8_WAIT_L(0); PG8_MMA(1, 0, At, B0); PG8_BAR; PG8_SCHED;
            PG8_STAGE(PG8_SB(1, 1), b3 + hstep, voffB);
            PG8_WAIT_V(6); PG8_BAR; PG8_MMA(1, 1, At, B1); PG8_BAR;
            }
        }
        if constexpr (ALIGN_EPI) { if (wr == 0) PG8_BAR; }
        if constexpr (!Epi::AFTER_DRAIN) { if constexpr (FP8) asm volatile("s_nop 15\n\ts_nop 15" ::: "memory"); E(acc, cur, wr, wc, fr, fq); S.done(cur); }
        if (!has_next) break;
        acc_init(E, acc, nxt, wr, wc, fr, fq);
        cur = nxt; cA = nA; cB = nB; ++ui;
        if constexpr (ALIGN_EPI) { if (wr == 1) PG8_BAR; }
    }
    PG8_WAIT_V(0);
    if constexpr (!ALIGN_EPI) { if (wr == 0) PG8_BAR; }
    PG8_BAR;
    if constexpr (Epi::AFTER_DRAIN) { E.fused(acc, cur, wr, wc, fr, fq, lds, wid, lane); S.done(cur); }
#undef PG8_ZERO8
#undef PG8_ACC8TO4
#undef PG8_SA
#undef PG8_SB
#undef PG8_STAGE
#undef PG8_LDA
#undef PG8_LDB
#undef PG8_MMA
#undef PG8_WAIT_V
#undef PG8_WAIT_L
#undef PG8_BAR
#undef PG8_SCHED
}

template <class Epi, class Sched, bool FP8 = false>
__device__ __forceinline__ void gemm_phase_gather(PG8_LAS unsigned char* lds, const Gemm g, const int* rowidx, const Sched& S, const Epi& E) {
    const int tid = threadIdx.x, wid = __builtin_amdgcn_readfirstlane(tid >> 6), lane = tid & 63, wr = wid >> 2, wc = wid & 3, fr = lane & 15, fq = lane >> 4;
    const int K = g.K, nt = K / BK;
    int RA[2]; unsigned CA2[2], voffB[2];
#pragma unroll
    for (int i = 0; i < 2; ++i) { int R, C; stage_rc(tid * 16 + i * 8192, R, C); const int Rb = Epi::PERM ? ((R & ~31) + perm32(R & 31)) : R;
        RA[i] = R; CA2[i] = (unsigned)C * 2u; voffB[i] = (unsigned)(Rb * K + C) * 2u; }
    const size_t kstep = (size_t)(BK * 2);
    const size_t hstep = (size_t)HALF * K * 2;
    const size_t tstep = 2 * hstep;
    const unsigned ldsw = (unsigned)wid * 1024u;
    const unsigned rowb = (unsigned)K * 2u;
    const int aoff = lds_byte(wr * 64 + fr, fq * (FP8 ? 16 : 8)), boff = lds_byte(wc * 32 + fr, fq * (FP8 ? 16 : 8));
    const int h0off = (fq & 1) * 16, h1off = 16 - h0off;
#define PG8_SA(b, h) (((b) * 2 + (h)) * HTB)
#define PG8_SB(b, h) ((4 + (b) * 2 + (h)) * HTB)
#define PG8_STAGE(bufoff, gbase, voff) do { _Pragma("unroll") for (int _i = 0; _i < 2; ++_i) \
        __builtin_amdgcn_global_load_lds((const unsigned*)((const char*)(gbase) + (voff)[_i]), (PG8_LAS unsigned*)(lds + (bufoff) + ldsw + _i * 8192), 16, 0, 0); } while (0)
#define PG8_STAGEA(bufoff, offs, kb) do { _Pragma("unroll") for (int _i = 0; _i < 2; ++_i) \
        __builtin_amdgcn_global_load_lds((const unsigned*)((const char*)g.A + (size_t)(offs)[_i] + (size_t)(kb)), (PG8_LAS unsigned*)(lds + (bufoff) + ldsw + _i * 8192), 16, 0, 0); } while (0)
#define PG8_GIDX(d0, d1, pm_) do { _Pragma("unroll") for (int _i = 0; _i < 2; ++_i) { const int r0_ = rowidx[(size_t)(pm_) * BM + RA[_i]], r1_ = rowidx[(size_t)(pm_) * BM + HALF + RA[_i]]; \
        d0[_i] = (unsigned)r0_ * rowb + CA2[_i]; d1[_i] = (unsigned)r1_ * rowb + CA2[_i]; } } while (0)
#define PG8_LDA(dst, b, h) do { if constexpr (FP8) { _Pragma("unroll") for (int m = 0; m < 4; ++m) dst##8[m] = cat8(*(const PG8_LAS bf16x8*)(lds + PG8_SA(b, h) + aoff + m * 2048 + h0off), *(const PG8_LAS bf16x8*)(lds + PG8_SA(b, h) + aoff + m * 2048 + h1off)); } else { \
        _Pragma("unroll") for (int m = 0; m < 4; ++m) _Pragma("unroll") for (int k = 0; k < 2; ++k) dst[m][k] = *(const PG8_LAS bf16x8*)(lds + PG8_SA(b, h) + aoff + m * 2048 + k * 1024); } } while (0)
#define PG8_LDB(dst, b, h) do { if constexpr (FP8) { _Pragma("unroll") for (int n = 0; n < 2; ++n) dst##8[n] = cat8(*(const PG8_LAS bf16x8*)(lds + PG8_SB(b, h) + boff + n * 2048 + h0off), *(const PG8_LAS bf16x8*)(lds + PG8_SB(b, h) + boff + n * 2048 + h1off)); } else { \
        _Pragma("unroll") for (int n = 0; n < 2; ++n) _Pragma("unroll") for (int k = 0; k < 2; ++k) dst[n][k] = *(const PG8_LAS bf16x8*)(lds + PG8_SB(b, h) + boff + n * 2048 + k * 1024); } } while (0)
#define PG8_MMA(ai, bj, At, Bt) do { __builtin_amdgcn_s_setprio(1); if constexpr (FP8) { _Pragma("unroll") for (int m = 0; m < 4; ++m) _Pragma("unroll") for (int n = 0; n < 2; ++n) \
        asm volatile("v_mfma_scale_f32_16x16x128_f8f6f4 %0, %1, %2, %0, %3, %4 op_sel_hi:[0,0,0]" : "+v"(acc[ai][bj][m][n]) : "v"(Bt##8[n]), "v"(At##8[m]), "v"(scw_), "v"(sc1_)); } else { \
        _Pragma("unroll") for (int m = 0; m < 4; ++m) _Pragma("unroll") for (int n = 0; n < 2; ++n) _Pragma("unroll") for (int k = 0; k < 2; ++k) \
        acc[ai][bj][m][n] = __builtin_amdgcn_mfma_f32_16x16x32_bf16(Bt[n][k], At[m][k], acc[ai][bj][m][n], 0, 0, 0); } __builtin_amdgcn_s_setprio(0); } while (0)
#define PG8_WAIT_V(n) asm volatile("s_waitcnt vmcnt(" #n ")" ::: "memory")
#define PG8_WAIT_L(n) asm volatile("s_waitcnt lgkmcnt(" #n ")" ::: "memory")
#define PG8_BAR __builtin_amdgcn_s_barrier()
#define PG8_SCHED __builtin_amdgcn_sched_barrier(0)
    Unit cur, nxt; int ui = 0;
    if (!S.next(0, cur)) return;
    f32x4 acc[2][2][4][2];
    acc_init(E, acc, cur, wr, wc, fr, fq);
    bf16x8 At[4][2], B0[2][2], B1[2][2];
    v8i32 At8[4], B08[2], B18[2];
    typedef float f32x8 __attribute__((ext_vector_type(8)));
    f32x8 acc8[2][2][4];
#define PG8_ZERO8() do { _Pragma("unroll") for (int a = 0; a < 2; ++a) _Pragma("unroll") for (int b = 0; b < 2; ++b) _Pragma("unroll") for (int m = 0; m < 4; ++m) acc8[a][b][m] = (f32x8){0.f, 0.f, 0.f, 0.f, 0.f, 0.f, 0.f, 0.f}; } while (0)
#define PG8_ACC8TO4() do { if constexpr (FP8) { _Pragma("unroll") for (int a = 0; a < 2; ++a) _Pragma("unroll") for (int b = 0; b < 2; ++b) _Pragma("unroll") for (int m = 0; m < 4; ++m) { \
        acc[a][b][m][0] = __builtin_shufflevector(acc8[a][b][m], acc8[a][b][m], 0, 1, 2, 3); acc[a][b][m][1] = __builtin_shufflevector(acc8[a][b][m], acc8[a][b][m], 4, 5, 6, 7); } PG8_ZERO8(); } } while (0)
    const int sc1_ = 0x7f7f7f7f, scw_ = 0x7a7a7a7a;
    unsigned ga0[2], ga1[2], gn0[2], gn1[2];
    PG8_GIDX(ga0, ga1, cur.pm);
    const char* cB = (const char*)g.Bt + (size_t)cur.pn * tstep;
    S.a_ready(cur);
    PG8_STAGE(PG8_SB(0, 0), cB, voffB); PG8_STAGE(PG8_SB(0, 1), cB + hstep, voffB); PG8_STAGEA(PG8_SA(0, 0), ga0, 0); PG8_STAGEA(PG8_SA(0, 1), ga1, 0);
    if (wr == 1) PG8_BAR;
    PG8_WAIT_V(2); PG8_BAR;
    PG8_STAGE(PG8_SB(1, 0), cB + kstep, voffB); PG8_STAGEA(PG8_SA(1, 0), ga0, kstep); PG8_STAGE(PG8_SB(1, 1), cB + hstep + kstep, voffB);
    PG8_WAIT_V(6); PG8_BAR;
    for (;;) {
        const bool has_next = S.next(ui + 1, nxt);
        if (has_next) { PG8_GIDX(gn0, gn1, nxt.pm); } else { gn0[0] = ga0[0]; gn0[1] = ga0[1]; gn1[0] = ga1[0]; gn1[1] = ga1[1]; }
        const char* nB = has_next ? (const char*)g.Bt + (size_t)nxt.pn * tstep : cB;
        for (int t = 0; t < nt; t += 2) {
            const bool last = (t == nt - 2);
            const size_t k1 = (size_t)(t + 1) * kstep;
            const size_t k2 = last ? (size_t)0 : (size_t)(t + 2) * kstep;
            unsigned s0[2], s1[2];
            s0[0] = last ? gn0[0] : ga0[0]; s0[1] = last ? gn0[1] : ga0[1]; s1[0] = last ? gn1[0] : ga1[0]; s1[1] = last ? gn1[1] : ga1[1];
            const char* b2 = last ? nB : cB + (size_t)(t + 2) * kstep;
            const char* b3 = b2 + kstep;
            if (last && has_next) S.a_ready(nxt);
            PG8_LDB(B0, 0, 0); PG8_LDB(B1, 0, 1); PG8_SCHED; PG8_LDA(At, 0, 0); PG8_STAGEA(PG8_SA(1, 1), ga1, k1);
            PG8_WAIT_V(8); PG8_WAIT_L(0); PG8_BAR; PG8_MMA(0, 0, At, B0); PG8_MMA(0, 1, At, B1); PG8_BAR; PG8_SCHED;
            PG8_LDA(At, 0, 1); PG8_STAGE(PG8_SB(0, 0), b2, voffB); PG8_STAGE(PG8_SB(0, 1), b2 + hstep, voffB); PG8_STAGEA(PG8_SA(0, 0), s0, k2);
            PG8_WAIT_V(8); PG8_WAIT_L(0); PG8_BAR; PG8_MMA(1, 0, At, B0); PG8_MMA(1, 1, At, B1); PG8_BAR; PG8_SCHED;
            PG8_LDB(B0, 1, 0); PG8_LDB(B1, 1, 1); PG8_SCHED; PG8_LDA(At, 1, 0); PG8_STAGEA(PG8_SA(0, 1), s1, k2);
            PG8_WAIT_V(8); PG8_WAIT_L(0); PG8_BAR; PG8_MMA(0, 0, At, B0); PG8_MMA(0, 1, At, B1); PG8_BAR; PG8_SCHED;
            PG8_LDA(At, 1, 1); PG8_STAGE(PG8_SB(1, 0), b3, voffB); PG8_STAGE(PG8_SB(1, 1), b3 + hstep, voffB); PG8_STAGEA(PG8_SA(1, 0), s0, k2 + kstep);
            PG8_WAIT_V(8); PG8_WAIT_L(0); PG8_BAR; PG8_MMA(1, 0, At, B0); PG8_MMA(1, 1, At, B1); PG8_BAR; PG8_SCHED;
        }
        if (wr == 0) PG8_BAR;
        if constexpr (FP8) asm volatile("s_nop 15\n\ts_nop 15" ::: "memory"); E(acc, cur, wr, wc, fr, fq); S.done(cur);
        if (!has_next) break;
        acc_init(E, acc, nxt, wr, wc, fr, fq);
        cur = nxt; cB = nB; ga0[0] = gn0[0]; ga0[1] = gn0[1]; ga1[0] = gn1[0]; ga1[1] = gn1[1]; ++ui;
        if (wr == 1) PG8_BAR;
    }
    PG8_WAIT_V(0);
    PG8_BAR;
#undef PG8_ZERO8
#undef PG8_ACC8TO4
#undef PG8_SA
#undef PG8_SB
#undef PG8_STAGE
#undef PG8_STAGEA
#undef PG8_GIDX
#undef PG8_LDA
#undef PG8_LDB
#undef PG8_MMA
#undef PG8_WAIT_V
#undef PG8_WAIT_L
#undef PG8_BAR
#undef PG8_SCHED
}
}
#define XB_TMO      128
#define XB_XCNT(j)  (256  + 64 * (j))
#define XB_XSUB(j)  (1280 + 64 * (j))
#define XB_XGEN(j)  (2304 + 64 * (j))
#define XB_TOP      3328
#define XB_TOPGEN   3392
#define XCD_BAR_WORDS 3456
#define XB_SPIN_CAP (1u << 18)

__device__ __forceinline__ unsigned xb_ld(unsigned* p)              { return __hip_atomic_load(p, __ATOMIC_RELAXED, __HIP_MEMORY_SCOPE_AGENT); }
__device__ __forceinline__ unsigned xb_add(unsigned* p, unsigned v) { return __hip_atomic_fetch_add(p, v, __ATOMIC_RELAXED, __HIP_MEMORY_SCOPE_AGENT); }
__device__ __forceinline__ unsigned xb_xcc_id() { return (unsigned)__builtin_amdgcn_s_getreg((3 << 11) | 20) & 0xFu; }
#define XB_SPIN(cond, bar) do { unsigned _sp = 0; while (cond) { __builtin_amdgcn_s_sleep(1); \
    if ((++_sp & 255u) == 0u) { if (xb_ld(&(bar)[XB_TMO])) break; if (_sp > XB_SPIN_CAP) { atomicAdd(&(bar)[XB_TMO], 1u); break; } } } } while (0)

struct XcdBarrier {
    unsigned* bar; unsigned x;
    volatile LAS unsigned* st;
};

__device__ __forceinline__ XcdBarrier xcd_barrier_post(unsigned* bar, volatile LAS unsigned* st) {
    XcdBarrier b; b.bar = bar; b.x = xb_xcc_id(); b.st = st;
    if (threadIdx.x == 0) (void)xb_add(&bar[XB_XCNT(b.x)], 1u);
    return b;
}
__device__ __forceinline__ void xcd_barrier_complete(unsigned* bar, unsigned x, unsigned& nloc, unsigned& nx) {
    const unsigned G = gridDim.x * gridDim.y * gridDim.z;
    unsigned sum, cnt, mine, sp = 0u;
    for (;;) {
        sum = 0u; cnt = 0u; mine = 0u;
#pragma unroll
        for (unsigned j = 0; j < 16; ++j) { const unsigned c = xb_ld(&bar[XB_XCNT(j)]); sum += c; cnt += (c > 0u) ? 1u : 0u; mine = (j == x) ? c : mine; }
        if (sum == G) break;
        __builtin_amdgcn_s_sleep(1);
        if ((++sp & 255u) == 0u) { if (xb_ld(&bar[XB_TMO])) break; if (sp > XB_SPIN_CAP) { atomicAdd(&bar[XB_TMO], 1u); break; } }
    }
    nloc = mine > 0u ? mine : 1u; nx = cnt > 0u ? cnt : 1u;
}

__device__ __forceinline__ void xcd_barrier(const XcdBarrier& b) {
    asm volatile("s_waitcnt vmcnt(0)" ::: "memory");
    __syncthreads();
    if (threadIdx.x == 0) {
        unsigned* bar = b.bar;
        __builtin_amdgcn_s_waitcnt(0);
        unsigned nloc = b.st[0], nx = b.st[1];
        if (nloc == 0u) { xcd_barrier_complete(bar, b.x, nloc, nx); b.st[0] = nloc; b.st[1] = nx; }
        const unsigned old = xb_add(&bar[XB_XSUB(b.x)], 1u);
        const unsigned gen = old / nloc;
        if (old + 1u == (gen + 1u) * nloc) {
            __builtin_amdgcn_fence(__ATOMIC_RELEASE, "agent");
            asm volatile("s_waitcnt vmcnt(0)" ::: "memory");
            const unsigned og = xb_add(&bar[XB_TOP], 1u);
            const unsigned tg = og / nx;
            if (og + 1u == (tg + 1u) * nx) xb_add(&bar[XB_TOPGEN], 1u);
            else XB_SPIN(xb_ld(&bar[XB_TOPGEN]) == tg, bar);
            __builtin_amdgcn_fence(__ATOMIC_ACQUIRE, "agent");
            xb_add(&bar[XB_XGEN(b.x)], 1u);
            asm volatile("s_waitcnt vmcnt(0)" ::: "memory");
        } else {
            XB_SPIN(xb_ld(&bar[XB_XGEN(b.x)]) == gen, bar);
            __builtin_amdgcn_fence(__ATOMIC_ACQUIRE, "agent");
            asm volatile("s_waitcnt vmcnt(0)" ::: "memory");
        }
    }
    __syncthreads();
}

struct Ctx {
    LAS unsigned char* lds; unsigned char* ws; int tid, lane, wave, G, blk;
};
__device__ __forceinline__ int tok2row(int tok, bool latent_only) { return latent_only ? (tok >> 13) * TPB + (tok & 8191) : tok; }

__device__ __forceinline__ void p0_transpose_item(const float* W, int K, int N, bf16* WT, int row_off, LAS float* scr, int item, int lane) {
    const int nblk = N / 32, kb = item / nblk, nb = item % nblk, k0 = 64 * kb, n0 = 32 * nb;
#pragma unroll 8
    for (int i = 0; i < 32; ++i) { const int kk = 2 * i + (lane >> 5); scr[kk * 33 + (lane & 31)] = W[(size_t)(k0 + kk) * N + n0 + (lane & 31)]; }
    LDS_WAIT(); asm volatile("" ::: "memory");
    const int c = lane & 7;
#pragma unroll
    for (int j = 0; j < 4; ++j) { const int n = (lane >> 3) + 8 * j; const LAS float* s = scr + (8 * c) * 33 + n;
        v4u o; o.x = pk2(s[0 * 33], s[1 * 33]); o.y = pk2(s[2 * 33], s[3 * 33]); o.z = pk2(s[4 * 33], s[5 * 33]); o.w = pk2(s[6 * 33], s[7 * 33]);
        *(GAS v4u*)(WT + (size_t)(row_off + n0 + n) * K + k0 + 8 * c) = o; }
    LDS_WAIT(); asm volatile("" ::: "memory");
}

__device__ __forceinline__ void p0_transpose_item8(const float* W, int K, int N, unsigned char* WT, int row_off, LAS float* scr, int item, int lane) {
    const int nblk = N / 32, kb = item / nblk, nb = item % nblk, k0 = 64 * kb, n0 = 32 * nb;
#pragma unroll 8
    for (int i = 0; i < 32; ++i) { const int kk = 2 * i + (lane >> 5); scr[kk * 33 + (lane & 31)] = W[(size_t)(k0 + kk) * N + n0 + (lane & 31)]; }
    LDS_WAIT(); asm volatile("" ::: "memory");
    const int c = lane & 3;
#pragma unroll
    for (int j = 0; j < 2; ++j) { const int n = (lane >> 2) + 16 * j; const LAS float* s = scr + (16 * c) * 33 + n;
        int w[4];
#pragma unroll
        for (int q = 0; q < 4; ++q) { int x = 0; x = __builtin_amdgcn_cvt_pk_fp8_f32(32.0f * s[(4 * q) * 33], 32.0f * s[(4 * q + 1) * 33], x, false); x = __builtin_amdgcn_cvt_pk_fp8_f32(32.0f * s[(4 * q + 2) * 33], 32.0f * s[(4 * q + 3) * 33], x, true); w[q] = x; }
        *(GAS v4u*)(WT + (size_t)(row_off + n0 + n) * K + k0 + 16 * c) = (v4u){(unsigned)w[0], (unsigned)w[1], (unsigned)w[2], (unsigned)w[3]}; }
    LDS_WAIT(); asm volatile("" ::: "memory");
}
__device__ __forceinline__ void p0_transpose_item8w(const float* W, int K, int N, unsigned char* WT, int row_off, LAS float* scr, int item, int lane) {
    const int nblk = N / 32, kb = item / nblk, nb = item % nblk, k0 = 128 * kb, n0 = 32 * nb;
#pragma unroll
    for (int h = 0; h < 2; ++h) { f32x4 t[8];
#pragma unroll
        for (int i = 0; i < 8; ++i) t[i] = __builtin_nontemporal_load((const f32x4*)(W + (size_t)(k0 + 64 * h + 8 * i + (lane >> 3)) * N + n0 + 4 * (lane & 7)));
#pragma unroll
        for (int i = 0; i < 8; ++i) { LAS float* d = scr + (64 * h + 8 * i + (lane >> 3)) * 33 + 4 * (lane & 7); d[0] = t[i].x; d[1] = t[i].y; d[2] = t[i].z; d[3] = t[i].w; } }
    LDS_WAIT(); asm volatile("" ::: "memory");
    const int n = lane & 31, half = lane >> 5; const LAS float* sc = scr + (64 * half) * 33 + n;
    unsigned char* dst = WT + (size_t)(row_off + n0 + n) * K + k0 + 64 * half;
#pragma unroll
    for (int c = 0; c < 4; ++c) { int w[4];
#pragma unroll
        for (int q = 0; q < 4; ++q) { const LAS float* s4 = sc + (16 * c + 4 * q) * 33; int x = 0;
            x = __builtin_amdgcn_cvt_pk_fp8_f32(32.0f * s4[0], 32.0f * s4[33], x, false); x = __builtin_amdgcn_cvt_pk_fp8_f32(32.0f * s4[66], 32.0f * s4[99], x, true); w[q] = x; }
        *(GAS v4u*)(dst + 16 * c) = (v4u){(unsigned)w[0], (unsigned)w[1], (unsigned)w[2], (unsigned)w[3]}; }
    LDS_WAIT(); asm volatile("" ::: "memory");
}

constexpr int L1_D6 = 10000, L1_D2 = 2500, L1_D5 = 1500, L1_D12 = 1500, L1_DEFER = L1_D6 + L1_D2 + L1_D5 + L1_D12; static_assert(L1_DEFER <= 32 * 512, "deferred items are layer 1 gate/up items");
__device__ __forceinline__ void convert_l1_share(const KP& p, const Ctx& F, int j0, int n, int rank, int nb) {
    LAS float* scr = (LAS float*)(F.lds + F.wave * 17408);
    for (int j = j0 + rank * 8 + F.wave; j < j0 + n; j += nb * 8) { const int mat = 32 + (j >> 9), rr = j & 511;
        p0_transpose_item8w(p.moe_w_gu + (size_t)mat * 1024 * 2048, 1024, 2048, F.ws + WS_W_GU, mat * 2048, scr, rr, F.lane); }
}

__device__ __forceinline__ void phase_prologue(const KP& p, const Ctx& F) {
    unsigned char* ws = F.ws;
    if (F.blk < 192) {
        LAS float* sc = (LAS float*)F.lds;
        LAS float* part = (LAS float*)(F.lds + 20480);
        for (int i = F.tid; i < 5120; i += 512) { const int bs = i >> 10, k = i & 1023; const float cv = bs < 4 ? p.c[bs * 1024 + k] : p.c_ctx[k]; sc[i] = cv / (1.0f + expf(-cv)); }
        __syncthreads();
        float* modv = (float*)(ws + WS_MODV);
        for (int u = F.blk; u < 192; u += F.G) {
            const int layer = u / 96, n0 = (u % 96) * 64;
            float a0 = 0.f, a1 = 0.f, a2 = 0.f, a3 = 0.f, a4 = 0.f;
            const float* W = p.mod_w + (size_t)layer * 1024 * 6144 + n0 + F.lane;
#pragma unroll 32
            for (int kk = 0; kk < 128; ++kk) { const int k = F.wave * 128 + kk; const float w = W[(size_t)k * 6144];
                a0 += sc[k] * w; a1 += sc[1024 + k] * w; a2 += sc[2048 + k] * w; a3 += sc[3072 + k] * w; a4 += sc[4096 + k] * w; }
            part[(F.wave * 5 + 0) * 64 + F.lane] = a0; part[(F.wave * 5 + 1) * 64 + F.lane] = a1; part[(F.wave * 5 + 2) * 64 + F.lane] = a2;
            part[(F.wave * 5 + 3) * 64 + F.lane] = a3; part[(F.wave * 5 + 4) * 64 + F.lane] = a4;
            __syncthreads();
            if (F.tid < 320) { const int bs = F.tid >> 6, l = F.tid & 63; float s = 0.f;
#pragma unroll
                for (int w = 0; w < 8; ++w) s += part[(w * 5 + bs) * 64 + l];
                modv[(size_t)(layer * 5 + bs) * 6144 + n0 + l] = s + p.mod_b[layer * 6144 + n0 + l]; }
            __syncthreads();
        }
    }
    __syncthreads();
    const int gt = F.blk * 512 + F.tid, NGT = F.G * 512;
    { float* tc = (float*)(ws + WS_ROPE); float* tsn = tc + 2048;
      for (int i = gt; i < 2048; i += NGT) { const int comp = i >> 4, f = i & 15; const float inv = powf(10000.0f, -(float)f / 16.0f); const float ang = (float)comp * inv; tc[i] = cosf(ang); tsn[i] = sinf(ang); } }
    { bf16* WG = (bf16*)(ws + WS_W_GIN); bf16* WI = (bf16*)(ws + WS_W_IN);
      for (int i = gt; i < 32 * 1024; i += NGT) { const int rr = i >> 10, k = i & 1023; const int dir = rr >> 4, j = rr & 15;
          WG[(size_t)(3072 + rr) * 1024 + k] = (bf16)f2bf(p.gla_w_gate1[((size_t)dir * 1024 + k) * 16 + j]); }
      for (int i = gt; i < 224 * 1024 / 8; i += NGT) *(v4u*)(WG + (size_t)3104 * 1024 + (size_t)i * 8) = (v4u){0u, 0u, 0u, 0u};
      for (int i = gt; i < 192 * 1024 / 16; i += NGT) *(v4u*)((unsigned char*)WI + (size_t)832 * 1024 + (size_t)i * 16) = (v4u){0u, 0u, 0u, 0u}; }
    LAS float* scr = (LAS float*)(F.lds + F.wave * 17408);
    const int gw = F.blk * 8 + F.wave, NGW = F.G * 8;
    constexpr int I_IN = 8 * 26, I_UQ = 4 * 48, I_UKV = 2 * 64, I_O = 8 * 32, I_GIN = 16 * 96, I_GO = 16 * 32, I_GU = 8 * 64, I_DN = 8 * 32;
    constexpr int I_SMALL = I_IN + I_UQ + I_UKV + I_O + I_GIN + I_GO;
    constexpr int NITEMS = I_SMALL + 64 * I_GU + 64 * I_DN;
    for (int it = gw; it < NITEMS; it += NGW) {
        int r = it;
        if (r < I_IN) { p0_transpose_item8w(p.mla_w_in, 1024, 832, ws + WS_W_IN, 0, scr, r, F.lane); continue; } r -= I_IN;
        if (r < I_UQ) { p0_transpose_item8w(p.mla_w_uq, 512, 1536, ws + WS_W_UQ, 0, scr, r, F.lane); continue; } r -= I_UQ;
        if (r < I_UKV) { p0_transpose_item8w(p.mla_w_ukv, 256, 2048, ws + WS_W_UKV, 0, scr, r, F.lane); continue; } r -= I_UKV;
        if (r < I_O) { p0_transpose_item8w(p.mla_w_o, 1024, 1024, ws + WS_W_O, 0, scr, r, F.lane); continue; } r -= I_O;
        if (r < I_GIN) { p0_transpose_item(p.gla_w_in, 1024, 3072, (bf16*)(ws + WS_W_GIN), 0, scr, r, F.lane); continue; } r -= I_GIN;
        if (r < I_GO) { p0_transpose_item(p.gla_w_o, 1024, 1024, (bf16*)(ws + WS_W_GO), 0, scr, r, F.lane); continue; } r -= I_GO;
        if (r < 64 * I_GU) { const int mat = r / I_GU, rr = r % I_GU;
            if (mat >= 32 && (mat - 32) * I_GU + rr < L1_DEFER) continue;
            p0_transpose_item8w(p.moe_w_gu + (size_t)mat * 1024 * 2048, 1024, 2048, ws + WS_W_GU, mat * 2048, scr, rr, F.lane); continue; } r -= 64 * I_GU;
        { const int mat = r / I_DN, rr = r % I_DN;
            p0_transpose_item8w(p.moe_w_down + (size_t)mat * 1024 * 1024, 1024, 1024, ws + WS_W_DN, mat * 1024, scr, rr, F.lane); }
    }
}

__device__ __forceinline__ void norm_mod_store(const f32x4 (&v)[4], const float* gw, const float* scv, const float* shv, bf16* orow, int lane) {
    float ss = 0.f;
#pragma unroll
    for (int j = 0; j < 4; ++j) ss += (v[j].x * v[j].x + v[j].y * v[j].y) + (v[j].z * v[j].z + v[j].w * v[j].w);
    const float rstd = 1.0f / sqrtf(wave_sum(ss) * (1.0f / 1024.0f) + EPS);
#pragma unroll
    for (int j = 0; j < 4; ++j) { const int c = 4 * lane + 256 * j;
        const f32x4 g = *(const f32x4*)(gw + c), sc = *(const f32x4*)(scv + c), sh = *(const f32x4*)(shv + c);
        const f32x4 h = (v[j] * rstd) * g * (sc + 1.0f) + sh;
        v2u o; o.x = pk2(h.x, h.y); o.y = pk2(h.z, h.w); *(v2u*)(orow + c) = o; }
}

__device__ __forceinline__ void norm_mod_store8(const f32x4 (&v)[4], const float* gw, const float* scv, const float* shv, unsigned char* orow, int lane) {
    float ss = 0.f;
#pragma unroll
    for (int j = 0; j < 4; ++j) ss += (v[j].x * v[j].x + v[j].y * v[j].y) + (v[j].z * v[j].z + v[j].w * v[j].w);
    const float rstd = 1.0f / sqrtf(wave_sum(ss) * (1.0f / 1024.0f) + EPS);
#pragma unroll
    for (int j = 0; j < 4; ++j) { const int c = 4 * lane + 256 * j;
        const f32x4 g = *(const f32x4*)(gw + c), sc = *(const f32x4*)(scv + c), sh = *(const f32x4*)(shv + c);
        const f32x4 h = (v[j] * rstd) * g * (sc + 1.0f) + sh;
        int w8 = 0; w8 = __builtin_amdgcn_cvt_pk_fp8_f32(h.x, h.y, w8, false); w8 = __builtin_amdgcn_cvt_pk_fp8_f32(h.z, h.w, w8, true); *(int*)(orow + c) = w8; }
}

__device__ __forceinline__ void phase_norm1_l0(const KP& p, const Ctx& F) {
    const float* modv = (const float*)(F.ws + WS_MODV); unsigned char* H8 = F.ws + WS_H8;
    const int gw = F.blk * 8 + F.wave, NGW = F.G * 8;
    for (int r = gw; r < M; r += NGW) {
        const int b = r / TPB, t = r % TPB; const bool lat = t < SEQ; const int bs = lat ? b : 4;
        const float* xr = lat ? p.x + ((size_t)b * SEQ + t) * 1024 : p.ctx + ((size_t)b * LC + (t - SEQ)) * 1024;
        f32x4 v[4];
#pragma unroll
        for (int j = 0; j < 4; ++j) v[j] = *(const f32x4*)(xr + 4 * F.lane + 256 * j);
        const float* mv = modv + (size_t)bs * 6144;
        norm_mod_store8(v, p.norm1, mv + 1024, mv, H8 + (size_t)r * 1024, F.lane);
    }
}

__device__ __forceinline__ void phase_mla_thin(const KP& p, const Ctx& F) {
    const bf16* A1 = (const bf16*)(F.ws + WS_A1); unsigned char* CQ8 = F.ws + WS_CQ8; unsigned char* CKV8 = F.ws + WS_CKV8; unsigned char* KR8 = F.ws + WS_KR8;
    const float* tc = (const float*)(F.ws + WS_ROPE); const float* tsn = tc + 2048;
    const int gw = F.blk * 8 + F.wave, NGW = F.G * 8, lane = F.lane;
    for (int r = gw; r < M; r += NGW) {
        const bf16* ar = A1 + (size_t)r * 1024; const int t = r % TPB;
        const v4u qa = *(const v4u*)(ar + 8 * lane);
        float q[8] = {bflo(qa.x), bfhi(qa.x), bflo(qa.y), bfhi(qa.y), bflo(qa.z), bfhi(qa.z), bflo(qa.w), bfhi(qa.w)};
        float ss = 0.f;
#pragma unroll
        for (int i = 0; i < 8; ++i) ss += q[i] * q[i];
        const float rq = 1.0f / sqrtf(wave_sum(ss) * (1.0f / 512.0f) + EPS);
        const f32x4 g0 = *(const f32x4*)(p.mla_q_norm + 8 * lane), g1 = *(const f32x4*)(p.mla_q_norm + 8 * lane + 4);
        { int a = 0, b2 = 0; a = __builtin_amdgcn_cvt_pk_fp8_f32(q[0] * rq * g0.x, q[1] * rq * g0.y, a, false); a = __builtin_amdgcn_cvt_pk_fp8_f32(q[2] * rq * g0.z, q[3] * rq * g0.w, a, true);
          b2 = __builtin_amdgcn_cvt_pk_fp8_f32(q[4] * rq * g1.x, q[5] * rq * g1.y, b2, false); b2 = __builtin_amdgcn_cvt_pk_fp8_f32(q[6] * rq * g1.z, q[7] * rq * g1.w, b2, true);
          *(v2u*)(CQ8 + (size_t)r * 512 + 8 * lane) = (v2u){(unsigned)a, (unsigned)b2}; }
        const v2u ka = *(const v2u*)(ar + 512 + 4 * lane);
        const float k0 = bflo(ka.x), k1 = bfhi(ka.x), k2 = bflo(ka.y), k3 = bfhi(ka.y);
        const float rk = 1.0f / sqrtf(wave_sum(k0 * k0 + k1 * k1 + k2 * k2 + k3 * k3) * (1.0f / 256.0f) + EPS);
        const f32x4 gk = *(const f32x4*)(p.mla_kv_norm + 4 * lane);
        { int a = 0; a = __builtin_amdgcn_cvt_pk_fp8_f32(k0 * rk * gk.x, k1 * rk * gk.y, a, false); a = __builtin_amdgcn_cvt_pk_fp8_f32(k2 * rk * gk.z, k3 * rk * gk.w, a, true); *(int*)(CKV8 + (size_t)r * 256 + 4 * lane) = a; }
        float val = bf2f(ar[768 + lane]);
        const float other = __shfl_xor(val, 16);
        if (t < SEQ) { const int axis = lane >> 5, half = (lane >> 4) & 1, f = lane & 15; const int comp = axis == 0 ? (t >> 6) : (t & 63);
            const float cs = tc[comp * 16 + f], sn = tsn[comp * 16 + f];
            val = half == 0 ? val * cs - other * sn : val * cs + other * sn; }
        KR8[(size_t)r * 64 + lane] = (unsigned char)(__builtin_amdgcn_cvt_pk_fp8_f32(val, 0.f, 0, false) & 0xff);
    }
}

__device__ __forceinline__ void phase_router(const KP& p, const Ctx& F, int layer, bool latent_only) {
    const int ntok = latent_only ? NLAT : M; const int tpb = ntok / F.G;
    const float* modv = (const float*)(F.ws + WS_MODV) + (size_t)layer * 5 * 6144; const bf16* xres = (const bf16*)(F.ws + WS_XRES); unsigned char* H8 = F.ws + WS_H8;
    int* TOPI = (int*)(F.ws + WS_TOPI); float* TOPW = (float*)(F.ws + WS_TOPW); int* HIST = (int*)(F.ws + WS_HIST);
    constexpr int RS = 1032;
    LAS bf16* hhi = (LAS bf16*)F.lds;
    LAS bf16* hlo = hhi + 16 * RS;
    LAS float* part = (LAS float*)(F.lds + 2 * 16 * RS * 2);
    LAS float* lg = part + 8 * 16 * 32;
    LAS float* sel = lg + 16 * 32;
    LAS int* lhist = (LAS int*)(sel + 64);
    const int lane = F.lane, wave = F.wave, e = lane & 31, q4 = lane >> 4, l15 = lane & 15;
    if (F.tid < 32) lhist[F.tid] = 0;
    bf16x8 whi[2][4], wlo[2][4];
    { const float* wr_ = p.moe_w_router + (size_t)layer * 1024 * 32;
#pragma unroll
      for (int nt = 0; nt < 2; ++nt)
#pragma unroll
          for (int kk = 0; kk < 4; ++kk)
#pragma unroll
              for (int j = 0; j < 8; ++j) { const float w = wr_[(size_t)(wave * 128 + kk * 32 + q4 * 8 + j) * 32 + nt * 16 + l15]; const unsigned h = f2bf(w); whi[nt][kk][j] = (short)h; wlo[nt][kk][j] = (short)f2bf(w - bf2f(h)); } }
    const float brt = p.moe_b_router[layer * 32 + e];
    const float* n2 = p.norm2 + layer * 1024;
    __syncthreads();
    const int tok0 = F.blk * tpb, nsteps = (tpb + 15) / 16;
    v2u vn[2][4];
    f32x4 gsc[4], shv[4]; int bs_cur = -1;
#pragma unroll
    for (int rr = 0; rr < 2; ++rr) { const int tl = 2 * wave + rr; const int r = tok2row(tok0 + (tl < tpb ? tl : 0), latent_only);
#pragma unroll
        for (int j = 0; j < 4; ++j) vn[rr][j] = *(const v2u*)(xres + (size_t)r * 1024 + 4 * lane + 256 * j); }
#pragma unroll 1
    for (int st = 0; st < nsteps; ++st) {
#pragma unroll
        for (int rr = 0; rr < 2; ++rr) {
            const int tl = st * 16 + 2 * wave + rr; const bool valid = tl < tpb; const int tok = tok0 + (valid ? tl : 0);
            f32x4 v[4];
#pragma unroll
            for (int j = 0; j < 4; ++j) v[j] = (f32x4){bflo(vn[rr][j].x), bfhi(vn[rr][j].x), bflo(vn[rr][j].y), bfhi(vn[rr][j].y)};
            { const int tln = tl + 16; const int rn = tok2row(tok0 + (tln < tpb ? tln : 0), latent_only);
#pragma unroll
              for (int j = 0; j < 4; ++j) vn[rr][j] = *(const v2u*)(xres + (size_t)rn * 1024 + 4 * lane + 256 * j); }
            const int r = tok2row(tok, latent_only); const int b = r / TPB, t = r % TPB; const int bs = t < SEQ ? b : 4;
            if (bs != bs_cur) { const float* mv = modv + (size_t)bs * 6144; bs_cur = bs;
#pragma unroll
                for (int j = 0; j < 4; ++j) { const int c = 4 * lane + 256 * j; const f32x4 g = *(const f32x4*)(n2 + c), sc = *(const f32x4*)(mv + 4096 + c); gsc[j] = g * (sc + 1.0f); shv[j] = *(const f32x4*)(mv + 3072 + c); } }
            float ss = 0.f;
#pragma unroll
            for (int j = 0; j < 4; ++j) ss += (v[j].x * v[j].x + v[j].y * v[j].y) + (v[j].z * v[j].z + v[j].w * v[j].w);
            const float rstd = 1.0f / sqrtf(wave_sum(ss) * (1.0f / 1024.0f) + EPS);
#pragma unroll
            for (int j = 0; j < 4; ++j) { const int c = 4 * lane + 256 * j;
                const f32x4 h = (v[j] * rstd) * gsc[j] + shv[j];
                v2u o; o.x = pk2h(h.x, h.y); o.y = pk2h(h.z, h.w);
                v2u l; l.x = pk2h(h.x - bflo(o.x), h.y - bfhi(o.x)); l.y = pk2h(h.z - bflo(o.y), h.w - bfhi(o.y));
                *(LAS v2u*)(hhi + (2 * wave + rr) * RS + c) = o; *(LAS v2u*)(hlo + (2 * wave + rr) * RS + c) = l;
                if (valid) { int w8 = 0; w8 = __builtin_amdgcn_cvt_pk_fp8_f32(h.x, h.y, w8, false); w8 = __builtin_amdgcn_cvt_pk_fp8_f32(h.z, h.w, w8, true); *(int*)(H8 + (size_t)r * 1024 + c) = w8; } }
        }
        __syncthreads();
        { f32x4 a0 = {0.f, 0.f, 0.f, 0.f}, a1 = {0.f, 0.f, 0.f, 0.f};
#pragma unroll
          for (int kk = 0; kk < 4; ++kk) { const int ko = l15 * RS + wave * 128 + kk * 32 + q4 * 8;
              const bf16x8 ah = *(const LAS bf16x8*)(hhi + ko), al = *(const LAS bf16x8*)(hlo + ko);
              a0 = __builtin_amdgcn_mfma_f32_16x16x32_bf16(ah, whi[0][kk], a0, 0, 0, 0); a1 = __builtin_amdgcn_mfma_f32_16x16x32_bf16(ah, whi[1][kk], a1, 0, 0, 0);
              a0 = __builtin_amdgcn_mfma_f32_16x16x32_bf16(ah, wlo[0][kk], a0, 0, 0, 0); a1 = __builtin_amdgcn_mfma_f32_16x16x32_bf16(ah, wlo[1][kk], a1, 0, 0, 0);
              a0 = __builtin_amdgcn_mfma_f32_16x16x32_bf16(al, whi[0][kk], a0, 0, 0, 0); a1 = __builtin_amdgcn_mfma_f32_16x16x32_bf16(al, whi[1][kk], a1, 0, 0, 0); }
#pragma unroll
          for (int rg = 0; rg < 4; ++rg) { part[(wave * 16 + 4 * q4 + rg) * 32 + l15] = a0[rg]; part[(wave * 16 + 4 * q4 + rg) * 32 + 16 + l15] = a1[rg]; } }
        __syncthreads();
        { const int row = 2 * wave + (lane >> 5); const int tl = st * 16 + row; const bool valid = tl < tpb; const int tok = tok0 + tl;
            float logit = brt;
#pragma unroll
            for (int w = 0; w < 8; ++w) logit += part[(w * 16 + row) * 32 + e];
            lg[row * 32 + e] = logit;
            int rank = 0;
#pragma unroll
            for (int j4 = 0; j4 < 8; ++j4) { const f32x4 lv = *(const LAS f32x4*)(lg + row * 32 + 4 * j4);
#pragma unroll
                for (int i = 0; i < 4; ++i) { const int j = 4 * j4 + i; rank += (lv[i] > logit || (lv[i] == logit && j < e)) ? 1 : 0; } }
            if (valid && rank < 4) { TOPI[(size_t)tok * 4 + rank] = e; atomicAdd((int*)(lhist + e), 1); }
            if (rank < 4) sel[row * 4 + rank] = logit;
            if (valid && e < 4) { const f32x4 sv = *(const LAS f32x4*)(sel + row * 4);
                const float e1 = __expf(sv[1] - sv[0]), e2 = __expf(sv[2] - sv[0]), e3 = __expf(sv[3] - sv[0]); const float inv = 1.0f / (1.0f + e1 + e2 + e3);
                const float mine = e == 0 ? 1.0f : (e == 1 ? e1 : (e == 2 ? e2 : e3));
                TOPW[(size_t)tok * 4 + e] = mine * inv; }
        }
    }
    __syncthreads();
    if (F.tid < 32) HIST[F.blk * 32 + F.tid] = lhist[F.tid];
}

__device__ __forceinline__ void phase_lists(const KP& p, const Ctx& F, bool latent_only) {
    const int ntok = latent_only ? NLAT : M; const int tpb = ntok / F.G;
    const int* HIST = (const int*)(F.ws + WS_HIST); const int* TOPI = (const int*)(F.ws + WS_TOPI);
    int* POS = (int*)(F.ws + WS_POS); int* SORT = (int*)(F.ws + WS_SORT); int* META = (int*)(F.ws + WS_META);
    LAS int* ltot = (LAS int*)F.lds;
    LAS int* lbase = ltot + 32;
    LAS int* lstart = ltot + 64;
    LAS int* ltop = ltot + 128;
    LAS int* ptot = ltot + 1024; LAS int* pbase = ltot + 1536;
    { const int e = F.tid & 31, j = F.tid >> 5, per = (F.G + 15) >> 4; int tot = 0, base = 0;
        for (int k = 0; k < per; ++k) { const int b = j * per + k; const int h = (b < F.G) ? HIST[b * 32 + e] : 0; tot += h; base += (b < F.blk) ? h : 0; }
        ptot[j * 32 + e] = tot; pbase[j * 32 + e] = base; }
    for (int i = F.tid; i < tpb * 4; i += 512) ltop[i] = TOPI[(size_t)F.blk * tpb * 4 + i];
    __syncthreads();
    if (F.tid < 32) { int tot = 0, base = 0;
#pragma unroll
        for (int j = 0; j < 16; ++j) { tot += ptot[j * 32 + F.tid]; base += pbase[j * 32 + F.tid]; }
        ltot[F.tid] = tot; lbase[F.tid] = base; }
    __syncthreads();
    if (F.tid == 0) { int s = 0; for (int e = 0; e < 32; ++e) { lstart[e] = s; s += (ltot[e] + 255) & ~255; } lstart[32] = s; }
    __syncthreads();
    {
        const int e = F.tid & 31, seg = F.tid >> 5, n = tpb * 4, per = (n + 15) >> 4, i0 = seg * per, i1 = min(n, i0 + per);
        int cnt = 0;
        for (int i = i0; i < i1; ++i) cnt += (ltop[i] == e) ? 1 : 0;
        ptot[seg * 32 + e] = cnt;
        __syncthreads();
        int pos = lstart[e] + lbase[e];
        for (int s2 = 0; s2 < seg; ++s2) pos += ptot[s2 * 32 + e];
        for (int i = i0; i < i1; ++i) if (ltop[i] == e) { const int tok = F.blk * tpb + (i >> 2); SORT[pos] = tok2row(tok, latent_only); POS[(size_t)tok * 4 + (i & 3)] = pos; ++pos; } }
    if (F.blk < 32) { const int e = F.blk; const int s0 = lstart[e] + ltot[e], s1 = lstart[e + 1]; for (int i = s0 + F.tid; i < s1; i += 512) SORT[i] = 0; }
    if (F.blk == 0 && F.tid < 33) { META[64 + F.tid] = lstart[F.tid] >> 8; if (F.tid < 32) { META[F.tid] = ltot[F.tid]; META[32 + F.tid] = lstart[F.tid]; } }
}

template <bool FINAL>
__device__ __forceinline__ void phase_combine(const KP& p, const Ctx& F, int layer) {
    const float* modv = (const float*)(F.ws + WS_MODV); bf16* xres = (bf16*)(F.ws + WS_XRES); bf16* H = (bf16*)(F.ws + WS_H);
    const int* POS = (const int*)(F.ws + WS_POS); const float* TOPW = (const float*)(F.ws + WS_TOPW); const unsigned char* YS = F.ws + WS_YS;
    const int ntok = FINAL ? NLAT : M; const int gw = F.blk * 8 + F.wave, NGW = F.G * 8, lane = F.lane;
    int4 psC, psN, psNN; float4 wvC, wvN, wvNN; int yC[4][4], yN[4][4]; v2u xC[4], xN[4];
#define CB_IDX(tok_, ps_, wv_) do { ps_ = *(const int4*)(POS + (size_t)(tok_) * 4); wv_ = *(const float4*)(TOPW + (size_t)(tok_) * 4); } while (0)
#define CB_DATA(tok_, ps_, y_, x_) do { const int r_ = tok2row((tok_), FINAL); _Pragma("unroll") for (int j_ = 0; j_ < 4; ++j_) { const int c_ = 4 * lane + 256 * j_; \
        y_[0][j_] = *(const int*)(YS + (size_t)ps_.x * 1024 + c_); y_[1][j_] = *(const int*)(YS + (size_t)ps_.y * 1024 + c_); y_[2][j_] = *(const int*)(YS + (size_t)ps_.z * 1024 + c_); y_[3][j_] = *(const int*)(YS + (size_t)ps_.w * 1024 + c_); \
        x_[j_] = *(const v2u*)(xres + (size_t)r_ * 1024 + c_); } } while (0)
    int tok = gw;
    if (tok < ntok) { CB_IDX(tok, psC, wvC); CB_DATA(tok, psC, yC, xC); }
    if (tok + NGW < ntok) CB_IDX(tok + NGW, psN, wvN);
#pragma unroll 1
    for (; tok < ntok; tok += NGW) {
        if (tok + NGW < ntok) CB_DATA(tok + NGW, psN, yN, xN);
        if (tok + 2 * NGW < ntok) CB_IDX(tok + 2 * NGW, psNN, wvNN);
        __builtin_amdgcn_sched_barrier(0);
        const int r = tok2row(tok, FINAL); const int b = r / TPB, t = r % TPB; const int bs = t < SEQ ? b : 4;
        const float* g2 = modv + (size_t)(layer * 5 + bs) * 6144 + 5120;
        f32x4 v[4];
#pragma unroll
        for (int j = 0; j < 4; ++j) { const int c = 4 * lane + 256 * j; f32x4 a;
            a.x = wvC.x * __builtin_amdgcn_cvt_f32_fp8(yC[0][j], 0) + wvC.y * __builtin_amdgcn_cvt_f32_fp8(yC[1][j], 0) + wvC.z * __builtin_amdgcn_cvt_f32_fp8(yC[2][j], 0) + wvC.w * __builtin_amdgcn_cvt_f32_fp8(yC[3][j], 0);
            a.y = wvC.x * __builtin_amdgcn_cvt_f32_fp8(yC[0][j], 1) + wvC.y * __builtin_amdgcn_cvt_f32_fp8(yC[1][j], 1) + wvC.z * __builtin_amdgcn_cvt_f32_fp8(yC[2][j], 1) + wvC.w * __builtin_amdgcn_cvt_f32_fp8(yC[3][j], 1);
            a.z = wvC.x * __builtin_amdgcn_cvt_f32_fp8(yC[0][j], 2) + wvC.y * __builtin_amdgcn_cvt_f32_fp8(yC[1][j], 2) + wvC.z * __builtin_amdgcn_cvt_f32_fp8(yC[2][j], 2) + wvC.w * __builtin_amdgcn_cvt_f32_fp8(yC[3][j], 2);
            a.w = wvC.x * __builtin_amdgcn_cvt_f32_fp8(yC[0][j], 3) + wvC.y * __builtin_amdgcn_cvt_f32_fp8(yC[1][j], 3) + wvC.z * __builtin_amdgcn_cvt_f32_fp8(yC[2][j], 3) + wvC.w * __builtin_amdgcn_cvt_f32_fp8(yC[3][j], 3);
            const f32x4 gg = *(const f32x4*)(g2 + c);
            v[j] = (f32x4){bflo(xC[j].x), bfhi(xC[j].x), bflo(xC[j].y), bfhi(xC[j].y)} + gg * a; }
        if (!FINAL) {
#pragma unroll
            for (int j = 0; j < 4; ++j) { v2u o; o.x = pk2(v[j].x, v[j].y); o.y = pk2(v[j].z, v[j].w); *(v2u*)(xres + (size_t)r * 1024 + 4 * lane + 256 * j) = o; }
            const float* mv = modv + (size_t)(5 + bs) * 6144;
            norm_mod_store(v, p.norm1 + 1024, mv + 1024, mv, H + (size_t)r * 1024, lane);
        } else {
            float ss = 0.f;
#pragma unroll
            for (int j = 0; j < 4; ++j) ss += (v[j].x * v[j].x + v[j].y * v[j].y) + (v[j].z * v[j].z + v[j].w * v[j].w);
            const float rstd = 1.0f / sqrtf(wave_sum(ss) * (1.0f / 1024.0f) + EPS);
            float* orow = p.out + (size_t)tok * 1024;
#if defined(MX_SELFTEST) || defined(ATT_CHECK)
            const float tsc = 1.0f + 0.1f * (float)((const unsigned*)(F.ws + WS_CTL))[64];
#else
            const float tsc = 1.0f;
#endif
#pragma unroll
            for (int j = 0; j < 4; ++j) { const int c = 4 * lane + 256 * j; const f32x4 g = *(const f32x4*)(p.final_norm + c); *(f32x4*)(orow + c) = (v[j] * rstd) * g * tsc; }
        }
        psC = psN; wvC = wvN; psN = psNN; wvN = wvNN;
#pragma unroll
        for (int j = 0; j < 4; ++j) { xC[j] = xN[j];
#pragma unroll
            for (int k2 = 0; k2 < 4; ++k2) yC[k2][j] = yN[k2][j]; }
    }
#undef CB_IDX
#undef CB_DATA
}

__device__ __forceinline__ void phase_gla_finish(const KP& p, const Ctx& F) {
    const bf16* OFb = (const bf16*)(F.ws + WS_OF); const bf16* OBb = (const bf16*)(F.ws + WS_OB); const bf16* A2 = (const bf16*)(F.ws + WS_A2); bf16* Z = (bf16*)(F.ws + WS_Z);
    const int gw = F.blk * 8 + F.wave, NGW = F.G * 8, lane = F.lane;
    for (int tok = gw; tok < NLAT; tok += NGW) {
        const int r = tok2row(tok, true); const int c = 16 * lane;
        const v4u a0 = *(const v4u*)(OFb + (size_t)r * 1024 + c), a1 = *(const v4u*)(OFb + (size_t)r * 1024 + c + 8);
        const v4u b0 = *(const v4u*)(OBb + (size_t)r * 1024 + c), b1 = *(const v4u*)(OBb + (size_t)r * 1024 + c + 8);
        const v4u g0 = *(const v4u*)(A2 + (size_t)r * A2W + 2048 + c), g1 = *(const v4u*)(A2 + (size_t)r * A2W + 2048 + c + 8);
        float o[16], rg[16];
#pragma unroll
        for (int i = 0; i < 4; ++i) { o[2 * i] = bflo(a0[i]) + bflo(b0[i]); o[2 * i + 1] = bfhi(a0[i]) + bfhi(b0[i]); o[8 + 2 * i] = bflo(a1[i]) + bflo(b1[i]); o[8 + 2 * i + 1] = bfhi(a1[i]) + bfhi(b1[i]);
            rg[2 * i] = bflo(g0[i]); rg[2 * i + 1] = bfhi(g0[i]); rg[8 + 2 * i] = bflo(g1[i]); rg[8 + 2 * i + 1] = bfhi(g1[i]); }
        float ss = 0.f;
#pragma unroll
        for (int i = 0; i < 16; ++i) ss += o[i] * o[i];
        ss += __shfl_xor(ss, 1); ss += __shfl_xor(ss, 2); ss += __shfl_xor(ss, 4); ss += __shfl_xor(ss, 8);
        const float rstd = 1.0f / sqrtf(ss * (1.0f / 256.0f) + EPS);
        const float* hn = p.gla_head_norm + (c & 255);
        unsigned w[8];
#pragma unroll
        for (int i = 0; i < 8; ++i) { const float x0 = o[2 * i] * rstd * hn[2 * i] * (rg[2 * i] / (1.0f + __expf(-rg[2 * i]))), x1 = o[2 * i + 1] * rstd * hn[2 * i + 1] * (rg[2 * i + 1] / (1.0f + __expf(-rg[2 * i + 1])));
            w[i] = pk2(x0, x1); }
        *(v4u*)(Z + (size_t)r * 1024 + c) = (v4u){w[0], w[1], w[2], w[3]}; *(v4u*)(Z + (size_t)r * 1024 + c + 8) = (v4u){w[4], w[5], w[6], w[7]};
    }
}

namespace att {
constexpr int NW = 8, QBLK = 32, KVBLK = 64;
constexpr float SCALE = 0.07216878364870322f;
constexpr float THR = 2.f;
constexpr float PSHIFT = 5.f;
#ifndef ATT_SDEPTH
#define ATT_SDEPTH 2
#endif
constexpr int SDEPTH = ATT_SDEPTH;
constexpr int LDQ8 = 1536, LDK = 1024, LDK8 = 1024, LDKR8 = 64, LDO = 1024;
constexpr int SHM_V = 128 * KVBLK, SHM_K8 = KVBLK * 128, SHM_KR8 = KVBLK * 64;
constexpr int OFF_V = 0, OFF_K = 2 * SHM_V, OFF_KR = OFF_K + 2 * SHM_K8, OFF_WS = OFF_KR + 2 * SHM_KR8, OFF_Q2 = OFF_WS + NW * 64 * 4, SHM_ATTN = OFF_Q2 + NW * 2048;
typedef int v8i __attribute__((ext_vector_type(8)));
typedef int v4i __attribute__((ext_vector_type(4)));
#define K8U(key, u) ((key) * 128 + ((((u) ^ (((key) >> 1) & 7))) << 4))
#define KR8U(key, u) ((key) * 64 + ((((u) ^ (((key) >> 2) & 3))) << 4))
__device__ __forceinline__ v8i cat8(v4i lo, v4i hi) { return (v8i){lo[0], lo[1], lo[2], lo[3], hi[0], hi[1], hi[2], hi[3]}; }
__device__ __forceinline__ void mfma64(f32x16& c, v8i a, v8i b, int sc) { asm volatile("v_mfma_scale_f32_32x32x64_f8f6f4 %0, %1, %2, %0, %3, %3 op_sel_hi:[0,0,0]" : "+v"(c) : "v"(a), "v"(b), "v"(sc)); }
__device__ __forceinline__ void mfma64s(f32x16& c, v8i a, v8i b, int sa, int sb) { asm volatile("v_mfma_scale_f32_32x32x64_f8f6f4 %0, %1, %2, %0, %3, %4 op_sel_hi:[0,0,0]" : "+v"(c) : "v"(a), "v"(b), "v"(sa), "v"(sb)); }
typedef float f32x8 __attribute__((ext_vector_type(8)));
#define SBAR() __builtin_amdgcn_sched_barrier(0)
__device__ __forceinline__ int crow(int r, int hi) { return (r & 3) + 8 * (r >> 2) + 4 * hi; }
__device__ __forceinline__ unsigned cvtpk(float lo, float hi) { unsigned r; asm volatile("v_cvt_pk_bf16_f32 %0, %1, %2" : "=v"(r) : "v"(lo), "v"(hi)); return r; }

constexpr float THR2 = THR * 1.4426950408889634f;
__device__ __forceinline__ void softmax_step(f32x16& p0, f32x16& p1, float mref, float& m2, float& l_reg, float& al, v8i& pa, bool first) {
  const float d = mref - m2;
  if (__builtin_expect(__any(d != 0.f), 0)) {
#pragma unroll
    for (int r = 0; r < 16; ++r) { p0[r] += d; p1[r] += d; }
  }
  float pmax = p0[0];
#pragma unroll
  for (int r = 1; r < 16; ++r) pmax = fmaxf(pmax, p0[r]);
#pragma unroll
  for (int r = 0; r < 16; ++r) pmax = fmaxf(pmax, p1[r]);
  { auto rr = __builtin_amdgcn_permlane32_swap(__float_as_uint(pmax), __float_as_uint(pmax), false, false);
    pmax = fmaxf(__uint_as_float(rr[0]), __uint_as_float(rr[1])); }
  const float ex = pmax - PSHIFT;
  al = 1.f;
  if (__builtin_expect(first || __any(ex > THR2), 0)) {
    const float inc = first ? ex : fmaxf(ex, 0.f);
    m2 += inc; al = first ? 0.f : __builtin_amdgcn_exp2f(-inc);
#pragma unroll
    for (int r = 0; r < 16; ++r) { p0[r] -= inc; p1[r] -= inc; }
  }
#pragma unroll
  for (int r = 0; r < 16; ++r) p0[r] = __builtin_amdgcn_exp2f(p0[r]);
#pragma unroll
  for (int r = 0; r < 16; ++r) p1[r] = __builtin_amdgcn_exp2f(p1[r]);
  float ps = 0;
#pragma unroll
  for (int r = 0; r < 16; ++r) ps += p0[r];
#pragma unroll
  for (int r = 0; r < 16; ++r) ps += p1[r];
  { auto rr = __builtin_amdgcn_permlane32_swap(__float_as_uint(ps), __float_as_uint(ps), false, false);
    ps = __uint_as_float(rr[0]) + __uint_as_float(rr[1]); }
  l_reg = l_reg * al + ps;
#pragma unroll
  for (int w = 0; w < 4; ++w) { int x, y;
    asm("v_cvt_pk_fp8_f32 %0, %2, %3\n\tv_cvt_pk_fp8_f32 %1, %6, %7\n\tv_cvt_pk_fp8_f32 %0, %4, %5 op_sel:[0,0,1]\n\tv_cvt_pk_fp8_f32 %1, %8, %9 op_sel:[0,0,1]\n\ts_nop 0"
        : "=&v"(x), "=&v"(y) : "v"(p0[4 * w]), "v"(p0[4 * w + 1]), "v"(p0[4 * w + 2]), "v"(p0[4 * w + 3]), "v"(p1[4 * w]), "v"(p1[4 * w + 1]), "v"(p1[4 * w + 2]), "v"(p1[4 * w + 3]));
    pa[w] = x; pa[4 + w] = y; }
}
__device__ __forceinline__ void qkt(f32x16& p0, f32x16& p1, const char* K8s, const char* KR8s, const v8i* qf, int r32, int hi, int sc) {
  p0 = f32x16{}; p1 = f32x16{};
  asm volatile("s_nop 4" : "+v"(p0), "+v"(p1));
#pragma unroll
  for (int s = 0; s < 2; ++s) { const int u0 = 4 * s + 2 * hi;
    const v8i a0 = cat8(*reinterpret_cast<const v4i*>(K8s + K8U(r32, u0)), *reinterpret_cast<const v4i*>(K8s + K8U(r32, u0 + 1)));
    const v8i a1 = cat8(*reinterpret_cast<const v4i*>(K8s + K8U(32 + r32, u0)), *reinterpret_cast<const v4i*>(K8s + K8U(32 + r32, u0 + 1)));
    mfma64(p0, a0, qf[s], sc); mfma64(p1, a1, qf[s], sc); }
  { const int u0 = 2 * hi;
    const v8i a0 = cat8(*reinterpret_cast<const v4i*>(KR8s + KR8U(r32, u0)), *reinterpret_cast<const v4i*>(KR8s + KR8U(r32, u0 + 1)));
    const v8i a1 = cat8(*reinterpret_cast<const v4i*>(KR8s + KR8U(32 + r32, u0)), *reinterpret_cast<const v4i*>(KR8s + KR8U(32 + r32, u0 + 1)));
    mfma64(p0, a0, qf[2], sc); mfma64(p1, a1, qf[2], sc); }
  asm volatile("s_nop 15\n\ts_nop 7" : "+v"(p0), "+v"(p1));
}
#define V8U(d, u) ((d) * 64 + ((((u) ^ (((d) >> 2) & 3))) << 4))
__device__ __forceinline__ void pv_d0(f32x16* o, const char* V8s, v8i pa, int r32, int hi, int sc) {
#pragma unroll
  for (int d0 = 0; d0 < 4; ++d0) { const int d = 32 * d0 + r32;
    const v8i vb = cat8(*reinterpret_cast<const v4i*>(V8s + V8U(d, 2 * hi)), *reinterpret_cast<const v4i*>(V8s + V8U(d, 2 * hi + 1)));
    mfma64(o[d0], pa, vb, sc); }
  asm volatile("s_nop 15\n\ts_nop 7" : "+v"(o[0]), "+v"(o[1]), "+v"(o[2]), "+v"(o[3]));
}

__device__ __forceinline__ void attn_unit(const unsigned char* __restrict__ Qb, const unsigned char* __restrict__ Kh, const unsigned char* __restrict__ KRh, const unsigned char* __restrict__ Vh, unsigned char* __restrict__ Ob, int seq, char* lds) {
  int tid_ = threadIdx.x; asm volatile("" : "+v"(tid_));
  const int tid = tid_, wid = __builtin_amdgcn_readfirstlane(tid >> 6), lane = tid & 63, r32 = lane & 31, hi = lane >> 5;
  char* V_lds = lds + OFF_V; char* K_lds = lds + OFF_K; char* KR_lds = lds + OFF_KR;
  float* ws = (float*)(lds + OFF_WS) + wid * 64; float* li_l = ws; float* al_l = ws + 32;
  float m2 = 0.f, mrE = 0.f, mrO = 0.f, l_reg = 0, al = 1.f; f32x16 o[4] = {}; v8i qf[2];
  const int sc1 = 0x7f7f7f7f, scq = 0x7c7c7c7c;
  const unsigned char* Qw = Qb + (long)(wid * QBLK + r32) * LDQ8 + hi * 32;
#pragma unroll
  for (int s = 0; s < 2; ++s) qf[s] = *reinterpret_cast<const v8i*>(Qw + s * 64);
  char* q2_l = lds + OFF_Q2 + wid * 2048 + lane * 16;
  { const v8i q2 = *reinterpret_cast<const v8i*>(Qw + 128); *(v4i*)q2_l = (v4i){q2[0], q2[1], q2[2], q2[3]}; *(v4i*)(q2_l + 1024) = (v4i){q2[4], q2[5], q2[6], q2[7]}; }
  const int v8d = tid >> 2, v8u = tid & 3;
  const int k8r = tid >> 3, k8u = tid & 7, kr8r = (tid >> 2) & 63, kr8u = tid & 3;
  const bool has_kr = wid < 4;
  const int NT = seq / KVBLK;
  v4i sv8, sk8, skr8;
#define SLOAD(kt, vt) do { const int kt_ = min((kt), NT - 1) * KVBLK, vt_ = min(max((vt), 0), NT - 1) * KVBLK; \
    sv8 = *reinterpret_cast<const v4i*>(Vh + (size_t)v8d * 8448 + (unsigned)vt_ + v8u * 16); \
    sk8 = *reinterpret_cast<const v4i*>(Kh + (unsigned)(kt_ + k8r) * LDK8 + k8u * 16); \
    if (has_kr) skr8 = *reinterpret_cast<const v4i*>(KRh + (unsigned)(kt_ + kr8r) * LDKR8 + kr8u * 16); } while (0)
#define SWRITE(b) do { *(v4i*)(V_lds + (b) * SHM_V + V8U(v8d, v8u)) = sv8; \
    *(v4i*)(K_lds + (b) * SHM_K8 + K8U(k8r, k8u)) = sk8; \
    if (has_kr) *(v4i*)(KR_lds + (b) * SHM_KR8 + KR8U(kr8r, kr8u)) = skr8; } while (0)
#define STAGE(b, t_) do { asm volatile("s_waitcnt vmcnt(0)" ::: "memory"); SWRITE(b); SLOAD((t_) + 3, (t_) + 1); } while (0)
#define RESC() do { if (__any(al < 1.f)) { if (hi == 0) al_l[r32] = al; asm volatile("s_waitcnt lgkmcnt(0)" ::: "memory"); \
    _Pragma("unroll") for (int d = 0; d < 4; ++d) _Pragma("unroll") for (int r = 0; r < 16; ++r) o[d][r] *= al_l[crow(r, hi)]; \
    asm volatile("s_nop 4" : "+v"(o[0]), "+v"(o[1]), "+v"(o[2]), "+v"(o[3])); } } while (0)
#define LDK(b, half, s) cat8(*reinterpret_cast<const v4i*>(K_lds + (b) * SHM_K8 + K8U(32 * (half) + r32, 4 * (s) + 2 * hi)), *reinterpret_cast<const v4i*>(K_lds + (b) * SHM_K8 + K8U(32 * (half) + r32, 4 * (s) + 2 * hi + 1)))
#define LDKR(b, half) cat8(*reinterpret_cast<const v4i*>(KR_lds + (b) * SHM_KR8 + KR8U(32 * (half) + r32, 2 * hi)), *reinterpret_cast<const v4i*>(KR_lds + (b) * SHM_KR8 + KR8U(32 * (half) + r32, 2 * hi + 1)))
#define LDV(b, d0) cat8(*reinterpret_cast<const v4i*>(V_lds + (b) * SHM_V + V8U(32 * (d0) + r32, 2 * hi)), *reinterpret_cast<const v4i*>(V_lds + (b) * SHM_V + V8U(32 * (d0) + r32, 2 * hi + 1)))
#define MSTEP(do_pv, vb, do_qk, kb, P0, P1, MR) do { __builtin_amdgcn_s_setprio(1); \
    if (do_pv) { RESC(); \
      { const v8i v0 = LDV(vb, 0), v1 = LDV(vb, 1), v2 = LDV(vb, 2), v3 = LDV(vb, 3); SBAR(); \
        mfma64(o[0], pa, v0, sc1); mfma64(o[1], pa, v1, sc1); mfma64(o[2], pa, v2, sc1); mfma64(o[3], pa, v3, sc1); SBAR(); } } \
    if (do_qk) { v8i a0 = LDK(kb, 0, 0), a1 = LDK(kb, 1, 0); const v8i b0 = LDK(kb, 0, 1), b1 = LDK(kb, 1, 1); \
      { const float ci = PSHIFT - m2; MR = m2; _Pragma("unroll") for (int r_ = 0; r_ < 16; ++r_) { P0[r_] = ci; P1[r_] = ci; } } \
      asm volatile("s_nop 4" : "+v"(P0), "+v"(P1)); SBAR(); \
      mfma64s(P0, a0, qf[0], sc1, scq); mfma64s(P1, a1, qf[0], sc1, scq); SBAR(); \
      a0 = LDKR(kb, 0); a1 = LDKR(kb, 1); const v8i q2 = cat8(*reinterpret_cast<const v4i*>(q2_l), *reinterpret_cast<const v4i*>(q2_l + 1024)); SBAR(); \
      mfma64s(P0, b0, qf[1], sc1, scq); mfma64s(P1, b1, qf[1], sc1, scq); SBAR(); \
      mfma64s(P0, a0, q2, sc1, scq); mfma64s(P1, a1, q2, sc1, scq); \
      asm volatile("s_nop 15\n\ts_nop 7" : "+v"(P0), "+v"(P1)); } SBAR(); __builtin_amdgcn_s_setprio(0); } while (0)
#define VSTEP(P0, P1, MR, first) do { softmax_step(P0, P1, MR, m2, l_reg, al, pa, first); SBAR(); } while (0)
  f32x16 pE0, pE1, pO0, pO1; v8i pa = {0, 0, 0, 0, 0, 0, 0, 0};
  const bool g1 = wid >= 4;
  SLOAD(0, 0); asm volatile("s_waitcnt vmcnt(0)" ::: "memory"); SWRITE(0); SLOAD(1, 0); __syncthreads();
  if (g1) __syncthreads();
#pragma unroll 1
  for (int t = -1; t < NT; t += 2) {
    if (g1) STAGE(1, t);
    MSTEP(t >= 1, 0, t + 1 < NT, 0, pE0, pE1, mrE);
    __syncthreads();
    if (!g1) STAGE(1, t);
    if (t >= 1) VSTEP(pO0, pO1, mrO, false);
    __syncthreads();
    if (g1) STAGE(0, t + 1);
    MSTEP(t >= 0, 1, t + 2 < NT, 1, pO0, pO1, mrO);
    __syncthreads();
    if (!g1) STAGE(0, t + 1);
    if (t + 1 < NT) VSTEP(pE0, pE1, mrE, t < 0);
    __syncthreads();
  }
  if (!g1) __syncthreads();
  asm volatile("s_nop 15\n\ts_nop 7" : "+v"(o[0]), "+v"(o[1]), "+v"(o[2]), "+v"(o[3]));
  if (hi == 0) li_l[r32] = l_reg; asm volatile("s_waitcnt lgkmcnt(0)" ::: "memory");
  float rli[16];
#pragma unroll
  for (int r = 0; r < 16; ++r) rli[r] = __builtin_amdgcn_rcpf(li_l[crow(r, hi)]);
  unsigned char* Ow = Ob + (long)(wid * QBLK) * LDO;
#pragma unroll
  for (int r = 0; r < 16; ++r) { int orow = crow(r, hi);
#pragma unroll
    for (int d0 = 0; d0 < 4; ++d0) Ow[(long)orow * LDO + d0 * 32 + r32] = (unsigned char)(__builtin_amdgcn_cvt_pk_fp8_f32(o[d0][r] * rli[r], 0.f, 0, false) & 0xff); }
  __syncthreads();
#undef SLOAD
#undef SWRITE
#undef STAGE
#undef RESC
#undef LDK
#undef LDKR
#undef LDV
#undef MSTEP
#undef VSTEP
}
#undef K8U
#undef KR8U
#undef V8U
#undef SBAR
}

__device__ __forceinline__ void phase_attention(const Ctx& F) {
    const unsigned char* Q = F.ws + WS_Q8; const unsigned char* KN = F.ws + WS_KN8; const unsigned char* KR = F.ws + WS_KR8; const unsigned char* VT = F.ws + WS_VT8; unsigned char* O = F.ws + WS_O8;
    char* lds = (char*)F.lds;
    const bool xcd = (F.G & 7) == 0; const int nq = xcd ? (F.G >> 3) : F.G; const int lat_rounds = xcd ? (128 + nq - 1) / nq : (1024 + F.G - 1) / F.G;
#pragma unroll 1
    for (int i = 0;; ++i) {
        int bh, qrow, krow, seq;
        if (i < lat_rounds) {
            int qt;
            if (xcd) { const int x = F.blk & 7, q = F.blk >> 3; const int uu = i * nq + q; bh = (uu >> 5) * 8 + x; qt = uu & 31; if (uu >= 128) continue; }
            else { const int uu = i * F.G + F.blk; bh = uu >> 5; qt = uu & 31; if (uu >= 1024) continue; }
            qrow = qt * 256; krow = 0; seq = TPB;
        } else { bh = (i - lat_rounds) * F.G + F.blk; if (bh >= NB * 8) break; qrow = SEQ; krow = SEQ; seq = LC; }
        const int b = bh >> 3, h = bh & 7; const size_t r0 = (size_t)b * TPB;
        att::attn_unit(Q + (r0 + qrow) * 1536 + h * 192, KN + (r0 + krow) * 1024 + h * 128, KR + (r0 + krow) * 64, VT + (size_t)(bh * 128) * 8448 + krow, O + (r0 + qrow) * 1024 + h * 128, seq, lds);
    }
}

__device__ __forceinline__ f32x4 mfma16(bf16x8 a, bf16x8 b, f32x4 c) { return __builtin_amdgcn_mfma_f32_16x16x32_bf16(a, b, c, 0, 0, 0); }
constexpr int NCH = M / 64;
constexpr int GL_AM = 0, GL_ST = 18432, GL_END = GL_ST + 8 * 32 * 136 * 2;

__device__ __forceinline__ void phase_gla_prep(const KP& p, const Ctx& F) {
    const bf16* A2 = (const bf16*)(F.ws + WS_A2);
    bf16* QE = (bf16*)(F.ws + WS_QE); bf16* KE = (bf16*)(F.ws + WS_KE); bf16* KPT = (bf16*)(F.ws + WS_KPT); bf16* VT = (bf16*)(F.ws + WS_VT); float* DEC = (float*)(F.ws + WS_DEC);
    const int gw = F.blk * 8 + F.wave, NGW = F.G * 8, tid = F.tid, lane = F.lane, wave = F.wave, q4 = lane >> 4, l15 = lane & 15;
    constexpr int TS = 264, PS = 72;
    LAS bf16* qT = (LAS bf16*)F.lds; LAS bf16* kT = qT + 64 * TS; LAS bf16* pT = kT + 64 * TS;
    const int pr = tid >> 5, pc = (tid & 31) * 8;
    const int kpr = tid >> 3, kpc = (tid & 7) * 8;
    v4u sq[4], sk[4]; bf16x8 tf[4]; bf16x8 w2n[2]; float bgn[2];
#define GP_LOADS(task_) do { const int hp_ = (task_) & 1, cgd_ = (task_) >> 1; const int cg_ = cgd_ % NCH, dir_ = cgd_ / NCH; const bf16* a_ = A2 + ((size_t)cg_ * 64) * A2W; \
        _Pragma("unroll") for (int i_ = 0; i_ < 4; ++i_) { const bf16* r_ = a_ + (size_t)(pr + 16 * i_) * A2W + hp_ * 256 + pc; sq[i_] = *(const v4u*)r_; sk[i_] = *(const v4u*)(r_ + 512); } \
        _Pragma("unroll") for (int mt_ = 0; mt_ < 4; ++mt_) { tf[mt_] = (bf16x8){0, 0, 0, 0, 0, 0, 0, 0}; if (q4 < 2) tf[mt_] = *(const bf16x8*)(a_ + (size_t)(16 * mt_ + l15) * A2W + 3072 + dir_ * 16 + q4 * 8); } \
        _Pragma("unroll") for (int tt_ = 0; tt_ < 2; ++tt_) { const int dcol_ = hp_ * 256 + (2 * wave + tt_) * 16 + l15; w2n[tt_] = (bf16x8){0, 0, 0, 0, 0, 0, 0, 0}; \
            if (q4 < 2) { _Pragma("unroll") for (int j_ = 0; j_ < 8; ++j_) w2n[tt_][j_] = (short)f2bf(p.gla_w_gate2[(size_t)(dir_ * 16 + q4 * 8 + j_) * 512 + dcol_]); } \
            bgn[tt_] = p.gla_b_gate[dir_ * 512 + dcol_]; } } while (0)
    const int ntask = 2 * NCH * 2;
    if (F.blk < ntask) GP_LOADS(F.blk);
#pragma unroll 1
    for (int task = F.blk; task < ntask; task += F.G) {
        const int hp = task & 1, cgd = task >> 1; const int cg = cgd % NCH, dir = cgd / NCH; const size_t row0 = (size_t)cg * 64;
#pragma unroll
        for (int i = 0; i < 4; ++i) { *(LAS v4u*)(qT + (pr + 16 * i) * TS + pc) = sq[i]; *(LAS v4u*)(kT + (pr + 16 * i) * TS + pc) = sk[i]; }
        bf16x8 tfc[4], w2c[2]; float bgc[2];
#pragma unroll
        for (int mt = 0; mt < 4; ++mt) tfc[mt] = tf[mt];
#pragma unroll
        for (int tt = 0; tt < 2; ++tt) { w2c[tt] = w2n[tt]; bgc[tt] = bgn[tt]; }
        __syncthreads();
        if (task + F.G < ntask) GP_LOADS(task + F.G);
        __builtin_amdgcn_sched_barrier(0);
#pragma unroll
        for (int tt = 0; tt < 2; ++tt) {
            const int ct = 2 * wave + tt, lc = ct * 16 + l15, dcol = hp * 256 + lc;
            const float bgd = bgc[tt];
            f32x4 gp[4];
#pragma unroll
            for (int mt = 0; mt < 4; ++mt) gp[mt] = mfma16(tfc[mt], w2c[tt], (f32x4){0.f, 0.f, 0.f, 0.f});
            float bb[4][4], gg[4][4]; float carry = 0.f;
#pragma unroll
            for (int mt = 0; mt < 4; ++mt) {
                float c[4];
#pragma unroll
                for (int r = 0; r < 4; ++r) { const float xg = gp[mt][r] + bgd; const float g = (fminf(xg, 0.f) - __logf(1.0f + __expf(-fabsf(xg)))) * 0.0625f; gg[mt][r] = g; c[r] = g + (r ? c[r - 1] : 0.f); }
                const float t0 = __shfl(c[3], l15), t1 = __shfl(c[3], l15 + 16), t2 = __shfl(c[3], l15 + 32), t3 = __shfl(c[3], l15 + 48);
                const float ex = carry + (q4 > 0 ? t0 : 0.f) + (q4 > 1 ? t1 : 0.f) + (q4 > 2 ? t2 : 0.f);
#pragma unroll
                for (int r = 0; r < 4; ++r) bb[mt][r] = ex + c[r];
                carry += (t0 + t1) + (t2 + t3);
            }
            const float btot = carry;
#pragma unroll
            for (int mt = 0; mt < 4; ++mt) {
                float kp[4];
#pragma unroll
                for (int r = 0; r < 4; ++r) { const int m = 16 * mt + 4 * q4 + r;
                    const float qv = bf2f(qT[m * TS + lc]), kv = bf2f(kT[m * TS + lc]); const float bv = dir ? (btot - bb[mt][r] + gg[mt][r]) : bb[mt][r];
                    qT[m * TS + lc] = (bf16)f2bf(qv * 0.08838834764831845f * __expf(bv)); kT[m * TS + lc] = (bf16)f2bf(kv * __expf(-bv));
                    kp[r] = kv * __expf(btot - bv); }
                v2u w; w.x = pk2(kp[0], kp[1]); w.y = pk2(kp[2], kp[3]);
                *(LAS v2u*)(pT + lc * PS + 16 * mt + 4 * q4) = w;
            }
            if (q4 == 0) DEC[((size_t)dir * NCH + cg) * 512 + dcol] = __expf(btot);
        }
        __syncthreads();
#pragma unroll
        for (int i = 0; i < 4; ++i) { const size_t oi = ((size_t)dir * M + row0 + pr + 16 * i) * 512 + hp * 256 + pc;
            *(v4u*)(QE + oi) = *(const LAS v4u*)(qT + (pr + 16 * i) * TS + pc); *(v4u*)(KE + oi) = *(const LAS v4u*)(kT + (pr + 16 * i) * TS + pc);
            *(v4u*)(KPT + (((size_t)dir * NCH + cg) * 512 + hp * 256 + kpr + 64 * i) * 64 + kpc) = *(const LAS v4u*)(pT + (kpr + 64 * i) * PS + kpc); }
        __syncthreads();
    }
#undef GP_LOADS
}

constexpr int GL_QE = 0, GL_KE = 17408, GL_KP = 34816, GL_AMS = 53248, GL_STS = 62464, GL_DEC = GL_STS + 8 * 32 * 136 * 2, GL_T1 = GL_DEC + 512, GL_END2 = GL_T1 + 2048;
template <bool OUT>
__device__ __forceinline__ void gla_unit(const KP& p, const Ctx& F, int ch, int s) {
    const int dir = ch & 1, hh = (ch >> 1) & 3, b = ch >> 3;
    const int tid = F.tid, lane = F.lane, wave = F.wave, q4 = lane >> 4, l15 = lane & 15;
    const bf16* A2 = (const bf16*)(F.ws + WS_A2); const bf16* VT = (const bf16*)(F.ws + WS_VT);
    bf16* UST = (bf16*)(F.ws + WS_UST); float* DS = (float*)(F.ws + WS_DS);
    bf16* Oout = (bf16*)(F.ws + (dir ? WS_OB : WS_OF));
    LAS bf16* QEs = (LAS bf16*)(F.lds + GL_QE); LAS bf16* KEs = (LAS bf16*)(F.lds + GL_KE); LAS bf16* KPs = (LAS bf16*)(F.lds + GL_KP); LAS bf16* AMs = (LAS bf16*)(F.lds + GL_AMS);
    LAS bf16* ST = (LAS bf16*)(F.lds + GL_STS) + wave * (32 * 136); LAS float* DECs = (LAS float*)(F.lds + GL_DEC); LAS bf16* T1s = (LAS bf16*)(F.lds + GL_T1);
    const int qr0 = tid >> 4, qc0 = (tid & 15) * 8;
    const int lc = wave * 16 + l15;
    v4u sq[2], sk[2], st1 = {0u, 0u, 0u, 0u}; bf16x8 vtn[2][2];
    bf16x8 w2f = {0, 0, 0, 0, 0, 0, 0, 0};
    if (q4 < 2) {
#pragma unroll
        for (int j = 0; j < 8; ++j) w2f[j] = (short)f2bf(p.gla_w_gate2[(size_t)(dir * 16 + q4 * 8 + j) * 512 + hh * 128 + lc]);
    }
    const float bgd = p.gla_b_gate[dir * 512 + hh * 128 + lc];
#define GL_CHUNK(sb_) ((s == 0) ? (dir ? 131 - (sb_) : 128 + (sb_)) : (dir ? 127 - 4 * (s - 1) - (sb_) : 4 * (s - 1) + (sb_)))
#define GL_LOADS(sb_) do { const int cg_ = b * 132 + GL_CHUNK(sb_); const bf16* a_ = A2 + ((size_t)cg_ * 64) * A2W; \
        if (OUT) { sq[0] = *(const v4u*)(a_ + (size_t)qr0 * A2W + hh * 128 + qc0); sq[1] = *(const v4u*)(a_ + (size_t)(qr0 + 32) * A2W + hh * 128 + qc0); } \
        sk[0] = *(const v4u*)(a_ + (size_t)qr0 * A2W + 512 + hh * 128 + qc0); sk[1] = *(const v4u*)(a_ + (size_t)(qr0 + 32) * A2W + 512 + hh * 128 + qc0); \
        if (tid < 128) st1 = *(const v4u*)(a_ + (size_t)(tid >> 1) * A2W + 3072 + dir * 16 + (tid & 1) * 8); \
        { const bf16* v_ = VT + ((size_t)cg_ * 1024 + hh * 256 + wave * 32) * 64 + 8 * q4; \
            vtn[0][0] = *(const bf16x8*)(v_ + (size_t)l15 * 64); vtn[0][1] = *(const bf16x8*)(v_ + (size_t)l15 * 64 + 32); \
            vtn[1][0] = *(const bf16x8*)(v_ + (size_t)(16 + l15) * 64); vtn[1][1] = *(const bf16x8*)(v_ + (size_t)(16 + l15) * 64 + 32); } } while (0)
    GL_LOADS(0);
    f32x4 sacc[2][8];
    if (OUT) {
        const bf16* U0 = UST + ((size_t)(ch * 32 + (s - 1)) * 256 + wave * 32 + 4 * q4) * 128 + l15;
#pragma unroll
        for (int et = 0; et < 2; ++et)
#pragma unroll
            for (int nt = 0; nt < 8; ++nt)
#pragma unroll
                for (int r = 0; r < 4; ++r) { const bf16 v = U0[(size_t)(16 * et + r) * 128 + nt * 16]; sacc[et][nt][r] = bf2f(v); ST[(16 * et + 4 * q4 + r) * 136 + nt * 16 + l15] = v; }
    } else {
#pragma unroll
        for (int et = 0; et < 2; ++et)
#pragma unroll
            for (int nt = 0; nt < 8; ++nt) sacc[et][nt] = (f32x4){0.f, 0.f, 0.f, 0.f};
    }
    float dprod[8];
#pragma unroll
    for (int nt = 0; nt < 8; ++nt) dprod[nt] = 1.0f;
#pragma unroll 1
    for (int sb = 0; sb < 4; ++sb) {
        const size_t row0 = (size_t)(b * 132 + GL_CHUNK(sb)) * 64;
        if (OUT) { *(LAS v4u*)(QEs + qr0 * 136 + qc0) = sq[0]; *(LAS v4u*)(QEs + (qr0 + 32) * 136 + qc0) = sq[1]; }
        *(LAS v4u*)(KEs + qr0 * 136 + qc0) = sk[0]; *(LAS v4u*)(KEs + (qr0 + 32) * 136 + qc0) = sk[1];
        if (tid < 128) *(LAS v4u*)(T1s + tid * 8) = st1;
        bf16x8 vtf[2][2];
#pragma unroll
        for (int et = 0; et < 2; ++et) { vtf[et][0] = vtn[et][0]; vtf[et][1] = vtn[et][1]; }
        __syncthreads();
        if (sb < 3) GL_LOADS(sb + 1);
        __builtin_amdgcn_sched_barrier(0);
        {
            float bb[4][4]; float carry = 0.f;
#pragma unroll
            for (int mt = 0; mt < 4; ++mt) {
                bf16x8 tf = {0, 0, 0, 0, 0, 0, 0, 0};
                if (q4 < 2) tf = *(const LAS bf16x8*)(T1s + (16 * mt + l15) * 16 + q4 * 8);
                const f32x4 gp = mfma16(tf, w2f, (f32x4){0.f, 0.f, 0.f, 0.f});
                float c[4], g4[4];
#pragma unroll
                for (int r = 0; r < 4; ++r) { const float xg = gp[r] + bgd; const float g = (fminf(xg, 0.f) - __logf(1.0f + __expf(-fabsf(xg)))) * 0.0625f; g4[r] = g; c[r] = g + (r ? c[r - 1] : 0.f); }
                const float t0 = __shfl(c[3], l15), t1 = __shfl(c[3], l15 + 16), t2 = __shfl(c[3], l15 + 32), t3 = __shfl(c[3], l15 + 48);
                const float ex = carry + (q4 > 0 ? t0 : 0.f) + (q4 > 1 ? t1 : 0.f) + (q4 > 2 ? t2 : 0.f);
#pragma unroll
                for (int r = 0; r < 4; ++r) bb[mt][r] = ex + c[r] - (dir ? g4[r] : 0.f);
                carry += (t0 + t1) + (t2 + t3);
            }
            const float btot = carry;
#pragma unroll
            for (int mt = 0; mt < 4; ++mt) {
                float kp[4];
#pragma unroll
                for (int r = 0; r < 4; ++r) { const int m = 16 * mt + 4 * q4 + r;
                    const float kv = bf2f(KEs[m * 136 + lc]); const float bv = dir ? (btot - bb[mt][r]) : bb[mt][r];
                    kp[r] = kv * __expf(btot - bv);
                    if (OUT) { const float qv = bf2f(QEs[m * 136 + lc]); const unsigned qk = pk2h(qv * 0.08838834764831845f * __expf(bv), kv * __expf(-bv)); QEs[m * 136 + lc] = (bf16)(qk & 0xffffu); KEs[m * 136 + lc] = (bf16)(qk >> 16); } }
                v2u w; w.x = pk2h(kp[0], kp[1]); w.y = pk2h(kp[2], kp[3]);
                *(LAS v2u*)(KPs + lc * 72 + 16 * mt + 4 * q4) = w;
            }
            if (q4 == 0) DECs[lc] = __expf(btot);
        }
        __syncthreads();
        float dc[8];
#pragma unroll
        for (int nt = 0; nt < 8; ++nt) dc[nt] = DECs[nt * 16 + l15];
        if (OUT) {
#pragma unroll
            for (int tt = 0; tt < 2; ++tt) { const int tix = 2 * wave + tt, mt = tix >> 2, nt = tix & 3; f32x4 a = {0.f, 0.f, 0.f, 0.f};
#pragma unroll
                for (int kk = 0; kk < 4; ++kk) a = mfma16(*(const LAS bf16x8*)(QEs + (16 * mt + l15) * 136 + kk * 32 + 8 * q4), *(const LAS bf16x8*)(KEs + (16 * nt + l15) * 136 + kk * 32 + 8 * q4), a);
#pragma unroll
                for (int r = 0; r < 4; ++r) { const int i = 16 * mt + 4 * q4 + r, j = 16 * nt + l15; const bool keep = dir ? (j >= i) : (j <= i); AMs[i * 72 + j] = keep ? (bf16)f2bf(a[r]) : (bf16)0; } }
            __syncthreads();
            bf16x8 stf[2][4];
#pragma unroll
            for (int et = 0; et < 2; ++et)
#pragma unroll
                for (int kk = 0; kk < 4; ++kk) stf[et][kk] = *(const LAS bf16x8*)(ST + (16 * et + l15) * 136 + kk * 32 + 8 * q4);
#pragma unroll
            for (int mt = 0; mt < 4; ++mt) { f32x4 o0 = {0.f, 0.f, 0.f, 0.f}, o1 = {0.f, 0.f, 0.f, 0.f};
#pragma unroll
                for (int kk = 0; kk < 4; ++kk) { const bf16x8 qf = *(const LAS bf16x8*)(QEs + (16 * mt + l15) * 136 + kk * 32 + 8 * q4); o0 = mfma16(qf, stf[0][kk], o0); o1 = mfma16(qf, stf[1][kk], o1); }
#pragma unroll
                for (int kk = 0; kk < 2; ++kk) { const bf16x8 af = *(const LAS bf16x8*)(AMs + (16 * mt + l15) * 72 + kk * 32 + 8 * q4); o0 = mfma16(af, vtf[0][kk], o0); o1 = mfma16(af, vtf[1][kk], o1); }
#pragma unroll
                for (int r = 0; r < 4; ++r) { bf16* op = Oout + (row0 + 16 * mt + 4 * q4 + r) * 1024 + hh * 256 + wave * 32 + l15; op[0] = (bf16)f2bf(o0[r]); op[16] = (bf16)f2bf(o1[r]); } }
        }
#pragma unroll
        for (int nt = 0; nt < 8; ++nt) { dprod[nt] *= dc[nt];
            const bf16x8 k0 = *(const LAS bf16x8*)(KPs + (16 * nt + l15) * 72 + 8 * q4), k1 = *(const LAS bf16x8*)(KPs + (16 * nt + l15) * 72 + 32 + 8 * q4);
#pragma unroll
            for (int et = 0; et < 2; ++et) { sacc[et][nt] = sacc[et][nt] * dc[nt]; sacc[et][nt] = mfma16(vtf[et][0], k0, sacc[et][nt]); sacc[et][nt] = mfma16(vtf[et][1], k1, sacc[et][nt]); } }
        if (OUT && sb < 3) {
#pragma unroll
            for (int et = 0; et < 2; ++et)
#pragma unroll
                for (int nt = 0; nt < 8; ++nt)
#pragma unroll
                    for (int r = 0; r < 4; ++r) ST[(16 * et + 4 * q4 + r) * 136 + nt * 16 + l15] = (bf16)f2bf(sacc[et][nt][r]);
        }
        __syncthreads();
    }
#undef GL_LOADS
#undef GL_CHUNK
    if (!OUT) {
        bf16* U0 = UST + ((size_t)(ch * 32 + s) * 256 + wave * 32 + 4 * q4) * 128 + l15;
#pragma unroll
        for (int et = 0; et < 2; ++et)
#pragma unroll
            for (int nt = 0; nt < 8; ++nt)
#pragma unroll
                for (int r = 0; r < 4; ++r) U0[(size_t)(16 * et + r) * 128 + nt * 16] = (bf16)f2bf(sacc[et][nt][r]);
        if (wave == 0 && q4 == 0) {
#pragma unroll
            for (int nt = 0; nt < 8; ++nt) DS[(size_t)(ch * 32 + s) * 128 + nt * 16 + l15] = dprod[nt];
        }
    }
}
template <bool OUT>
__device__ __forceinline__ void phase_gla_units(const KP& p, const Ctx& F) {
#pragma unroll 1
    for (int u = F.blk; u < 32 * 32; u += F.G) { const int s = (u & 31) + (OUT ? 1 : 0), ch = u >> 5; gla_unit<OUT>(p, F, ch, s); }
}
__device__ __forceinline__ void phase_gla_scan(const Ctx& F) {
    unsigned* UST = (unsigned*)(F.ws + WS_UST); const float* DS = (const float*)(F.ws + WS_DS);
    const int gt = F.blk * 512 + F.tid, NGT = F.G * 512;
    for (int idx = gt; idx < 32 * 16384; idx += NGT) {
        const int ch = idx >> 14, ed2 = idx & 16383, d = (ed2 & 63) * 2;
        unsigned u[32]; float d0[32], d1[32];
#pragma unroll
        for (int s = 0; s < 32; ++s) { u[s] = UST[(size_t)(ch * 32 + s) * 16384 + ed2]; const float2 dd = *(const float2*)(DS + (size_t)(ch * 32 + s) * 128 + d); d0[s] = dd.x; d1[s] = dd.y; }
        float r0 = 0.f, r1 = 0.f;
#pragma unroll
        for (int s = 0; s < 32; ++s) { r0 = d0[s] * r0 + bflo(u[s]); r1 = d1[s] * r1 + bfhi(u[s]); UST[(size_t)(ch * 32 + s) * 16384 + ed2] = pk2(r0, r1); }
    }
}

constexpr int NWAVES = 8;
constexpr int LDS_BYTES = 163840;
constexpr int CTRL_OFF = 159744;
constexpr int MISC_OFF = CTRL_OFF + 320;
constexpr int TSTART_OFF = CTRL_OFF + 1024;
constexpr int CW_BAR = 4096;
constexpr int NPHASE = 24;


#ifdef MX_SELFTEST
typedef int v8i __attribute__((ext_vector_type(8)));
__device__ __forceinline__ float mx_a(int i, int k) { return (float)((i * 7 + k * 3) % 5 - 2) * 0.5f; }
__device__ __forceinline__ float mx_b(int k, int j) { return (float)((k * 5 + j * 11) % 7 - 3) * 0.25f; }
__device__ __forceinline__ int mx_kmap(int hyp, int q4, int j, int t) { return hyp == 0 ? 32 * q4 + 4 * j + t : 64 * (j >> 2) + 16 * q4 + 4 * (j & 3) + t; }
__device__ __forceinline__ bool mx_try(int hyp, int lane) {
    const int l15 = lane & 15, q4 = lane >> 4; v8i a, b;
#pragma unroll
    for (int j = 0; j < 8; ++j) { int wa = 0, wb = 0;
        wa = __builtin_amdgcn_cvt_pk_fp8_f32(mx_a(l15, mx_kmap(hyp, q4, j, 0)), mx_a(l15, mx_kmap(hyp, q4, j, 1)), wa, false);
        wa = __builtin_amdgcn_cvt_pk_fp8_f32(mx_a(l15, mx_kmap(hyp, q4, j, 2)), mx_a(l15, mx_kmap(hyp, q4, j, 3)), wa, true);
        wb = __builtin_amdgcn_cvt_pk_fp8_f32(mx_b(mx_kmap(hyp, q4, j, 0), l15), mx_b(mx_kmap(hyp, q4, j, 1), l15), wb, false);
        wb = __builtin_amdgcn_cvt_pk_fp8_f32(mx_b(mx_kmap(hyp, q4, j, 2), l15), mx_b(mx_kmap(hyp, q4, j, 3), l15), wb, true);
        a[j] = wa; b[j] = wb; }
    f32x4 c = {0.f, 0.f, 0.f, 0.f};
    c = __builtin_amdgcn_mfma_scale_f32_16x16x128_f8f6f4(a, b, c, 0, 0, 0, 0x7f7f7f7f, 0, 0x7f7f7f7f);
    bool ok = true;
#pragma unroll
    for (int r = 0; r < 4; ++r) { const int i = 4 * q4 + r; float ref = 0.f; for (int kk = 0; kk < 128; ++kk) ref += mx_a(i, kk) * mx_b(kk, l15); ok = ok && (fabsf(ref - c[r]) < 1e-3f); }
    return __all(ok);
}
#endif

#ifdef ATT_CHECK
__device__ __forceinline__ float f8dec(unsigned char b) { return __builtin_amdgcn_cvt_f32_fp8((int)b, 0); }
__device__ __forceinline__ void att_check(const Ctx& F, unsigned* ctl) {
    if (F.blk >= 8) return;
    const int sid = F.blk * 8 + F.wave, lane = F.lane, b = sid & 3, h = (sid >> 2) & 7;
    const bool isctx = sid >= 56; const int qt = isctx ? SEQ + (sid * 37) % 256 : (sid * 1237 + 11) % SEQ;
    const size_t r0 = (size_t)b * TPB; const size_t krow0 = r0 + (isctx ? SEQ : 0); const int nk = isctx ? LC : TPB;
    const unsigned char* Q8 = F.ws + WS_Q8 + (r0 + qt) * 1536 + h * 192; const unsigned char* KN8 = F.ws + WS_KN8 + krow0 * 1024 + h * 128; const unsigned char* KR8 = F.ws + WS_KR8 + krow0 * 64;
    const unsigned char* VT = F.ws + WS_VT8 + (size_t)((b * 8 + h) * 128) * 8448 + (isctx ? SEQ : 0); const unsigned char* O8 = F.ws + WS_O8 + (r0 + qt) * 1024 + h * 128;
    const float q0 = f8dec(Q8[lane]), q1 = f8dec(Q8[64 + lane]), q2 = f8dec(Q8[128 + lane]);
    float m = -1e30f, l = 0.f, a0 = 0.f, a1 = 0.f;
    for (int j = 0; j < nk; ++j) {
        const float part = q0 * f8dec(KN8[(size_t)j * 1024 + lane]) + q1 * f8dec(KN8[(size_t)j * 1024 + 64 + lane]) + q2 * f8dec(KR8[(size_t)j * 64 + lane]);
        const float s = wave_sum(part) * 0.07216878364870322f;
        const float mn = fmaxf(m, s), sc = __expf(m - mn), pj = __expf(s - mn); m = mn;
        l = l * sc + pj; { const size_t ko = (size_t)(j & ~63) + pg8::vpos(j & 63); a0 = a0 * sc + pj * f8dec(VT[(size_t)lane * 8448 + ko]); a1 = a1 * sc + pj * f8dec(VT[(size_t)(64 + lane) * 8448 + ko]); }
    }
    const float o0 = a0 / l, o1 = a1 / l, k0 = f8dec(O8[lane]), k1 = f8dec(O8[64 + lane]);
    const float err = wave_sum((o0 - k0) * (o0 - k0) + (o1 - k1) * (o1 - k1)), nrm = wave_sum(o0 * o0 + o1 * o1);
    if (lane == 0 && !(err <= 0.04f * nrm)) atomicOr(&ctl[64], 4u);
}
#endif
__device__ __forceinline__ void load_tstart(const Ctx& F) {
    const int* META = (const int*)(F.ws + WS_META); LAS int* ts = (LAS int*)(F.lds + TSTART_OFF);
    int t0 = threadIdx.x; asm volatile("" : "+v"(t0));
    if (t0 < 33) ts[t0] = META[64 + t0];
    __syncthreads();
    for (int rt = t0; rt < SROWS / 256; rt += NWAVES * 64) { int e = 0;
#pragma unroll 1
        for (int k = 1; k < 32; ++k) e += (ts[k] <= rt) ? 1 : 0;
        ts[64 + rt] = e; }
    __syncthreads();
}

typedef const __attribute__((address_space(4))) KP* KPc;
__device__ __forceinline__ const KP& kp_launder() { KPc q = (KPc)__builtin_amdgcn_kernarg_segment_ptr(); asm volatile("" : "+s"(q)); return *(const KP*)q; }
__global__ void __launch_bounds__(NWAVES * 64, 2) trunk_fwd(KP pk) {
#define p kp_launder()
    extern __shared__ __attribute__((aligned(16))) unsigned char lds_raw[];
    Ctx F;
    F.lds = (LAS unsigned char*)lds_raw; F.ws = p.ws;
    F.tid = threadIdx.x; F.lane = F.tid & 63; F.wave = __builtin_amdgcn_readfirstlane(F.tid >> 6); F.G = gridDim.x; F.blk = blockIdx.x;
    { int t0 = threadIdx.x; asm volatile("" : "+v"(t0));
      for (int u = t0; u < (LDS_BYTES - CTRL_OFF) / 4; u += NWAVES * 64) ((LAS unsigned*)(F.lds + CTRL_OFF))[u] = 0u; }
    __syncthreads();
    unsigned* ctl = (unsigned*)(p.ws + WS_CTL);
#if MK_PER_PHASE
#define GRID_BAR() do { } while (0)
#else
    XcdBarrier bar = xcd_barrier_post(ctl + CW_BAR, (volatile LAS unsigned*)(F.lds + MISC_OFF) + 8);
#define GRID_BAR() xcd_barrier(bar)
#endif
#ifdef MX_SELFTEST
    if (F.blk == 0 && F.wave == 0) { const bool h1 = mx_try(0, F.lane), h2 = mx_try(1, F.lane); if (F.lane == 0) ctl[64] = h1 ? 0u : (h2 ? 1u : 2u); }
#endif
    const int lo = p.ph_lo, hi = p.ph_hi;
#ifndef PH_MASK
#define PH_MASK 0xffffff
#endif
#define IN(k) (((PH_MASK >> (k)) & 1) && lo <= (k) && (k) < hi)
#define SEAM(k) do { if (IN(k) && IN((k) + 1)) GRID_BAR(); } while (0)
#ifndef REP_MASK
#define REP_MASK 0
#endif
#define NREP(k) (1 + ((REP_MASK >> (k)) & 1))
    unsigned char* ws = p.ws;
    const float* modv = (const float*)(ws + WS_MODV);
    LAS unsigned char* ring = F.lds;
    const LAS int* tstart = (const LAS int*)(F.lds + TSTART_OFF);

    if (IN(0)) _Pragma("unroll") for (int rep_ = 0; rep_ < NREP(0); ++rep_) { if (rep_) GRID_BAR(); phase_prologue(p, F); } SEAM(0);
    if (IN(1)) _Pragma("unroll") for (int rep_ = 0; rep_ < NREP(1); ++rep_) { if (rep_) GRID_BAR(); phase_norm1_l0(p, F); } SEAM(1);
    if (IN(2)) _Pragma("unroll") for (int rep_ = 0; rep_ < NREP(2); ++rep_) { if (rep_) GRID_BAR();
        pg8::Gemm g{(const pg8::bf16_t*)(ws + WS_H8), (const pg8::bf16_t*)(ws + WS_W_IN), M, 1024, 512}; pg8::StaticOrder S; S.init(M, 1024, F.G, F.blk);
        pg8::EpiBf16 E{(pg8::bf16_t*)(ws + WS_A1), 1024, nullptr, 0, 0, 1.0f};
        pg8::gemm_phase<pg8::EpiBf16, pg8::StaticOrder, true, true, true>(ring, g, S, E);
    if (F.blk >= 16) convert_l1_share(p, F, L1_D6, L1_D2, F.blk - 16, F.G - 16);
    } SEAM(2);
    if (IN(3)) _Pragma("unroll") for (int rep_ = 0; rep_ < NREP(3); ++rep_) { if (rep_) GRID_BAR(); phase_mla_thin(p, F); } SEAM(3);
    if (IN(4)) _Pragma("unroll") for (int rep_ = 0; rep_ < NREP(4); ++rep_) { if (rep_) GRID_BAR();
        { pg8::Gemm g{(const pg8::bf16_t*)(ws + WS_CQ8), (const pg8::bf16_t*)(ws + WS_W_UQ), M, 1536, 256}; pg8::StaticOrder S; S.init(M, 1536, F.G, F.blk);
          pg8::EpiQRope E{ws + WS_Q8, (const float*)(ws + WS_ROPE), (const float*)(ws + WS_ROPE) + 2048, (8.0f * 0.07216878364870322f * 1.4426950408889634f)};
          pg8::gemm_phase<pg8::EpiQRope, pg8::StaticOrder, true, true, true>(ring, g, S, E); }
        { pg8::Gemm g{(const pg8::bf16_t*)(ws + WS_CKV8), (const pg8::bf16_t*)(ws + WS_W_UKV), M, 2048, 128}; pg8::StaticOrder S; S.init(M, 2048, F.G, (F.blk + F.G / 2) % F.G);
          pg8::EpiKV E{ws + WS_KN8, ws + WS_VT8, 1.0f};
          pg8::gemm_phase<pg8::EpiKV, pg8::StaticOrder, true, true, true>(ring, g, S, E); }
    } SEAM(4);
    if (IN(5)) _Pragma("unroll") for (int rep_ = 0; rep_ < NREP(5); ++rep_) { if (rep_) GRID_BAR(); phase_attention(F); if (F.blk >= 32) convert_l1_share(p, F, L1_D6 + L1_D2, L1_D5, F.blk - 32, F.G - 32); } SEAM(5);
#ifdef ATT_CHECK
    if (IN(5) && IN(6)) { att_check(F, ctl); }
#endif
    if (IN(6)) _Pragma("unroll") for (int rep_ = 0; rep_ < NREP(6); ++rep_) { if (rep_) GRID_BAR();
        pg8::Gemm g{(const pg8::bf16_t*)(ws + WS_O8), (const pg8::bf16_t*)(ws + WS_W_O), M, 1024, 512}; pg8::StaticOrder S; S.init(M, 1024, F.G, F.blk);
        pg8::EpiResid E{p.x, p.ctx, (pg8::bf16_t*)(ws + WS_XRES), modv + 2048, 1.0f};
        pg8::gemm_phase<pg8::EpiResid, pg8::StaticOrder, true, true, true>(ring, g, S, E);
        if (F.blk >= 16) convert_l1_share(p, F, 0, L1_D6, F.blk - 16, F.G - 16);
    } SEAM(6);
    if (IN(7)) _Pragma("unroll") for (int rep_ = 0; rep_ < NREP(7); ++rep_) { if (rep_) GRID_BAR(); phase_router(p, F, 0, false); } SEAM(7);
    if (IN(8)) _Pragma("unroll") for (int rep_ = 0; rep_ < NREP(8); ++rep_) { if (rep_) GRID_BAR(); phase_lists(p, F, false); } SEAM(8);
    if (IN(9)) _Pragma("unroll") for (int rep_ = 0; rep_ < NREP(9); ++rep_) { if (rep_) GRID_BAR();
        load_tstart(F);
        pg8::Gemm g{(const pg8::bf16_t*)(ws + WS_H8), (const pg8::bf16_t*)(ws + WS_W_GU), 0, 2048, 512}; pg8::MoeOrder S{tstart, 3, F.G, F.blk};
        pg8::EpiSwiglu E{ws + WS_ACT, p.moe_b_gu, 1.0f};
        pg8::gemm_phase_gather<pg8::EpiSwiglu, pg8::MoeOrder, true>(ring, g, (const int*)(ws + WS_SORT), S, E);
    } SEAM(9);
    if (IN(10)) _Pragma("unroll") for (int rep_ = 0; rep_ < NREP(10); ++rep_) { if (rep_) GRID_BAR();
        load_tstart(F);
        pg8::Gemm g{(const pg8::bf16_t*)(ws + WS_ACT), (const pg8::bf16_t*)(ws + WS_W_DN), 0, 1024, 512}; pg8::MoeOrder S{tstart, 2, F.G, F.blk};
        pg8::EpiDown8 E{ws + WS_YS, p.moe_b_down, 1.0f};
        pg8::gemm_phase<pg8::EpiDown8, pg8::MoeOrder, true, true, true>(ring, g, S, E);
    } SEAM(10);
    if (IN(11)) _Pragma("unroll") for (int rep_ = 0; rep_ < NREP(11); ++rep_) { if (rep_) GRID_BAR(); phase_combine<false>(p, F, 0); } SEAM(11);

    if (IN(12)) _Pragma("unroll") for (int rep_ = 0; rep_ < NREP(12); ++rep_) { if (rep_) GRID_BAR();
        pg8::Gemm g{(const pg8::bf16_t*)(ws + WS_H), (const pg8::bf16_t*)(ws + WS_W_GIN), M, A2W, 1024}; pg8::StaticOrder S; S.init(M, A2W, F.G, F.blk);
        pg8::EpiGla E{(pg8::bf16_t*)(ws + WS_A2), (pg8::bf16_t*)(ws + WS_VT)};
        pg8::gemm_phase<pg8::EpiGla, pg8::StaticOrder, true, true>(ring, g, S, E);
    if (F.blk >= 180) convert_l1_share(p, F, L1_D6 + L1_D2 + L1_D5, L1_D12, F.blk - 180, F.G - 180);
    } SEAM(12);
    if (IN(14)) _Pragma("unroll") for (int rep_ = 0; rep_ < NREP(14); ++rep_) { if (rep_) GRID_BAR(); phase_gla_units<false>(p, F); } SEAM(14);
    if (IN(15)) _Pragma("unroll") for (int rep_ = 0; rep_ < NREP(15); ++rep_) { if (rep_) GRID_BAR(); phase_gla_scan(F); } SEAM(15);
    if (IN(16)) _Pragma("unroll") for (int rep_ = 0; rep_ < NREP(16); ++rep_) { if (rep_) GRID_BAR(); phase_gla_units<true>(p, F); } SEAM(16);
    if (IN(17)) _Pragma("unroll") for (int rep_ = 0; rep_ < NREP(17); ++rep_) { if (rep_) GRID_BAR(); phase_gla_finish(p, F); } SEAM(17);
    if (IN(18)) _Pragma("unroll") for (int rep_ = 0; rep_ < NREP(18); ++rep_) { if (rep_) GRID_BAR();
        pg8::Gemm g{(const pg8::bf16_t*)(ws + WS_Z), (const pg8::bf16_t*)(ws + WS_W_GO), M, 1024, 1024}; pg8::LatentOrder S; S.init(1024, F.G, F.blk);
        pg8::EpiResid E{nullptr, nullptr, (pg8::bf16_t*)(ws + WS_XRES), modv + 5 * 6144 + 2048, 1.0f};
        pg8::gemm_phase<pg8::EpiResid, pg8::LatentOrder, true, true>(ring, g, S, E);
    } SEAM(18);
    if (IN(19)) _Pragma("unroll") for (int rep_ = 0; rep_ < NREP(19); ++rep_) { if (rep_) GRID_BAR(); phase_router(p, F, 1, true); } SEAM(19);
    if (IN(20)) _Pragma("unroll") for (int rep_ = 0; rep_ < NREP(20); ++rep_) { if (rep_) GRID_BAR(); phase_lists(p, F, true); } SEAM(20);
    if (IN(21)) _Pragma("unroll") for (int rep_ = 0; rep_ < NREP(21); ++rep_) { if (rep_) GRID_BAR();
        load_tstart(F);
        pg8::Gemm g{(const pg8::bf16_t*)(ws + WS_H8), (const pg8::bf16_t*)(ws + WS_W_GU + (size_t)65536 * 1024), 0, 2048, 512}; pg8::MoeOrder S{tstart, 3, F.G, F.blk};
        pg8::EpiSwiglu E{ws + WS_ACT, p.moe_b_gu + 32 * 2048, 1.0f};
        pg8::gemm_phase_gather<pg8::EpiSwiglu, pg8::MoeOrder, true>(ring, g, (const int*)(ws + WS_SORT), S, E);
    } SEAM(21);
    if (IN(22)) _Pragma("unroll") for (int rep_ = 0; rep_ < NREP(22); ++rep_) { if (rep_) GRID_BAR();
        load_tstart(F);
        pg8::Gemm g{(const pg8::bf16_t*)(ws + WS_ACT), (const pg8::bf16_t*)(ws + WS_W_DN + (size_t)32768 * 1024), 0, 1024, 512}; pg8::MoeOrder S{tstart, 2, F.G, F.blk};
        pg8::EpiDown8 E{ws + WS_YS, p.moe_b_down + 32 * 1024, 1.0f};
        pg8::gemm_phase<pg8::EpiDown8, pg8::MoeOrder, true, true, true>(ring, g, S, E);
    } SEAM(22);
    if (IN(23)) _Pragma("unroll") for (int rep_ = 0; rep_ < NREP(23); ++rep_) { if (rep_) GRID_BAR(); phase_combine<true>(p, F, 1); }
#undef IN
#undef SEAM
#undef GRID_BAR
#undef p
}

extern "C" void kernel_launch(void* const* d_in, const int* in_sizes, int n_in, void* d_out, int out_size, void* d_ws, size_t ws_size, hipStream_t stream) {
    static int grid = 0;
    if (grid == 0) {
        if (n_in != 27 || in_sizes[0] != NB * SEQ * DM || out_size != NB * SEQ * DM || ws_size < WS_END) {
            fprintf(stderr, "kernel_launch: shape mismatch (n_in %d, in0 %d, out %d, ws %zu, need ws >= %zu); nothing launched\n", n_in, n_in > 0 ? in_sizes[0] : -1, out_size, ws_size, (size_t)WS_END); grid = -1; return; }
        int dev = 0, cus = 0, per_cu = 0;
        if (hipGetDevice(&dev) != hipSuccess || hipDeviceGetAttribute(&cus, hipDeviceAttributeMultiprocessorCount, dev) != hipSuccess) { fprintf(stderr, "kernel_launch: device query failed\n"); grid = -1; return; }
        if (hipFuncSetAttribute((const void*)trunk_fwd, hipFuncAttributeMaxDynamicSharedMemorySize, LDS_BYTES) != hipSuccess) { fprintf(stderr, "kernel_launch: hipFuncSetAttribute failed\n"); grid = -1; return; }
        if (hipOccupancyMaxActiveBlocksPerMultiprocessor(&per_cu, (const void*)trunk_fwd, NWAVES * 64, LDS_BYTES) != hipSuccess || per_cu < 1)
            fprintf(stderr, "kernel_launch: note: occupancy query reports %d workgroups per CU\n", per_cu);
        (void)hipGetLastError();
        grid = cus;
        if (grid != 256) { fprintf(stderr, "kernel_launch: built for a 256-CU device (got %d CUs); nothing launched\n", cus); grid = -1; return; }
    }
    if (grid < 0) return;
    if (hipMemsetAsync((char*)d_ws + WS_CTL, 0, CTL_ZERO_BYTES, stream) != hipSuccess) { fprintf(stderr, "kernel_launch: memset failed\n"); return; }
    KP a{};
    const float** pp = (const float**)&a;
    for (int i = 0; i < 27; ++i) pp[i] = (const float*)d_in[i];
    a.out = (float*)d_out; a.ws = (unsigned char*)d_ws;
#if MK_PER_PHASE
    for (int ph = 0; ph < NPHASE; ++ph) { a.ph_lo = ph; a.ph_hi = ph + 1; hipLaunchKernelGGL(trunk_fwd, dim3(grid), dim3(NWAVES * 64), LDS_BYTES, stream, a); }
#else
    a.ph_lo = 0; a.ph_hi = NPHASE;
    hipLaunchKernelGGL(trunk_fwd, dim3(grid), dim3(NWAVES * 64), LDS_BYTES, stream, a);
#endif
    const hipError_t le = hipPeekAtLastError();
    if (le != hipSuccess) fprintf(stderr, "kernel_launch: launch failed: %s\n", hipGetErrorName(le));
}
```
